# Optimizing an MI355X kernel written in HIP

```python
import math
import jax, jax.numpy as jnp
from jax import lax
import numpy as np

D_MODEL = 1024
BATCH = 16
SEQ = 4096
DEPTH = 1

MEM_LEN = 256
HEAD_DIM = 64
DIFF_HEADS = 4
DIFF_QK = HEAD_DIM
DIFF_V = 2 * HEAD_DIM
FOX_HEADS = 8
FOX_DIM = HEAD_DIM
MEM_HEADS = 4
MEM_DIM = 128
N_BRANCHES = 3
ROPE_THETA = 500000.0
ROPE_DIM = HEAD_DIM // 4
Q_BLOCK = 128
N_GROUPS = 4
EXPERTS_PER_GROUP = 8
N_EXPERTS = N_GROUPS * EXPERTS_PER_GROUP
EXPERT_TOP_K = 2
EXPERT_FF = 512
MOE_BLOCK = 128
EPS = 1e-6
NEG_INF = -1e30
IN_SPLITS = (DIFF_HEADS * 2 * DIFF_QK, DIFF_HEADS * 2 * DIFF_QK, DIFF_HEADS * DIFF_V,
             FOX_HEADS * FOX_DIM, FOX_HEADS * FOX_DIM, FOX_HEADS * FOX_DIM, FOX_HEADS,
             MEM_HEADS * MEM_DIM, N_BRANCHES * D_MODEL)
IN_COLS = sum(IN_SPLITS)

kernel_name = "hybrid_diff_fox_mem_hiermoe_layer"


def _rms(x, g):
    xf = x.astype(jnp.float32)
    y = xf * lax.rsqrt(jnp.mean(xf * xf, axis=-1, keepdims=True) + EPS)
    return (y * g.astype(jnp.float32)).astype(x.dtype)


def _rope_tables(positions):
    inv = ROPE_THETA ** (-jnp.arange(0, ROPE_DIM, 2, dtype=jnp.float32) / ROPE_DIM)
    ang = positions.astype(jnp.float32)[..., None] * inv
    return jnp.cos(ang), jnp.sin(ang)


def _partial_rope(t, cos, sin):
    shape = cos.shape[:2] + (1,) * (t.ndim - 3) + cos.shape[-1:]
    c = cos.reshape(shape).astype(t.dtype)
    s = sin.reshape(shape).astype(t.dtype)
    half = ROPE_DIM // 2
    t1, t2, rest = t[..., :half], t[..., half:ROPE_DIM], t[..., ROPE_DIM:]
    return jnp.concatenate([t1 * c - t2 * s, t2 * c + t1 * s, rest], axis=-1)


def _causal_mask(s0, s1):
    return jnp.arange(s1)[None, :] <= jnp.arange(s0, s1)[:, None]


def _diff_attention(q, k, v, cos, sin, qn_g, kn_g, lam_params, subln_g, lambda_init):
    B, S, _ = q.shape
    q = q.reshape(B, S, DIFF_HEADS, 2, DIFF_QK)
    k = k.reshape(B, S, DIFF_HEADS, 2, DIFF_QK)
    v = v.reshape(B, S, DIFF_HEADS, DIFF_V).transpose(0, 2, 1, 3)
    q = (_partial_rope(_rms(q, qn_g), cos, sin) * DIFF_QK ** -0.5).transpose(0, 2, 3, 1, 4)
    k = _partial_rope(_rms(k, kn_g), cos, sin).transpose(0, 2, 3, 1, 4)
    lp = lam_params.astype(jnp.float32)
    lam = jnp.exp(jnp.sum(lp[0] * lp[1])) - jnp.exp(jnp.sum(lp[2] * lp[3])) + lambda_init
    outs = []
    for i in range(S // Q_BLOCK):
        s0, s1 = i * Q_BLOCK, (i + 1) * Q_BLOCK
        sc = jnp.einsum('bhmqd,bhmkd->bhmqk', q[:, :, :, s0:s1], k[:, :, :, :s1]).astype(jnp.float32)
        p = jax.nn.softmax(jnp.where(_causal_mask(s0, s1), sc, NEG_INF), axis=-1)
        pd = p[:, :, 0] - lam * p[:, :, 1]
        outs.append(jnp.einsum('bhqk,bhkd->bhqd', pd.astype(v.dtype), v[:, :, :s1]))
    o = _rms(jnp.concatenate(outs, axis=2), subln_g) * (1.0 - lambda_init)
    return o.transpose(0, 2, 1, 3).reshape(B, S, DIFF_HEADS * DIFF_V)


def _forgetting_attention(q, k, v, f_logit, f_bias, qn_g, kn_g):
    B, S, _ = q.shape
    q = (_rms(q.reshape(B, S, FOX_HEADS, FOX_DIM), qn_g) * FOX_DIM ** -0.5).transpose(0, 2, 1, 3)
    k = _rms(k.reshape(B, S, FOX_HEADS, FOX_DIM), kn_g).transpose(0, 2, 1, 3)
    v = v.reshape(B, S, FOX_HEADS, FOX_DIM).transpose(0, 2, 1, 3)
    log_f = jax.nn.log_sigmoid(f_logit.astype(jnp.float32) + f_bias.astype(jnp.float32))
    cum = jnp.cumsum(log_f, axis=1).transpose(0, 2, 1)
    outs = []
    for i in range(S // Q_BLOCK):
        s0, s1 = i * Q_BLOCK, (i + 1) * Q_BLOCK
        sc = jnp.einsum('bhqd,bhkd->bhqk', q[:, :, s0:s1], k[:, :, :s1]).astype(jnp.float32)
        sc = sc + cum[:, :, s0:s1, None] - cum[:, :, None, :s1]
        p = jax.nn.softmax(jnp.where(_causal_mask(s0, s1), sc, NEG_INF), axis=-1)
        outs.append(jnp.einsum('bhqk,bhkd->bhqd', p.astype(v.dtype), v[:, :, :s1]))
    o = jnp.concatenate(outs, axis=2)
    return o.transpose(0, 2, 1, 3).reshape(B, S, FOX_HEADS * FOX_DIM)


def _memory_attention(q, mem_n, w_kv, qn_g, kn_g):
    B, S, _ = q.shape
    M = mem_n.shape[1]
    q = (_rms(q.reshape(B, S, MEM_HEADS, MEM_DIM), qn_g) * MEM_DIM ** -0.5).transpose(0, 2, 1, 3)
    kv = jnp.einsum('bmd,dc->bmc', mem_n, w_kv).reshape(B, M, 2, MEM_HEADS, MEM_DIM)
    k = _rms(kv[:, :, 0], kn_g).transpose(0, 2, 1, 3)
    v = kv[:, :, 1].transpose(0, 2, 1, 3)
    p = jax.nn.softmax(jnp.einsum('bhsd,bhmd->bhsm', q, k).astype(jnp.float32), axis=-1)
    o = jnp.einsum('bhsm,bhmd->bhsd', p.astype(v.dtype), v)
    return o.transpose(0, 2, 1, 3).reshape(B, S, MEM_HEADS * MEM_DIM)


def _hier_moe(h, w_rg, b_rg, w_re, b_re, w_up, w_down):
    B, S, D = h.shape
    T = B * S
    ht = h.reshape(T, D)
    g_logits = (ht @ w_rg).astype(jnp.float32) + b_rg.astype(jnp.float32)
    g_idx = jnp.argmax(g_logits, axis=-1).astype(jnp.int32)
    g_gate = jnp.take_along_axis(jax.nn.softmax(g_logits, axis=-1), g_idx[:, None], axis=-1)
    e_logits = ((ht @ w_re).astype(jnp.float32) + b_re.astype(jnp.float32)).reshape(T, N_GROUPS, EXPERTS_PER_GROUP)
    e_logits = jnp.take_along_axis(e_logits, g_idx[:, None, None], axis=1)[:, 0]
    top_logit, top_local = lax.top_k(e_logits, EXPERT_TOP_K)
    weights = g_gate * jax.nn.softmax(top_logit, axis=-1)
    expert_id = g_idx[:, None] * EXPERTS_PER_GROUP + top_local.astype(jnp.int32)
    TK = T * EXPERT_TOP_K
    e_flat = expert_id.reshape(TK)
    tok = jnp.repeat(jnp.arange(T, dtype=jnp.int32), EXPERT_TOP_K)
    w_flat = weights.reshape(TK)
    order = jnp.argsort(e_flat)
    e_s, tok_s, w_s = e_flat[order], tok[order], w_flat[order]
    counts = jnp.bincount(e_flat, length=N_EXPERTS)
    starts = jnp.cumsum(counts) - counts
    padded = (counts + MOE_BLOCK - 1) // MOE_BLOCK * MOE_BLOCK
    pends = jnp.cumsum(padded)
    pstarts = pends - padded
    dest = pstarts[e_s] + jnp.arange(TK, dtype=jnp.int32) - starts[e_s]
    n_blocks = (TK + N_EXPERTS * (MOE_BLOCK - 1) + MOE_BLOCK - 1) // MOE_BLOCK
    rows = jnp.zeros((n_blocks * MOE_BLOCK, D), h.dtype).at[dest].set(ht[tok_s])
    block_expert = jnp.minimum(
        jnp.searchsorted(pends, jnp.arange(n_blocks, dtype=jnp.int32) * MOE_BLOCK, side='right'),
        N_EXPERTS - 1)

    def expert_block(args):
        xb, e = args
        a, b = jnp.split(xb @ w_up[e], 2, axis=-1)
        return (jax.nn.silu(a) * b) @ w_down[e]

    ys = lax.map(expert_block, (rows.reshape(n_blocks, MOE_BLOCK, D), block_expert)).reshape(-1, D)
    contrib = (w_s[:, None] * ys[dest].astype(jnp.float32)).astype(h.dtype)
    out = jnp.zeros((T, D), h.dtype).at[tok_s].add(contrib)
    return out.reshape(B, S, D)


def setup_inputs(seed: int = 0) -> dict:
    key = jax.random.key(seed)
    ks = jax.random.split(key, 32)

    def nrm(k, shape, scale):
        return jax.random.normal(k, shape, jnp.float32) * scale

    def gain(k, shape):
        return 1.0 + 0.02 * jax.random.normal(k, shape, jnp.float32)

    L, D = DEPTH, D_MODEL
    positions = (jnp.arange(SEQ, dtype=jnp.int32)[None, :]
                 + jax.random.randint(ks[2], (BATCH, 1), 0, 1024, dtype=jnp.int32))
    return {
        "x": nrm(ks[0], (BATCH, SEQ, D), 1.0),
        "mem": nrm(ks[1], (BATCH, MEM_LEN, D), 1.0),
        "positions": positions,
        "attn_norm_g": gain(ks[3], (L, D)),
        "w_in": nrm(ks[4], (L, D, IN_COLS), D ** -0.5),
        "diff_qnorm_g": gain(ks[5], (L, DIFF_QK)),
        "diff_knorm_g": gain(ks[6], (L, DIFF_QK)),
        "diff_lambda": nrm(ks[7], (L, 4, DIFF_QK), 0.1),
        "diff_subln_g": gain(ks[8], (L, DIFF_V)),
        "fox_qnorm_g": gain(ks[9], (L, FOX_DIM)),
        "fox_knorm_g": gain(ks[10], (L, FOX_DIM)),
        "fox_forget_b": 3.0 + 0.5 * jax.random.normal(ks[11], (L, FOX_HEADS), jnp.float32),
        "mem_norm_g": gain(ks[12], (L, D)),
        "w_mem_kv": nrm(ks[13], (L, D, 2 * MEM_HEADS * MEM_DIM), D ** -0.5),
        "mem_qnorm_g": gain(ks[14], (L, MEM_DIM)),
        "mem_knorm_g": gain(ks[15], (L, MEM_DIM)),
        "w_o_diff": nrm(ks[16], (L, DIFF_HEADS * DIFF_V, D), (DIFF_HEADS * DIFF_V) ** -0.5),
        "w_o_fox": nrm(ks[17], (L, FOX_HEADS * FOX_DIM, D), (FOX_HEADS * FOX_DIM) ** -0.5),
        "w_o_mem": nrm(ks[18], (L, MEM_HEADS * MEM_DIM, D), (MEM_HEADS * MEM_DIM) ** -0.5),
        "w_out": nrm(ks[19], (L, D, D), D ** -0.5),
        "ffn_norm_g": gain(ks[20], (L, D)),
        "w_router_group": nrm(ks[21], (L, D, N_GROUPS), D ** -0.5),
        "b_router_group": nrm(ks[22], (L, N_GROUPS), 0.01),
        "w_router_expert": nrm(ks[23], (L, D, N_EXPERTS), D ** -0.5),
        "b_router_expert": nrm(ks[24], (L, N_EXPERTS), 0.01),
        "w_up": nrm(ks[25], (L, N_EXPERTS, D, 2 * EXPERT_FF), D ** -0.5),
        "w_down": nrm(ks[26], (L, N_EXPERTS, EXPERT_FF, D), EXPERT_FF ** -0.5),
    }


def reference(x, mem, positions, attn_norm_g, w_in, diff_qnorm_g, diff_knorm_g, diff_lambda,
              diff_subln_g, fox_qnorm_g, fox_knorm_g, fox_forget_b, mem_norm_g, w_mem_kv,
              mem_qnorm_g, mem_knorm_g, w_o_diff, w_o_fox, w_o_mem, w_out, ffn_norm_g,
              w_router_group, b_router_group, w_router_expert, b_router_expert, w_up, w_down):
    B, S, D = x.shape
    cos, sin = _rope_tables(positions)
    split_points = [int(i) for i in np.cumsum(IN_SPLITS)[:-1]]
    for l in range(DEPTH):
        lambda_init = 0.8 - 0.6 * math.exp(-0.3 * l)
        h = _rms(x, attn_norm_g[l])
        proj = jnp.einsum('bsd,dc->bsc', h, w_in[l])
        qa, ka, va, qb, kb, vb, fb, qc, gates = jnp.split(proj, split_points, axis=-1)
        ya = _diff_attention(qa, ka, va, cos, sin, diff_qnorm_g[l], diff_knorm_g[l],
                             diff_lambda[l], diff_subln_g[l], lambda_init)
        yb = _forgetting_attention(qb, kb, vb, fb, fox_forget_b[l], fox_qnorm_g[l], fox_knorm_g[l])
        yc = _memory_attention(qc, _rms(mem, mem_norm_g[l]), w_mem_kv[l], mem_qnorm_g[l], mem_knorm_g[l])
        g = jax.nn.sigmoid(gates.astype(jnp.float32)).astype(x.dtype).reshape(B, S, N_BRANCHES, D)
        merged = (g[:, :, 0] * (ya @ w_o_diff[l])
                  + g[:, :, 1] * (yb @ w_o_fox[l])
                  + g[:, :, 2] * (yc @ w_o_mem[l]))
        x = x + merged @ w_out[l]
        x = x + _hier_moe(_rms(x, ffn_norm_g[l]), w_router_group[l], b_router_group[l],
                          w_router_expert[l], b_router_expert[l], w_up[l], w_down[l])
    return x
```

```cpp
#include <hip/hip_runtime.h>
#include <type_traits>
#include <hip/hip_cooperative_groups.h>
#include <cstdio>
#include <cstdint>
namespace cg = cooperative_groups;

#ifndef MK_N_LAUNCHES
#define MK_N_LAUNCHES 1
#endif

#define LAS __attribute__((address_space(3)))
typedef unsigned short bf16;
typedef short bf16x8 __attribute__((ext_vector_type(8)));
typedef short s16x4 __attribute__((ext_vector_type(4)));
typedef float f32x4 __attribute__((ext_vector_type(4)));
typedef float f32x16 __attribute__((ext_vector_type(16)));
typedef unsigned u32x4 __attribute__((ext_vector_type(4)));
typedef unsigned u32x2 __attribute__((ext_vector_type(2)));

constexpr int DM = 1024, NB = 16, SEQ = 4096, T = NB * SEQ, MEML = 256;
constexpr int NEXP = 32, EFF = 512;
constexpr float EPS = 1e-6f;
constexpr float LOG2E = 1.4426950408889634f;
constexpr int IN_COLS = 6664;
constexpr int N1 = 1536;
constexpr int QP = 1536, KVP = 2048, GP = 3072;
constexpr int MAXROWS = 2 * T + 64 * 256;

constexpr size_t MiB = 1u << 20;
constexpr size_t WS_CTL = 0;
constexpr size_t WS_WIN = 1 * MiB;
constexpr size_t WS_W8 = 8 * MiB;
constexpr size_t WS_WQK8 = 12 * MiB;
constexpr size_t WS_WMKV = 14 * MiB;
constexpr size_t WS_WO = 16 * MiB;
constexpr size_t WS_WOUT = 19 * MiB;
constexpr size_t WS_WR = 21 * MiB;
constexpr size_t WS_ROPE = 22 * MiB;
constexpr size_t WS_CUM = 26 * MiB;
constexpr size_t WS_CHTOT = 28 * MiB;
constexpr size_t WS_BLKCNT = 28 * MiB + 65536;
constexpr size_t WS_RSTD = 28 * MiB + 262144;
constexpr size_t WS_ROUTE = 29 * MiB;
constexpr size_t WS_TOK = 31 * MiB;
constexpr size_t WS_WL = 32 * MiB;
constexpr size_t WS_MEMN = 33 * MiB;
constexpr size_t WS_MEMKV = 41 * MiB;
constexpr size_t WS_WUP = 49 * MiB;
constexpr size_t WS_WDN = 113 * MiB;
constexpr size_t WS_QBUF = 145 * MiB;
constexpr size_t WS_KVBUF = 337 * MiB;
constexpr size_t WS_GATES = 593 * MiB;
constexpr size_t WS_H2U8 = WS_GATES + 192 * MiB;
constexpr size_t WS_Y8 = WS_H2U8 + 64 * MiB;
constexpr size_t WS_YA = WS_Y8 + 64 * MiB;
constexpr size_t WS_END = 977 * MiB;

constexpr int RING_BYTES = 131072;
constexpr int XOFF = RING_BYTES;
constexpr int X_ROWSS = XOFF;
constexpr int X_TAB = XOFF + 16384;
constexpr int X_BARST = X_TAB + 4096;
constexpr int LDS_BYTES = XOFF + 24576;
constexpr int CW_BAR = 4096;
constexpr size_t CTL_ZERO_BYTES = 65536;

struct Params {
    const float* in[27];
    float* out;
    unsigned char* ws;
    int ph_lo, ph_hi, item_lo, item_hi, dummy, pad_;
};

__device__ __forceinline__ unsigned cvt_pk_bf16(float lo, float hi) { unsigned r; asm volatile("v_cvt_pk_bf16_f32 %0, %1, %2" : "=v"(r) : "v"(lo), "v"(hi)); return r; }
__device__ __forceinline__ float bf2f(unsigned short h) { return __uint_as_float((unsigned)h << 16); }
__device__ __forceinline__ float wave_sum(float v) {
#pragma unroll
    for (int o = 1; o < 64; o <<= 1) v += __shfl_xor(v, o);
    return v;
}
__device__ __forceinline__ int lane_id() { int l; asm volatile("v_mbcnt_lo_u32_b32 %0, -1, 0\n\tv_mbcnt_hi_u32_b32 %0, -1, %0" : "=v"(l)); return l; }
__device__ __forceinline__ unsigned cvt4_fp8(float a, float b, float c, float d) { int p = __builtin_amdgcn_cvt_pk_fp8_f32(a, b, 0, false); p = __builtin_amdgcn_cvt_pk_fp8_f32(c, d, p, true); return (unsigned)p; }
#define LDS_WAIT() asm volatile("s_waitcnt lgkmcnt(0)" ::: "memory")
#define VM_WAIT() asm volatile("s_waitcnt vmcnt(0)" ::: "memory")


#define RLX_AGENT __ATOMIC_RELAXED, __HIP_MEMORY_SCOPE_AGENT
#define XB_TMO      128
#define XB_XCNT(j)  (256  + 64 * (j))
#define XB_XSUB(j)  (1280 + 64 * (j))
#define XB_XGEN(j)  (2304 + 64 * (j))
#define XB_TOP      3328
#define XB_TOPGEN   3392
#define XCD_BAR_WORDS 3456
#define XB_SPIN_CAP (1u << 20)
__device__ __forceinline__ unsigned xb_ld(unsigned* p)              { return __hip_atomic_load(p, __ATOMIC_RELAXED, __HIP_MEMORY_SCOPE_AGENT); }
__device__ __forceinline__ unsigned xb_add(unsigned* p, unsigned v) { return __hip_atomic_fetch_add(p, v, __ATOMIC_RELAXED, __HIP_MEMORY_SCOPE_AGENT); }
__device__ __forceinline__ unsigned xb_xcc_id() { return (unsigned)__builtin_amdgcn_s_getreg((3 << 11) | 20) & 0xFu; }
#define XB_SPIN(cond, bar) do { unsigned _sp = 0; while (cond) { __builtin_amdgcn_s_sleep(1); \
    if ((++_sp & 255u) == 0u) { if (xb_ld(&(bar)[XB_TMO])) break; if (_sp > XB_SPIN_CAP) { atomicAdd(&(bar)[XB_TMO], 1u); break; } } } } while (0)
struct XcdBarrier { unsigned* bar; unsigned x; volatile LAS unsigned* st; };
__device__ __forceinline__ XcdBarrier xcd_barrier_post(unsigned* bar, volatile LAS unsigned* st, bool t0) {
    XcdBarrier b; b.bar = bar; b.x = xb_xcc_id(); b.st = st;
    if (t0) (void)xb_add(&bar[XB_XCNT(b.x)], 1u);
    return b;
}
__device__ __forceinline__ void xcd_barrier_complete(unsigned* bar, unsigned x, unsigned& nloc, unsigned& nx) {
    const unsigned G = gridDim.x * gridDim.y * gridDim.z;
    unsigned sum, cnt, mine, sp = 0u;
    for (;;) {
        sum = 0u; cnt = 0u; mine = 0u;
#pragma unroll
        for (unsigned j = 0; j < 16; ++j) { const unsigned c = xb_ld(&bar[XB_XCNT(j)]); sum += c; cnt += (c > 0u) ? 1u : 0u; mine = (j == x) ? c : mine; }
        if (sum == G) break;
        __builtin_amdgcn_s_sleep(1);
        if ((++sp & 255u) == 0u) { if (xb_ld(&bar[XB_TMO])) break; if (sp > XB_SPIN_CAP) { atomicAdd(&bar[XB_TMO], 1u); break; } }
    }
    nloc = mine > 0u ? mine : 1u; nx = cnt > 0u ? cnt : 1u;
}
__device__ __forceinline__ void xcd_barrier(const XcdBarrier& b, bool t0) {
    asm volatile("s_waitcnt vmcnt(0)" ::: "memory");
    __syncthreads();
    if (t0) {
        unsigned* bar = b.bar;
        __builtin_amdgcn_s_waitcnt(0);
        unsigned nloc = b.st[0], nx = b.st[1];
        if (nloc == 0u) { xcd_barrier_complete(bar, b.x, nloc, nx); b.st[0] = nloc; b.st[1] = nx; }
        const unsigned old = xb_add(&bar[XB_XSUB(b.x)], 1u);
        const unsigned gen = old / nloc;
        if (old + 1u == (gen + 1u) * nloc) {
            __builtin_amdgcn_fence(__ATOMIC_RELEASE, "agent");
            asm volatile("s_waitcnt vmcnt(0)" ::: "memory");
            const unsigned og = xb_add(&bar[XB_TOP], 1u);
            const unsigned tg = og / nx;
            if (og + 1u == (tg + 1u) * nx) xb_add(&bar[XB_TOPGEN], 1u);
            else XB_SPIN(xb_ld(&bar[XB_TOPGEN]) == tg, bar);
            __builtin_amdgcn_fence(__ATOMIC_ACQUIRE, "agent");
            xb_add(&bar[XB_XGEN(b.x)], 1u);
            asm volatile("s_waitcnt vmcnt(0)" ::: "memory");
        } else {
            XB_SPIN(xb_ld(&bar[XB_XGEN(b.x)]) == gen, bar);
            __builtin_amdgcn_fence(__ATOMIC_ACQUIRE, "agent");
            asm volatile("s_waitcnt vmcnt(0)" ::: "memory");
        }
    }
    __syncthreads();
}
#define XB_FLAG_A (XCD_BAR_WORDS + 64)
__device__ __forceinline__ void flag_signal(unsigned* bar, int word, bool t0) {
    asm volatile("s_waitcnt vmcnt(0)" ::: "memory");
    __syncthreads();
    if (t0) { __builtin_amdgcn_fence(__ATOMIC_RELEASE, "agent"); asm volatile("s_waitcnt vmcnt(0)" ::: "memory"); (void)xb_add(&bar[word], 1u); }
}
__device__ __forceinline__ void flag_wait(unsigned* bar, int word, bool t0) {
    if (t0) { const unsigned G = gridDim.x; XB_SPIN(xb_ld(&bar[word]) < G, bar); __builtin_amdgcn_fence(__ATOMIC_ACQUIRE, "agent"); asm volatile("s_waitcnt vmcnt(0)" ::: "memory"); }
    __syncthreads();
}

namespace pg8 {
typedef int v4i_t __attribute__((ext_vector_type(4)));
typedef int v8i_t __attribute__((ext_vector_type(8)));
constexpr int BM = 256, BK = 64, HALF = 128, HTB = HALF * BK * 2, STAGE_BYTES = 8 * HTB;
__host__ __device__ __forceinline__ int lds_byte(int r, int c) { const int st = (r >> 4) * 2 + (c >> 5), rr = r & 15, cc = c & 31, ob = rr * 64 + cc * 2; return st * 1024 + (ob ^ (((ob >> 9) & 1) << 5)); }
__host__ __device__ __forceinline__ void stage_rc(int b, int& R, int& C) { const int st = b / 1024, sb = b % 1024, swz = sb ^ (((sb >> 9) & 1) << 5); R = (st >> 1) * 16 + swz / 64; C = (st & 1) * 32 + (swz % 64) / 2; }
__device__ __forceinline__ const char* uni_ptr64(const char* p) { const unsigned long u = (unsigned long)p;
    const unsigned lo = __builtin_amdgcn_readfirstlane((unsigned)u), hi = __builtin_amdgcn_readfirstlane((unsigned)(u >> 32)); return (const char*)(((unsigned long)hi << 32) | lo); }
__device__ __forceinline__ void glds16_s(const char* sbase, unsigned voff, unsigned lds_dst) { unsigned keep;
    asm volatile("s_mov_b32 %0, m0\n\ts_mov_b32 m0, %3\n\ts_nop 0\n\tglobal_load_lds_dwordx4 %1, %2\n\ts_mov_b32 m0, %0" : "=&s"(keep) : "v"(voff), "s"(sbase), "s"(lds_dst) : "memory"); }
__host__ __device__ __forceinline__ int perm32(int rho) { const int n = rho >> 4, i = rho & 15; return 8 * (i >> 2) + 4 * n + (i & 3); }

struct Unit { long aoff, boff; int gofs; int pm, pn, sub; };
struct Gemm { const char* A; const char* Bt; int lda, ldb, nt; const LAS int* gl; };

template <class Epi, class Sched, bool ALIGN_EPI, bool GATHER, bool FP8 = false, bool MIXED = false>
__device__ __forceinline__ void gemm_phase(LAS unsigned char* lds, const Gemm g, const Sched& S, Epi& E, int wid) {
    const int lane = lane_id(), tid = wid * 64 + lane, wr = wid >> 2, wc = wid & 3, fr = lane & 15, fq = lane >> 4;
    const int nt = g.nt;
    int Rr[2], Cb[2]; unsigned voffB[2], voffA[2][2];
#pragma unroll
    for (int i = 0; i < 2; ++i) { int R, C; stage_rc(tid * 16 + i * 8192, R, C); const int Rb = Epi::PERM ? ((R & ~31) + perm32(R & 31)) : R;
        Rr[i] = R; Cb[i] = C * 2; voffB[i] = (unsigned)(Rb * g.ldb + C * 2); }
    const size_t kstep = (size_t)(BK * 2);
    const size_t hstepB = (size_t)HALF * g.ldb;
    const unsigned ldsw = (unsigned)wid * 1024u;
    const unsigned lds_u = (unsigned)(unsigned long)(LAS unsigned char*)lds;

#define PG8_SETA(u) do { _Pragma("unroll") for (int _h = 0; _h < 2; ++_h) _Pragma("unroll") for (int _i = 0; _i < 2; ++_i) { const int _row = _h * HALF + Rr[_i]; \
        const int _src = GATHER ? g.gl[(u).gofs + _row] : _row; voffA[_h][_i] = (unsigned)_src * (unsigned)g.lda + (unsigned)Cb[_i]; } } while (0)
#define PG8_SA(b, h) (((b) * 2 + (h)) * HTB)
#define PG8_SB(b, h) ((4 + (b) * 2 + (h)) * HTB)
#define PG8_STAGE_A(bufoff, gbase, h) do { _Pragma("unroll") for (int _i = 0; _i < 2; ++_i) \
        glds16_s((const char*)(gbase), voffA[h][_i], lds_u + (unsigned)(bufoff) + ldsw + _i * 8192u); } while (0)
#define PG8_STAGE_B(bufoff, gbase) do { _Pragma("unroll") for (int _i = 0; _i < 2; ++_i) \
        glds16_s((const char*)(gbase), voffB[_i], lds_u + (unsigned)(bufoff) + ldsw + _i * 8192u); } while (0)
#define PG8_LDA(dst, b, h) do { if constexpr (FP8) { _Pragma("unroll") for (int m = 0; m < 4; ++m) { const LAS unsigned char* p_ = lds + PG8_SA(b, h) + aoff + m * 2048; \
            dst##8[m] = __builtin_shufflevector(*(const LAS v4i_t*)p_, *(const LAS v4i_t*)(p_ + 1024), 0, 1, 2, 3, 4, 5, 6, 7); } } \
        else { _Pragma("unroll") for (int m = 0; m < 4; ++m) _Pragma("unroll") for (int k = 0; k < 2; ++k) dst[m][k] = *(const LAS bf16x8*)(lds + PG8_SA(b, h) + aoff + m * 2048 + k * 1024); } } while (0)
#define PG8_LDB(dst, b, h) do { if constexpr (FP8) { _Pragma("unroll") for (int n = 0; n < 2; ++n) { const LAS unsigned char* p_ = lds + PG8_SB(b, h) + boff + n * 2048; \
            dst##8[n] = __builtin_shufflevector(*(const LAS v4i_t*)p_, *(const LAS v4i_t*)(p_ + 1024), 0, 1, 2, 3, 4, 5, 6, 7); } } \
        else { _Pragma("unroll") for (int n = 0; n < 2; ++n) _Pragma("unroll") for (int k = 0; k < 2; ++k) dst[n][k] = *(const LAS bf16x8*)(lds + PG8_SB(b, h) + boff + n * 2048 + k * 1024); } } while (0)
#define PG8_MMA(ai, bj, At, Bt) do { __builtin_amdgcn_s_setprio(1); if constexpr (F8U) { _Pragma("unroll") for (int m = 0; m < 4; ++m) _Pragma("unroll") for (int n = 0; n < 2; ++n) \
        acc[ai][bj][m][n] = __builtin_amdgcn_mfma_scale_f32_16x16x128_f8f6f4(Bt##8[n], At##8[m], acc[ai][bj][m][n], 0, 0, 0, 0, 0, 0); } \
        else if constexpr (FP8) { _Pragma("unroll") for (int m = 0; m < 4; ++m) _Pragma("unroll") for (int n = 0; n < 2; ++n) {   \
        acc[ai][bj][m][n] = __builtin_amdgcn_mfma_f32_16x16x32_bf16(__builtin_bit_cast(bf16x8, __builtin_shufflevector(Bt##8[n], Bt##8[n], 0, 1, 2, 3)), __builtin_bit_cast(bf16x8, __builtin_shufflevector(At##8[m], At##8[m], 0, 1, 2, 3)), acc[ai][bj][m][n], 0, 0, 0); \
        acc[ai][bj][m][n] = __builtin_amdgcn_mfma_f32_16x16x32_bf16(__builtin_bit_cast(bf16x8, __builtin_shufflevector(Bt##8[n], Bt##8[n], 4, 5, 6, 7)), __builtin_bit_cast(bf16x8, __builtin_shufflevector(At##8[m], At##8[m], 4, 5, 6, 7)), acc[ai][bj][m][n], 0, 0, 0); } } \
        else { _Pragma("unroll") for (int m = 0; m < 4; ++m) _Pragma("unroll") for (int n = 0; n < 2; ++n) _Pragma("unroll") for (int k = 0; k < 2; ++k) \
        acc[ai][bj][m][n] = __builtin_amdgcn_mfma_f32_16x16x32_bf16(Bt[n][k], At[m][k], acc[ai][bj][m][n], 0, 0, 0); } __builtin_amdgcn_s_setprio(0); } while (0)
#define PG8_WR_NOW() ({ int w_ = wid; asm volatile("" : "+s"(w_)); w_ >> 2; })
#define PG8_WAIT_V(n) asm volatile("s_waitcnt vmcnt(" #n ")" ::: "memory")
#define PG8_WAIT_L(n) asm volatile("s_waitcnt lgkmcnt(" #n ")" ::: "memory")
#define PG8_BAR __builtin_amdgcn_s_barrier()
#define PG8_SCHED __builtin_amdgcn_sched_barrier(0)
#define PG8_KLOOP(F8U_, NTU_) do { constexpr bool F8U = (F8U_); const int nt_u = (NTU_); \
_Pragma("nounroll") for (int t = 0; t < nt_u; t += 2) { \
            const bool last = (t == nt_u - 2); \
            const char* a1 = cA + (size_t)(t + 1) * kstep; \
            const char* a2 = last ? nA : cA + (size_t)(t + 2) * kstep; const char* b2 = last ? nB : cB + (size_t)(t + 2) * kstep; \
            const char* a3 = a2 + kstep; const char* b3 = b2 + kstep; \
            PG8_LDB(B0, 0, 0); PG8_LDB(B1, 0, 1); PG8_SCHED; PG8_LDA(At, 0, 0); PG8_STAGE_A(PG8_SA(1, 1), a1, 1); \
            if (GATHER) { if (last && has_next) PG8_SETA(nxt); } \
            PG8_WAIT_V(8); PG8_WAIT_L(0); PG8_BAR; PG8_MMA(0, 0, At, B0); PG8_MMA(0, 1, At, B1); PG8_BAR; PG8_SCHED; \
            PG8_LDA(At, 0, 1); PG8_STAGE_B(PG8_SB(0, 0), b2); PG8_STAGE_B(PG8_SB(0, 1), b2 + hstepB); PG8_STAGE_A(PG8_SA(0, 0), a2, 0); \
            PG8_WAIT_V(8); PG8_WAIT_L(0); PG8_BAR; PG8_MMA(1, 0, At, B0); PG8_MMA(1, 1, At, B1); PG8_BAR; PG8_SCHED; \
            PG8_LDB(B0, 1, 0); PG8_LDB(B1, 1, 1); PG8_SCHED; PG8_LDA(At, 1, 0); PG8_STAGE_A(PG8_SA(0, 1), a2, 1); \
            PG8_WAIT_V(8); PG8_WAIT_L(0); PG8_BAR; PG8_MMA(0, 0, At, B0); PG8_MMA(0, 1, At, B1); PG8_BAR; PG8_SCHED; \
            PG8_LDA(At, 1, 1); PG8_STAGE_B(PG8_SB(1, 0), b3); PG8_STAGE_B(PG8_SB(1, 1), b3 + hstepB); PG8_STAGE_A(PG8_SA(1, 0), a3, 0); \
            PG8_WAIT_V(8); PG8_WAIT_L(0); PG8_BAR; PG8_MMA(1, 0, At, B0); PG8_MMA(1, 1, At, B1); PG8_BAR; PG8_SCHED; \
        } } while (0)
    Unit cur, nxt; int ui = 0;
    if (!S.next(0, cur)) return;
    f32x4 acc[2][2][4][2];
    bf16x8 At[4][2], B0[2][2], B1[2][2];
    v8i_t At8[4], B08[2], B18[2];
    const char* cA = g.A + cur.aoff; const char* cB = g.Bt + cur.boff;
    PG8_SETA(cur);
    if (GATHER) PG8_WAIT_L(0);
    PG8_STAGE_B(PG8_SB(0, 0), cB); PG8_STAGE_B(PG8_SB(0, 1), cB + hstepB); PG8_STAGE_A(PG8_SA(0, 0), cA, 0); PG8_STAGE_A(PG8_SA(0, 1), cA, 1);
    if (PG8_WR_NOW() == 1) PG8_BAR;
    PG8_WAIT_V(2); PG8_BAR;
    PG8_STAGE_B(PG8_SB(1, 0), cB + kstep); PG8_STAGE_A(PG8_SA(1, 0), cA + kstep, 0); PG8_STAGE_B(PG8_SB(1, 1), cB + hstepB + kstep);
    PG8_WAIT_V(6); PG8_BAR;
#pragma unroll
    for (int a = 0; a < 2; ++a)
#pragma unroll
        for (int b = 0; b < 2; ++b)
#pragma unroll
            for (int m = 0; m < 4; ++m)
#pragma unroll
                for (int n = 0; n < 2; ++n) acc[a][b][m][n] = (f32x4){0.f, 0.f, 0.f, 0.f};
    const int aoff = lds_byte(wr * 64 + fr, fq * 8), boff = lds_byte(wc * 32 + fr, fq * 8);
#define PG8_UNIT(F8V_, NTV_) { \
        const bool has_next = S.next(ui + 1, nxt); \
        const char* nA = has_next ? g.A + nxt.aoff : cA; const char* nB = has_next ? g.Bt + nxt.boff : cB; \
        PG8_KLOOP(F8V_, NTV_); \
        if constexpr (ALIGN_EPI) { if (PG8_WR_NOW() == 0) PG8_BAR; } \
        const int le_ = lane_id(); \
        const bool keep = E(acc, cur, wr, wc, le_ & 15, le_ >> 4); \
        if (!has_next) break; \
        if (!keep) { \
            _Pragma("unroll") for (int a = 0; a < 2; ++a) _Pragma("unroll") for (int b = 0; b < 2; ++b) _Pragma("unroll") for (int m = 0; m < 4; ++m) _Pragma("unroll") for (int n = 0; n < 2; ++n) acc[a][b][m][n] = (f32x4){0.f, 0.f, 0.f, 0.f}; \
        } \
        cur = nxt; cA = nA; cB = nB; ++ui; \
        if constexpr (ALIGN_EPI) { if (PG8_WR_NOW() == 1) PG8_BAR; } }
    for (;;) {
        if constexpr (MIXED) { PG8_UNIT(false, 2 * nt) PG8_UNIT(true, nt) PG8_UNIT(true, nt) }
        else { PG8_UNIT(FP8, nt) }
    }
#undef PG8_UNIT
    PG8_WAIT_V(0);
    if constexpr (!ALIGN_EPI) { if (PG8_WR_NOW() == 0) PG8_BAR; }
    PG8_BAR;
#undef PG8_SETA
#undef PG8_SA
#undef PG8_SB
#undef PG8_STAGE_A
#undef PG8_STAGE_B
#undef PG8_LDA
#undef PG8_LDB
#undef PG8_MMA
#undef PG8_WAIT_V
#undef PG8_WR_NOW
#undef PG8_WAIT_L
#undef PG8_BAR
#undef PG8_SCHED
}
}

__device__ __forceinline__ int g64_col(int wc, int bj, int fq) { return 64 * wc + 32 * bj + 8 * fq; }
__host__ __device__ __forceinline__ int map_g64(int L) { const int l = L & 255; return (L & ~255) + 128 * ((l & 63) >> 5) + 32 * (l >> 6) + (l & 31); }
__host__ __device__ __forceinline__ int map_up(int n) { const int half = n >> 9, c = n & 511; return 256 * (c >> 7) + 128 * half + (c & 127); }

struct Frame {
    LAS unsigned char* lds;
    int wave, vcu, G;
    unsigned char* ws;
};

template <int MAP>
__device__ __forceinline__ int p0_rowmap(int Lbase, int n) {
    if (MAP == 0) return n;
    if (MAP == 2) return map_up(n);
    int L = Lbase + n;
    if (MAP == 3 && L >= 512) { const int a = L & 127; L = (L & ~127) + (a & 3) * 32 + (a >> 2); }
    return map_g64(L);
}
template <int MAP>
__device__ __forceinline__ void p0_transpose_item(const float* W, int ldw, int ncols, int K, bf16* WT, int Lbase, LAS float* scr, int item, int lane) {
    const int nblk = ncols / 32, kb = item / nblk, nb = item % nblk, k0 = 64 * kb, n0 = 32 * nb;
    const float* wp = W + (size_t)(k0 + (lane >> 5)) * ldw + n0 + (lane & 31);
#pragma unroll
    for (int hb = 0; hb < 2; ++hb) {
        float v[16];
#pragma unroll
        for (int i = 0; i < 16; ++i) v[i] = __builtin_nontemporal_load(wp + (size_t)(2 * (16 * hb + i)) * ldw);
        __builtin_amdgcn_sched_barrier(0);
#pragma unroll
        for (int i = 0; i < 16; ++i) scr[(2 * (16 * hb + i) + (lane >> 5)) * 33 + (lane & 31)] = v[i];
        __builtin_amdgcn_sched_barrier(0);
    }
    LDS_WAIT(); asm volatile("" ::: "memory");
    const int c = lane & 7;
#pragma unroll
    for (int j = 0; j < 4; ++j) { const int n = (lane >> 3) + 8 * j; const LAS float* s = scr + (8 * c) * 33 + n;
        u32x4 o; o.x = cvt_pk_bf16(s[0 * 33], s[1 * 33]); o.y = cvt_pk_bf16(s[2 * 33], s[3 * 33]); o.z = cvt_pk_bf16(s[4 * 33], s[5 * 33]); o.w = cvt_pk_bf16(s[6 * 33], s[7 * 33]);
        *(u32x4*)(WT + (size_t)p0_rowmap<MAP>(Lbase, n0 + n) * K + k0 + 8 * c) = o; }
    LDS_WAIT(); asm volatile("" ::: "memory");
}

template <int MAP>
__device__ __forceinline__ void p0_transpose_item8(const float* W, int ldw, int ncols, int K, unsigned char* WT8, int Lbase, float scale, LAS float* scr, int item, int lane) {
    const int nblk = ncols / 32, kb = item / nblk, nb = item % nblk, k0 = 64 * kb, n0 = 32 * nb;
    const float* wp = W + (size_t)(k0 + (lane >> 5)) * ldw + n0 + (lane & 31);
#pragma unroll
    for (int hb = 0; hb < 2; ++hb) {
        float v[16];
#pragma unroll
        for (int i = 0; i < 16; ++i) v[i] = __builtin_nontemporal_load(wp + (size_t)(2 * (16 * hb + i)) * ldw);
        __builtin_amdgcn_sched_barrier(0);
#pragma unroll
        for (int i = 0; i < 16; ++i) scr[(2 * (16 * hb + i) + (lane >> 5)) * 33 + (lane & 31)] = v[i] * scale;
        __builtin_amdgcn_sched_barrier(0);
    }
    LDS_WAIT(); asm volatile("" ::: "memory");
    const int c = lane & 3;
#pragma unroll
    for (int j = 0; j < 2; ++j) { const int n = (lane >> 2) + 16 * j; const LAS float* s = scr + (16 * c) * 33 + n;
        u32x4 o; o.x = cvt4_fp8(s[0 * 33], s[1 * 33], s[2 * 33], s[3 * 33]); o.y = cvt4_fp8(s[4 * 33], s[5 * 33], s[6 * 33], s[7 * 33]);
        o.z = cvt4_fp8(s[8 * 33], s[9 * 33], s[10 * 33], s[11 * 33]); o.w = cvt4_fp8(s[12 * 33], s[13 * 33], s[14 * 33], s[15 * 33]);
        *(u32x4*)(WT8 + (size_t)p0_rowmap<MAP>(Lbase, n0 + n) * K + k0 + 16 * c) = o; }
    LDS_WAIT(); asm volatile("" ::: "memory");
}

__device__ __forceinline__ void expert_weight_copies(Frame& F, const Params& P) {
    unsigned char* ws = F.ws; const int lane = lane_id(), wave = F.wave;
    const int cb = (int)blockIdx.x - 64, nb = F.G - 64;
    LAS float* scr = (LAS float*)(F.lds + 8192 + wave * 12288);
    constexpr int I_UP = 16 * 32, I_DN = 8 * 32;
    for (int it = cb * 8 + wave; it < NEXP * (I_UP + I_DN); it += nb * 8) {
        int r = it;
        if (r < NEXP * I_UP) { const int e = r / I_UP; p0_transpose_item8<2>(P.in[25] + (size_t)e * 1024 * 1024, 1024, 1024, DM, ws + WS_WUP + (size_t)e * 1024 * 1024, 0, 32.f, scr, r % I_UP, lane); continue; } r -= NEXP * I_UP;
        { const int e = r / I_DN; p0_transpose_item8<0>(P.in[26] + (size_t)e * 512 * 1024, 1024, 1024, 512, ws + WS_WDN + (size_t)e * 1024 * 512, 0, 16.f, scr, r % I_DN, lane); }
    }
    __syncthreads();
}

__device__ __forceinline__ void phase0(Frame& F, const Params& P) {
    const float* x = P.in[0]; const float* mem = P.in[1]; const int* pos = (const int*)P.in[2];
    const float* g_attn = P.in[3]; const float* w_in = P.in[4]; const float* fbias = P.in[11]; const float* g_mem = P.in[12];
    unsigned char* ws = F.ws;
    bf16* H = (bf16*)P.out;
    unsigned char* H8 = (unsigned char*)P.out + 128 * MiB;
    const int tid0 = F.wave * 64 + lane_id();
    const int lane = tid0 & 63, wave = F.wave;
    const int gw_ = F.vcu * 8 + wave, NGW = F.G * 8;
    {
        unsigned char* MEMN = ws + WS_MEMN;
        for (int m = gw_; m < NB * MEML; m += NGW) {
            const f32x4* xr = (const f32x4*)(mem + (size_t)m * DM) + lane; f32x4 v[4]; float ss = 0.f;
#pragma unroll
            for (int j = 0; j < 4; ++j) { v[j] = xr[64 * j]; ss += (v[j][0] * v[j][0] + v[j][1] * v[j][1]) + (v[j][2] * v[j][2] + v[j][3] * v[j][3]); }
            const float rstd = 1.0f / sqrtf(wave_sum(ss) * (1.f / DM) + EPS);
            unsigned* o4 = (unsigned*)(MEMN + (size_t)m * DM) + lane;
#pragma unroll
            for (int j = 0; j < 4; ++j) { const f32x4 hn = v[j] * rstd * *(const f32x4*)(g_mem + 256 * j + 4 * lane);
                o4[64 * j] = cvt4_fp8(hn[0], hn[1], hn[2], hn[3]); }
        }
    }
    {
        float* ROPE = (float*)(ws + WS_ROPE);
        const int gt = (blockIdx.x * 512 + tid0), NT_ = F.G * 512;
        for (int e = gt; e < T * 8; e += NT_) {
            const int t = e >> 3, i = e & 7;
            const double inv_rev = exp2(-(double)i * (18.931568569324174 / 8.0)) * 0.15915494309189535;
            double r = (double)pos[t] * inv_rev; r -= floor(r);
            const float rf = (float)r;
            ROPE[(size_t)t * 16 + i] = __builtin_amdgcn_cosf(rf); ROPE[(size_t)t * 16 + 8 + i] = __builtin_amdgcn_sinf(rf);
        }
    }
    {
        bf16* WR = (bf16*)(ws + WS_WR); const float* wrg = P.in[21]; const float* wre = P.in[23]; const float* gffn = P.in[20];
        const int gt = (blockIdx.x * 512 + tid0), NT_ = F.G * 512;
        for (int e = gt; e < 64 * 1024; e += NT_) { const int n = e >> 10, k = e & 1023;
            const float v = (n < 4 ? wrg[k * 4 + n] : (n < 36 ? wre[k * 32 + (n - 4)] : 0.f)) * gffn[k];
            WR[e] = (bf16)(cvt_pk_bf16(v, 0.f) & 0xffffu); }
    }
    {
        LAS float* scr = (LAS float*)(F.lds + 8192 + wave * 12288);
        constexpr int I_IN1 = 16 * 48, I_IN2 = 16 * 16, I_IN4 = 16 * 32, I_ING = 16 * 96, I_MKV = 16 * 32, I_WO = 8 * 32, I_WOUT = 16 * 32, I_UP = 16 * 32, I_DN = 8 * 32;
        constexpr int NITEMS = I_IN1 + I_IN4 + 2 * I_IN2 + I_ING + I_MKV + 3 * I_WO + I_WOUT + NEXP * I_UP + NEXP * I_DN;
        const int nitems = (F.G == 256) ? NITEMS - NEXP * (I_UP + I_DN) : NITEMS;
        for (int it = gw_; it < nitems; it += NGW) {
            int r = it;
            if (r < I_IN1) { p0_transpose_item<1>(w_in, IN_COLS, 1536, DM, (bf16*)(ws + WS_WIN), 0, scr, r, lane); continue; } r -= I_IN1;
            if (r < I_IN4) { p0_transpose_item8<1>(w_in + 1536, IN_COLS, 1024, DM, ws + WS_WQK8, 0, 32.f, scr, r, lane); continue; } r -= I_IN4;
            if (r < I_IN2) { p0_transpose_item8<1>(w_in + 2560, IN_COLS, 512, DM, ws + WS_W8, 0, 32.f, scr, r, lane); continue; } r -= I_IN2;
            if (r < I_IN2) { p0_transpose_item8<1>(w_in + 3080, IN_COLS, 512, DM, ws + WS_W8, 512, 32.f, scr, r, lane); continue; } r -= I_IN2;
            if (r < I_ING) { p0_transpose_item8<1>(w_in + 3592, IN_COLS, 3072, DM, ws + WS_W8, 1024, 32.f, scr, r, lane); continue; } r -= I_ING;
            if (r < I_MKV) { p0_transpose_item8<3>(P.in[13], 1024, 1024, DM, ws + WS_WMKV, 0, 32.f, scr, r, lane); continue; } r -= I_MKV;
            if (r < I_WO) { p0_transpose_item<1>(P.in[16], 1024, 1024, 512, (bf16*)(ws + WS_WO), 0, scr, r, lane); continue; } r -= I_WO;
            if (r < 2 * I_WO) { const int w = r / I_WO; p0_transpose_item8<1>(P.in[17 + w], 1024, 1024, 1024, ws + WS_WO + MiB + (size_t)w * 1024 * 1024, 0, 16.f, scr, r % I_WO, lane); continue; } r -= 2 * I_WO;
            if (r < I_WOUT) { p0_transpose_item<0>(P.in[19], 1024, 1024, DM, (bf16*)(ws + WS_WOUT), 0, scr, r, lane); continue; } r -= I_WOUT;
            if (r < NEXP * I_UP) { const int e = r / I_UP; p0_transpose_item8<2>(P.in[25] + (size_t)e * 1024 * 1024, 1024, 1024, DM, ws + WS_WUP + (size_t)e * 1024 * 1024, 0, 32.f, scr, r % I_UP, lane); continue; } r -= NEXP * I_UP;
            { const int e = r / I_DN; p0_transpose_item8<0>(P.in[26] + (size_t)e * 512 * 1024, 1024, 1024, 512, ws + WS_WDN + (size_t)e * 1024 * 512, 0, 16.f, scr, r % I_DN, lane); }
        }
    }
    __syncthreads();
    {
        float gw[4][4][8];
#pragma unroll
        for (int j = 0; j < 4; ++j)
#pragma unroll
            for (int e = 0; e < 4; ++e) { const int k = 256 * j + 4 * lane + e; const float gk = g_attn[k];
                const f32x4 w0 = *(const f32x4*)(w_in + (size_t)k * IN_COLS + 3072), w1 = *(const f32x4*)(w_in + (size_t)k * IN_COLS + 3076);
                gw[j][e][0] = gk * w0[0]; gw[j][e][1] = gk * w0[1]; gw[j][e][2] = gk * w0[2]; gw[j][e][3] = gk * w0[3];
                gw[j][e][4] = gk * w1[0]; gw[j][e][5] = gk * w1[1]; gw[j][e][6] = gk * w1[2]; gw[j][e][7] = gk * w1[3]; }
        f32x4 gv[4];
#pragma unroll
        for (int j = 0; j < 4; ++j) gv[j] = *(const f32x4*)(g_attn + 256 * j + 4 * lane);
        const float fb = fbias[lane & 7];
        LAS float* lf = (LAS float*)(F.lds);
        float* CUM = (float*)(ws + WS_CUM); float* CHTOT = (float*)(ws + WS_CHTOT);
        for (int ch = blockIdx.x; ch < T / 256; ch += F.G) {
            f32x4 vn[4];
            { const f32x4* xr0 = (const f32x4*)(x + (size_t)(ch * 256 + wave * 32) * DM) + lane;
#pragma unroll
              for (int j = 0; j < 4; ++j) vn[j] = __builtin_nontemporal_load(xr0 + 64 * j); }
            for (int rr = 0; rr < 32; ++rr) {
                const int row = ch * 256 + wave * 32 + rr;
                f32x4 v[4]; float ss = 0.f;
#pragma unroll
                for (int j = 0; j < 4; ++j) v[j] = vn[j];
                if (rr + 1 < 32) { const f32x4* xr1 = (const f32x4*)(x + (size_t)(row + 1) * DM) + lane;
#pragma unroll
                    for (int j = 0; j < 4; ++j) vn[j] = __builtin_nontemporal_load(xr1 + 64 * j); }
#pragma unroll
                for (int j = 0; j < 4; ++j) ss += (v[j][0] * v[j][0] + v[j][1] * v[j][1]) + (v[j][2] * v[j][2] + v[j][3] * v[j][3]);
                const float rstd = 1.0f / sqrtf(wave_sum(ss) * (1.f / DM) + EPS);
                float f[8];
#pragma unroll
                for (int h = 0; h < 8; ++h) f[h] = 0.f;
                unsigned long long* o8 = (unsigned long long*)(H + (size_t)row * DM) + lane;
#pragma unroll
                for (int j = 0; j < 4; ++j) {
#pragma unroll
                    for (int e = 0; e < 4; ++e) {
#pragma unroll
                        for (int h = 0; h < 8; ++h) f[h] += v[j][e] * gw[j][e][h]; }
                    const f32x4 hn = v[j] * rstd * gv[j];
                    o8[64 * j] = (unsigned long long)cvt_pk_bf16(hn[0], hn[1]) | ((unsigned long long)cvt_pk_bf16(hn[2], hn[3]) << 32);
                    ((unsigned*)(H8 + (size_t)row * DM))[64 * j + lane] = cvt4_fp8(hn[0], hn[1], hn[2], hn[3]);
                }
                float mine = 0.f;
#pragma unroll
                for (int h = 0; h < 8; ++h) { const float s = wave_sum(f[h]); if ((lane & 7) == h) mine = s; }
                if (lane < 8) { const float z = mine * rstd + fb; lf[(wave * 32 + rr) * 8 + lane] = -log1pf(__expf(-z)); }
            }
            __syncthreads();
            if (wave == 0) {
                const int seg = lane >> 3, h = lane & 7; float a = 0.f;
                for (int i = 0; i < 32; ++i) { a += lf[(seg * 32 + i) * 8 + h]; lf[(seg * 32 + i) * 8 + h] = a; }
                float incl = a, t;
                t = __shfl_up(incl, 8); if (seg >= 1) incl += t;
                t = __shfl_up(incl, 16); if (seg >= 2) incl += t;
                t = __shfl_up(incl, 32); if (seg >= 4) incl += t;
                const float excl = incl - a;
                const int b = ch >> 4, s0 = (ch & 15) * 256;
                float* dst = CUM + ((size_t)(b * 8 + h) * SEQ + s0 + seg * 32);
                for (int i = 0; i < 32; ++i) dst[i] = lf[(seg * 32 + i) * 8 + h] + excl;
                if (seg == 7) CHTOT[ch * 8 + h] = incl;
            }
            __syncthreads();
        }
    }
}

struct GridOrder {
    int nM, nN, nwg, G, c; long astep, bstep;
    __device__ void init(int nM_, int nN_, int G_, int c_, long astep_, long bstep_) { nM = nM_; nN = nN_; nwg = nM * nN; G = G_; c = c_; astep = astep_; bstep = bstep_; }
    __device__ bool next(int i, pg8::Unit& u) const {
        const long L = (long)i * G + c; if (L >= nwg) return false;
        int wgid = (int)L; { const int q = nwg / 8, r = nwg % 8, xcd = wgid % 8, off = wgid / 8; wgid = (xcd < r ? xcd * (q + 1) : r * (q + 1) + (xcd - r) * q) + off; }
        const int nig = 8 * nN, gid = wgid / nig, fm = gid * 8, gsz = (nM - fm) < 8 ? (nM - fm) : 8;
        u.pm = fm + ((wgid % nig) % gsz); u.pn = (wgid % nig) / gsz; u.aoff = (long)u.pm * astep; u.boff = (long)u.pn * bstep; u.gofs = 0; u.sub = 0; return true;
    }
};

struct EpiProj {
    static constexpr bool PERM = true;
    bf16* QB; bf16* KVB; bf16* GT; const float* rope; const float* g_dq; const float* g_dk; const float* g_fq; const float* g_fk; int fp8part;
    __device__ __forceinline__ bool operator()(f32x4 (&acc)[2][2][4][2], const pg8::Unit& u, int wr, int wc, int fr_in, int fq_in) const {
        int fr = fr_in, fq = fq_in; asm volatile("" : "+v"(fr), "+v"(fq));
        const int pn = fp8part ? u.pn + 10 : u.pn;
        int kind; const float* gptr = g_dq; bf16* base; int pitch, colt; float qs = 1.f; float ps = 1.f;
        if (pn < 2)       { kind = 0; gptr = g_dq; base = QB;  pitch = QP;  colt = pn * 256;               qs = 0.125f * LOG2E; }
        else if (pn < 4)  { kind = 0; gptr = g_dk; base = KVB; pitch = KVP; colt = (pn - 2) * 256; }
        else if (pn < 6)  { kind = 2;         base = KVB; pitch = KVP; colt = 512 + (pn - 4) * 256; }
        else if (pn < 8)  { kind = 1; gptr = g_fq; base = QB;  pitch = QP;  colt = 512 + (pn - 6) * 256;   qs = 0.125f * LOG2E; }
        else if (pn < 10) { kind = 1; gptr = g_fk; base = KVB; pitch = KVP; colt = 1024 + (pn - 8) * 256; }
        else if (pn < 12) { kind = 2;         base = KVB; pitch = KVP; colt = 1536 + (pn - 10) * 256; ps = fp8part ? (1.f / 32.f) : 1.f; }
        else if (pn < 14) { kind = 2;         base = QB;  pitch = QP;  colt = 1024 + (pn - 12) * 256; }
        else              { kind = 3;         base = GT;  pitch = GP;  colt = (pn - 14) * 256; }
        const int row0 = u.pm * 256 + wr * 64 + fr;
        f32x4 gn[2][2];
        if (kind < 2) {
#pragma unroll
            for (int bj = 0; bj < 2; ++bj)
#pragma unroll
                for (int n = 0; n < 2; ++n) gn[bj][n] = *(const f32x4*)(gptr + 32 * bj + 8 * fq + 4 * n);
        }
#pragma unroll
        for (int am = 0; am < 4; ++am) { const int ai = am >> 1, m0 = (am & 1) * 2;
            f32x4 rc[4][2], rsn[4][2];
            if (kind == 0) {
#pragma unroll
                for (int m = m0; m < m0 + 2; ++m)
#pragma unroll
                    for (int n = 0; n < 2; ++n) { const size_t rw = (size_t)(row0 + ai * 128 + m * 16) * 16; rc[m][n] = *(const f32x4*)(rope + rw + 4 * n); rsn[m][n] = *(const f32x4*)(rope + rw + 8 + 4 * n); }
            }
#pragma unroll
            for (int m = m0; m < m0 + 2; ++m) {
                const int row = row0 + ai * 128 + m * 16;
                f32x4 v[2][2];
#pragma unroll
                for (int bj = 0; bj < 2; ++bj)
#pragma unroll
                    for (int n = 0; n < 2; ++n) v[bj][n] = acc[ai][bj][m][n];
                if (kind < 2) {
                    float ss = 0.f;
#pragma unroll
                    for (int bj = 0; bj < 2; ++bj)
#pragma unroll
                        for (int n = 0; n < 2; ++n) ss += (v[bj][n][0] * v[bj][n][0] + v[bj][n][1] * v[bj][n][1]) + (v[bj][n][2] * v[bj][n][2] + v[bj][n][3] * v[bj][n][3]);
                    ss += __shfl_xor(ss, 16); ss += __shfl_xor(ss, 32);
                    const float r = qs / sqrtf(ss * (1.f / 64.f) + EPS);
#pragma unroll
                    for (int bj = 0; bj < 2; ++bj)
#pragma unroll
                        for (int n = 0; n < 2; ++n) v[bj][n] = v[bj][n] * gn[bj][n] * r;
                    if (kind == 0) {
#pragma unroll
                        for (int n = 0; n < 2; ++n) {
                            const f32x4 c = rc[m][n], s = rsn[m][n];
                            f32x4 o;
#pragma unroll
                            for (int j = 0; j < 4; ++j) { const float mine = v[0][n][j], oth = __shfl_xor(mine, 16);
                                o[j] = fq == 0 ? mine * c[j] - oth * s[j] : (fq == 1 ? mine * c[j] + oth * s[j] : mine); }
                            v[0][n] = o;
                        }
                    }
                } else if (kind == 3) {
                    const int t16 = ((wr * 4 + wc) * 64 + lane_id()) * 16;
                    u32x4 w;
#pragma unroll
                    for (int bj = 0; bj < 2; ++bj)
#pragma unroll
                        for (int n = 0; n < 2; ++n) { unsigned pk = 0;
#pragma unroll
                            for (int j = 0; j < 4; ++j) { const float sg = __builtin_amdgcn_rcpf(1.f + __expf(v[bj][n][j] * (-1.f / 32.f))); unsigned q = (unsigned)(sg * 255.f + 0.5f); q = q < 1u ? 1u : q; pk |= q << (8 * j); }
                            w[bj * 2 + n] = pk; }
                    *(u32x4*)((unsigned char*)GT + ((size_t)(u.pm * 12 + (pn - 14)) * 8 + (ai * 4 + m)) * 8192 + (unsigned)t16) = w;
                    continue;
                }
                if (kind == 2) {
#pragma unroll
                    for (int bj = 0; bj < 2; ++bj)
#pragma unroll
                        for (int n = 0; n < 2; ++n) v[bj][n] = v[bj][n] * ps; }
                bf16* rp = base + (size_t)row * pitch + colt + g64_col(wc, 0, fq);
#pragma unroll
                for (int bj = 0; bj < 2; ++bj) { u32x4 w; w.x = cvt_pk_bf16(v[bj][0][0], v[bj][0][1]); w.y = cvt_pk_bf16(v[bj][0][2], v[bj][0][3]); w.z = cvt_pk_bf16(v[bj][1][0], v[bj][1][1]); w.w = cvt_pk_bf16(v[bj][1][2], v[bj][1][3]);
                    *(u32x4*)(rp + 32 * bj) = w; }
            }
        }
        return false;
    }
};

struct EpiNorm {
    static constexpr bool PERM = true;
    bf16* QB; bf16* KVB; const float* g_fq; const float* g_fk;
    __device__ __forceinline__ bool operator()(f32x4 (&acc)[2][2][4][2], const pg8::Unit& u, int wr, int wc, int fr_in, int fq_in) const {
        int fr = fr_in, fq = fq_in; asm volatile("" : "+v"(fr), "+v"(fq));
        const bool isq = u.pn < 2;
        bf16* base = isq ? QB : KVB; const int pitch = isq ? QP : KVP; const int colt = isq ? 512 + u.pn * 256 : 1024 + (u.pn - 2) * 256;
        const float qs = isq ? 0.125f * LOG2E : 1.f; const float* gptr = isq ? g_fq : g_fk;
        const int row0 = u.pm * 256 + wr * 64 + fr;
#pragma unroll
        for (int ai = 0; ai < 2; ++ai)
#pragma unroll
            for (int m = 0; m < 4; ++m) {
                const int row = row0 + ai * 128 + m * 16; float ss = 0.f;
#pragma unroll
                for (int bj = 0; bj < 2; ++bj)
#pragma unroll
                    for (int n = 0; n < 2; ++n) { const f32x4 v = acc[ai][bj][m][n]; ss += (v[0] * v[0] + v[1] * v[1]) + (v[2] * v[2] + v[3] * v[3]); }
                ss += __shfl_xor(ss, 16); ss += __shfl_xor(ss, 32);
                const float r = qs / sqrtf(ss * (1.f / 64.f) + EPS * 1024.f);
                bf16* rp = base + (size_t)row * pitch + colt + g64_col(wc, 0, fq);
#pragma unroll
                for (int bj = 0; bj < 2; ++bj) { const f32x4 g0 = *(const f32x4*)(gptr + 32 * bj + 8 * fq), g1 = *(const f32x4*)(gptr + 32 * bj + 8 * fq + 4);
                    const f32x4 v0 = acc[ai][bj][m][0] * g0 * r, v1 = acc[ai][bj][m][1] * g1 * r;
                    u32x4 w; w.x = cvt_pk_bf16(v0[0], v0[1]); w.y = cvt_pk_bf16(v0[2], v0[3]); w.z = cvt_pk_bf16(v1[0], v1[1]); w.w = cvt_pk_bf16(v1[2], v1[3]);
                    *(u32x4*)(rp + 32 * bj) = w; }
            }
        return false;
    }
};

struct EpiGates {
    static constexpr bool PERM = true;
    unsigned char* GT;
    __device__ __forceinline__ bool operator()(f32x4 (&acc)[2][2][4][2], const pg8::Unit& u, int wr, int wc, int fr, int fq) const {
        const int t16 = ((wr * 4 + wc) * 64 + lane_id()) * 16;
#pragma unroll
        for (int ai = 0; ai < 2; ++ai)
#pragma unroll
            for (int m = 0; m < 4; ++m) { u32x4 w;
#pragma unroll
                for (int bj = 0; bj < 2; ++bj)
#pragma unroll
                    for (int n = 0; n < 2; ++n) { unsigned pk = 0;
#pragma unroll
                        for (int j = 0; j < 4; ++j) { const float sg = __builtin_amdgcn_rcpf(1.f + __expf(acc[ai][bj][m][n][j] * (-1.f / 32.f))); unsigned q = (unsigned)(sg * 255.f + 0.5f); q = q < 1u ? 1u : q; pk |= q << (8 * j); }
                        w[bj * 2 + n] = pk; }
                *(u32x4*)(GT + ((size_t)(u.pm * 12 + u.pn) * 8 + (ai * 4 + m)) * 8192 + (unsigned)t16) = w; }
        return false;
    }
};

struct EpiPlain {
    static constexpr bool PERM = true;
    bf16* O; int pitch; float sc;
    __device__ __forceinline__ bool operator()(f32x4 (&acc)[2][2][4][2], const pg8::Unit& u, int wr, int wc, int fr, int fq) const {
        const int row0 = u.pm * 256 + wr * 64 + fr;
#pragma unroll
        for (int ai = 0; ai < 2; ++ai)
#pragma unroll
            for (int m = 0; m < 4; ++m) { bf16* rp = O + (size_t)(row0 + ai * 128 + m * 16) * pitch + u.pn * 256 + g64_col(wc, 0, fq);
#pragma unroll
                for (int bj = 0; bj < 2; ++bj) { const f32x4 v0 = acc[ai][bj][m][0] * sc, v1 = acc[ai][bj][m][1] * sc; u32x4 w; w.x = cvt_pk_bf16(v0[0], v0[1]); w.y = cvt_pk_bf16(v0[2], v0[3]); w.z = cvt_pk_bf16(v1[0], v1[1]); w.w = cvt_pk_bf16(v1[2], v1[3]);
                    *(u32x4*)(rp + 32 * bj) = w; } }
        return false;
    }
};

struct EpiPlain8 {
    static constexpr bool PERM = true;
    bf16* O; int pitch;
    __device__ __forceinline__ bool operator()(f32x4 (&acc)[2][2][4][2], const pg8::Unit& u, int wr, int wc, int fr, int fq) const {
        const int row0 = u.pm * 256 + wr * 64 + fr;
#pragma unroll
        for (int ai = 0; ai < 2; ++ai)
#pragma unroll
            for (int m = 0; m < 4; ++m) { bf16* rp = O + (size_t)(row0 + ai * 128 + m * 16) * pitch + (u.pn & 7) * 256 + g64_col(wc, 0, fq);
#pragma unroll
                for (int bj = 0; bj < 2; ++bj) { const f32x4 v0 = acc[ai][bj][m][0], v1 = acc[ai][bj][m][1]; u32x4 w; w.x = cvt_pk_bf16(v0[0], v0[1]); w.y = cvt_pk_bf16(v0[2], v0[3]); w.z = cvt_pk_bf16(v1[0], v1[1]); w.w = cvt_pk_bf16(v1[2], v1[3]);
                    *(u32x4*)(rp + 32 * bj) = w; } }
        return false;
    }
};
__device__ __forceinline__ void phase1(Frame& F, const Params& P) {
    unsigned char* ws = F.ws;
    const int cpos = (F.G == 256 && (int)blockIdx.x >= 64) ? ((((int)blockIdx.x - 64) % 3) == 0 ? 0 : ((((int)blockIdx.x - 64) % 3) == 1 ? 1 : 2)) : -1;
    if (cpos == 0) expert_weight_copies(F, P);
    {
        pg8::Gemm g{(const char*)P.out, (const char*)(ws + WS_WIN), DM * 2, DM * 2, DM / 64, nullptr};
        GridOrder S; S.init(T / 256, N1 / 256, F.G, (int)blockIdx.x, 256L * DM * 2, 256L * DM * 2);
#ifdef EXP_P1PLAIN
#ifdef EXP_P1SAME
        if (P.dummy) { EpiPlain8 E{(bf16*)(ws + WS_KVBUF), 2048}; S.astep = 0; S.bstep = 0; pg8::gemm_phase<EpiPlain8, GridOrder, true, false>(F.lds, g, S, E, F.wave); return; }
#endif
        if (P.dummy) { EpiPlain8 E{(bf16*)(ws + WS_KVBUF), 2048}; pg8::gemm_phase<EpiPlain8, GridOrder, true, false>(F.lds, g, S, E, F.wave); return; }
#endif
        EpiProj E{(bf16*)(ws + WS_QBUF), (bf16*)(ws + WS_KVBUF), (bf16*)(ws + WS_GATES), (const float*)(ws + WS_ROPE), P.in[5], P.in[6], P.in[9], P.in[10], 0};
        pg8::gemm_phase<EpiProj, GridOrder, true, false>(F.lds, g, S, E, F.wave);
    }
    if (cpos == 1) expert_weight_copies(F, P);
    {
        pg8::Gemm g{(const char*)P.out + 128 * MiB, (const char*)(ws + WS_WQK8), DM, DM, DM / 128, nullptr};
        GridOrder S; S.init(T / 256, 4, F.G, (int)blockIdx.x, 256L * DM, 256L * DM);
        EpiNorm E{(bf16*)(ws + WS_QBUF), (bf16*)(ws + WS_KVBUF), P.in[9], P.in[10]};
        pg8::gemm_phase<EpiNorm, GridOrder, true, false, true>(F.lds, g, S, E, F.wave);
    }
    if (cpos == 2) expert_weight_copies(F, P);
    {
        pg8::Gemm g{(const char*)P.out + 128 * MiB, (const char*)(ws + WS_W8), DM, DM, DM / 128, nullptr};
        GridOrder S; S.init(T / 256, 16, F.G, (int)blockIdx.x, 256L * DM, 256L * DM);
        EpiProj E{(bf16*)(ws + WS_QBUF), (bf16*)(ws + WS_KVBUF), (bf16*)(ws + WS_GATES), (const float*)(ws + WS_ROPE), P.in[5], P.in[6], P.in[9], P.in[10], 1};
        pg8::gemm_phase<EpiProj, GridOrder, true, false, true>(F.lds, g, S, E, F.wave);
    }
    {
        pg8::Gemm g{(const char*)(ws + WS_MEMN), (const char*)(ws + WS_WMKV), DM, DM, DM / 128, nullptr};
        GridOrder S; S.init(NB * MEML / 256, 4, F.G, (int)blockIdx.x, 256L * DM, 256L * DM);
        EpiPlain E{(bf16*)(ws + WS_MEMKV), DM, 1.f / 32.f};
        pg8::gemm_phase<EpiPlain, GridOrder, true, false, true>(F.lds, g, S, E, F.wave);
    }
}

namespace sa {
__device__ __forceinline__ int crow(int r, int hi) { return (r & 3) + 8 * (r >> 2) + 4 * hi; }
constexpr int L_K = 0, L_V = 32768, L_KEY = 65536, L_WSF = 81920, L_PFX = 81920 + 2048;
typedef short v4i16_t __attribute__((ext_vector_type(4)));
__device__ __forceinline__ s16x4 vtr(const LAS unsigned char* p) { return __builtin_bit_cast(s16x4, __builtin_amdgcn_ds_read_tr16_b64_v4i16((LAS v4i16_t*)p)); }

template <int DQK, int DV, int KEYMODE>
__device__ __forceinline__ void unit(const bf16x8* qr, const bf16* Kg, long kpitch, const bf16* Vg, long vpitch, bf16* Og, long opitch,
                                     int NT, int band0, LAS unsigned char* lds, int wid) {
    const int lane = lane_id(), tid = wid * 64 + lane;
    constexpr int NKL = DQK / 64, NVL = DV / 64, KSLOT = 64 * DQK * 2, VSLOT = 64 * DV * 2, ND = DV / 32, NKS = DQK / 16;
    const int r32 = lane & 31, hi = lane >> 5;
    LAS float* wsf = (LAS float*)(lds + L_WSF) + wid * 64;
    const LAS float* keyarr = (const LAS float*)(lds + L_KEY);
    u32x4 kreg[NKL], vreg[NVL];
    const bf16* ksrc = Kg + (long)lane * kpitch + wid * 8;
    const bf16* vsrc = Vg + (long)(16 * (wid & 3) + (lane >> 2)) * vpitch + (wid >> 2) * 32 + (lane & 3) * 8;
#define SA_LOAD(t) do { _Pragma("unroll") for (int c = 0; c < NKL; ++c) kreg[c] = *(const u32x4*)(ksrc + (long)(t) * 64 * kpitch + c * 64); \
                        _Pragma("unroll") for (int c = 0; c < NVL; ++c) vreg[c] = *(const u32x4*)(vsrc + (long)(t) * 64 * vpitch + c * 64); } while (0)
#define SA_WRITE(s) do { _Pragma("unroll") for (int c = 0; c < NKL; ++c) *(LAS u32x4*)(lds + L_K + (s) * KSLOT + (wid + 8 * c) * 1024 + lane * 16) = kreg[c]; \
                         _Pragma("unroll") for (int c = 0; c < NVL; ++c) *(LAS u32x4*)(lds + L_V + (s) * VSLOT + ((wid >> 2) + 2 * c) * 4096 + (wid & 3) * 1024 + lane * 16) = vreg[c]; } while (0)
    float m_run = -INFINITY, l_run = 0.f;
    f32x16 o[ND];
#pragma unroll
    for (int d = 0; d < ND; ++d) o[d] = f32x16{};
    const int vb0 = ((lane >> 4) & 1) * 32 + (lane & 3) * 8 + (4 * hi + ((lane & 15) >> 2)) * 64;
    SA_LOAD(0); SA_WRITE(0);
    __syncthreads();
    for (int t = 0; t < NT; ++t) {
        const int s = t & 1;
        if (t + 1 < NT) SA_LOAD(t + 1);
        const int jb = t - band0;
        const bool active = (jb < 0) || (64 * jb <= 32 * wid + 31);
        if (active) {
            const LAS unsigned char* kb = lds + L_K + s * KSLOT + hi * 1024 + r32 * 16;
            f32x16 p0 = f32x16{}, p1 = f32x16{};
#pragma unroll
            for (int d0 = 0; d0 < NKS; ++d0) {
                const bf16x8 b0 = *(const LAS bf16x8*)(kb + d0 * 2048), b1 = *(const LAS bf16x8*)(kb + d0 * 2048 + 512);
                p0 = __builtin_amdgcn_mfma_f32_32x32x16_bf16(b0, qr[d0], p0, 0, 0, 0);
                p1 = __builtin_amdgcn_mfma_f32_32x32x16_bf16(b1, qr[d0], p1, 0, 0, 0);
            }
            if (KEYMODE != 0) {
#pragma unroll
                for (int r = 0; r < 16; ++r) { const float k0 = keyarr[64 * t + crow(r, hi)], k1 = keyarr[64 * t + 32 + crow(r, hi)];
                    if (KEYMODE == 1) { p0[r] -= k0; p1[r] -= k1; } else { p0[r] *= k0; p1[r] *= k1; } }
            }
            if (jb >= 0) {
                const int qrel = 32 * wid + r32, kb0 = 64 * jb + 4 * hi;
#pragma unroll
                for (int r = 0; r < 16; ++r) { const int kv = kb0 + (r & 3) + 8 * (r >> 2); if (kv > qrel) p0[r] = -INFINITY; if (kv + 32 > qrel) p1[r] = -INFINITY; }
            }
            float rm = fmaxf(p0[0], p1[0]);
#pragma unroll
            for (int r = 1; r < 16; ++r) rm = fmaxf(rm, fmaxf(p0[r], p1[r]));
            rm = fmaxf(rm, __shfl_xor(rm, 32));
            const float m_new = fmaxf(m_run, rm);
            const float alpha = __builtin_amdgcn_exp2f(m_run - m_new);
            m_run = m_new;
            float rs = 0.f;
#pragma unroll
            for (int r = 0; r < 16; ++r) { p0[r] = __builtin_amdgcn_exp2f(p0[r] - m_new); p1[r] = __builtin_amdgcn_exp2f(p1[r] - m_new); rs += p0[r] + p1[r]; }
            l_run = l_run * alpha + rs;
            if (__any(alpha != 1.f)) {
                if (hi == 0) wsf[r32] = alpha;
                LDS_WAIT();
#pragma unroll
                for (int r = 0; r < 16; ++r) { const float a = wsf[crow(r, hi)];
#pragma unroll
                    for (int d = 0; d < ND; ++d) o[d][r] *= a; }
            }
            u32x4 pw[4];
#pragma unroll
            for (int e = 0; e < 4; ++e) { pw[0][e] = cvt_pk_bf16(p0[2 * e], p0[2 * e + 1]); pw[1][e] = cvt_pk_bf16(p0[8 + 2 * e], p0[9 + 2 * e]);
                                          pw[2][e] = cvt_pk_bf16(p1[2 * e], p1[2 * e + 1]); pw[3][e] = cvt_pk_bf16(p1[8 + 2 * e], p1[9 + 2 * e]); }
            const LAS unsigned char* vb = lds + L_V + s * VSLOT + vb0;
#pragma unroll
            for (int d = 0; d < ND; ++d)
#pragma unroll
                for (int ks = 0; ks < 4; ++ks) {
                    const s16x4 lo = vtr(vb + d * 4096 + ks * 1024), hh = vtr(vb + d * 4096 + ks * 1024 + 512);
                    const bf16x8 vf = (bf16x8){lo[0], lo[1], lo[2], lo[3], hh[0], hh[1], hh[2], hh[3]};
                    o[d] = __builtin_amdgcn_mfma_f32_32x32x16_bf16(__builtin_bit_cast(bf16x8, pw[ks]), vf, o[d], 0, 0, 0);
                }
        }
        if (t + 1 < NT) SA_WRITE(s ^ 1);
        __syncthreads();
    }
    l_run += __shfl_xor(l_run, 32);
    if (hi == 0) wsf[32 + r32] = l_run;
    LDS_WAIT();
    LAS unsigned short* stg = (LAS unsigned short*)(lds + wid * (32 * DV * 2));
#pragma unroll
    for (int r = 0; r < 16; ++r) { const float rl = 1.0f / wsf[32 + crow(r, hi)]; const int orow = crow(r, hi);
#pragma unroll
        for (int d = 0; d < ND; ++d) stg[orow * DV + d * 32 + r32] = (unsigned short)(cvt_pk_bf16(o[d][r] * rl, 0.f) & 0xffffu); }
    LDS_WAIT();
    constexpr int CH = DV / 8;
#pragma unroll
    for (int i = 0; i < 32 * CH / 64; ++i) { const int piece = i * 64 + lane, row = piece / CH, ch = piece % CH;
        const u32x4 v = *(const LAS u32x4*)(stg + row * DV + ch * 8);
        *(u32x4*)(Og + (long)(wid * 32 + row) * opitch + ch * 8) = v; }
    __syncthreads();
#undef SA_LOAD
#undef SA_WRITE
}
constexpr int R_KEY = XOFF, R_WSF = XOFF + 1024;
__device__ __forceinline__ void fill_kv_res(const bf16* Kg, const bf16* Vg, long pitch, LAS unsigned char* lds, int wid) {
    const int lane = lane_id();
    const bf16* ksrc = Kg + (long)lane * pitch + wid * 8;
    const bf16* vsrc = Vg + (long)(16 * (wid & 3) + (lane >> 2)) * pitch + (wid >> 2) * 32 + (lane & 3) * 8;
    u32x4 kr[4][2], vr[4][2];
#pragma unroll
    for (int t = 0; t < 4; ++t)
#pragma unroll
        for (int c = 0; c < 2; ++c) { kr[t][c] = *(const u32x4*)(ksrc + (long)t * 64 * pitch + c * 64); vr[t][c] = *(const u32x4*)(vsrc + (long)t * 64 * pitch + c * 64); }
#pragma unroll
    for (int t = 0; t < 4; ++t)
#pragma unroll
        for (int c = 0; c < 2; ++c) { *(LAS u32x4*)(lds + t * 16384 + (wid + 8 * c) * 1024 + lane * 16) = kr[t][c];
            *(LAS u32x4*)(lds + 65536 + t * 16384 + ((wid >> 2) + 2 * c) * 4096 + (wid & 3) * 1024 + lane * 16) = vr[t][c]; }
}
__device__ __forceinline__ void unit_res(const bf16x8* qr, unsigned char* Og, long opitch, LAS unsigned char* lds, int wid) {
    const int lane = lane_id(), r32 = lane & 31, hi = lane >> 5;
    LAS float* wsf = (LAS float*)(lds + R_WSF) + wid * 64;
    const LAS float* keyarr = (const LAS float*)(lds + R_KEY);
    float m_run = -INFINITY, l_run = 0.f;
    f32x16 o[4];
#pragma unroll
    for (int d = 0; d < 4; ++d) o[d] = f32x16{};
    const int vb0 = ((lane >> 4) & 1) * 32 + (lane & 3) * 8 + (4 * hi + ((lane & 15) >> 2)) * 64;
#pragma unroll 1
    for (int t = 0; t < 4; ++t) {
        const LAS unsigned char* kb = lds + t * 16384 + hi * 1024 + r32 * 16;
        f32x16 p0 = f32x16{}, p1 = f32x16{};
#pragma unroll
        for (int d0 = 0; d0 < 8; ++d0) {
            const bf16x8 b0 = *(const LAS bf16x8*)(kb + d0 * 2048), b1 = *(const LAS bf16x8*)(kb + d0 * 2048 + 512);
            p0 = __builtin_amdgcn_mfma_f32_32x32x16_bf16(b0, qr[d0], p0, 0, 0, 0);
            p1 = __builtin_amdgcn_mfma_f32_32x32x16_bf16(b1, qr[d0], p1, 0, 0, 0);
        }
#pragma unroll
        for (int r = 0; r < 16; ++r) { p0[r] *= keyarr[64 * t + crow(r, hi)]; p1[r] *= keyarr[64 * t + 32 + crow(r, hi)]; }
        float rm = fmaxf(p0[0], p1[0]);
#pragma unroll
        for (int r = 1; r < 16; ++r) rm = fmaxf(rm, fmaxf(p0[r], p1[r]));
        rm = fmaxf(rm, __shfl_xor(rm, 32));
        const float m_new = fmaxf(m_run, rm);
        const float alpha = __builtin_amdgcn_exp2f(m_run - m_new);
        m_run = m_new;
        float rs = 0.f;
#pragma unroll
        for (int r = 0; r < 16; ++r) { p0[r] = __builtin_amdgcn_exp2f(p0[r] - m_new); p1[r] = __builtin_amdgcn_exp2f(p1[r] - m_new); rs += p0[r] + p1[r]; }
        l_run = l_run * alpha + rs;
        if (__any(alpha != 1.f)) {
            if (hi == 0) wsf[r32] = alpha;
            LDS_WAIT();
#pragma unroll
            for (int r = 0; r < 16; ++r) { const float a = wsf[crow(r, hi)];
#pragma unroll
                for (int d = 0; d < 4; ++d) o[d][r] *= a; }
        }
        u32x4 pw[4];
#pragma unroll
        for (int e = 0; e < 4; ++e) { pw[0][e] = cvt_pk_bf16(p0[2 * e], p0[2 * e + 1]); pw[1][e] = cvt_pk_bf16(p0[8 + 2 * e], p0[9 + 2 * e]);
                                      pw[2][e] = cvt_pk_bf16(p1[2 * e], p1[2 * e + 1]); pw[3][e] = cvt_pk_bf16(p1[8 + 2 * e], p1[9 + 2 * e]); }
        const LAS unsigned char* vb = lds + 65536 + t * 16384 + vb0;
#pragma unroll
        for (int d = 0; d < 4; ++d)
#pragma unroll
            for (int ks = 0; ks < 4; ++ks) {
                const s16x4 lo = vtr(vb + d * 4096 + ks * 1024), hh = vtr(vb + d * 4096 + ks * 1024 + 512);
                const bf16x8 vf = (bf16x8){lo[0], lo[1], lo[2], lo[3], hh[0], hh[1], hh[2], hh[3]};
                o[d] = __builtin_amdgcn_mfma_f32_32x32x16_bf16(__builtin_bit_cast(bf16x8, pw[ks]), vf, o[d], 0, 0, 0);
            }
    }
    l_run += __shfl_xor(l_run, 32);
    if (hi == 0) wsf[32 + r32] = l_run;
    LDS_WAIT();
#pragma unroll
    for (int r = 0; r < 16; ++r) { const float rl = 8.0f / wsf[32 + crow(r, hi)];
        *(unsigned*)(Og + (long)(wid * 32 + crow(r, hi)) * opitch + 4 * r32) = cvt4_fp8(o[0][r] * rl, o[1][r] * rl, o[2][r] * rl, o[3][r] * rl); }
}
}

namespace ta {
constexpr int NW=8,QBLK=32,QB=QBLK*NW,KVBLK=64;
__device__ __forceinline__ void zero16(f32x16&x){
  #pragma unroll
  for(int r=0;r<16;++r){float z;asm volatile("v_mov_b32 %0, 0":"=v"(z));x[r]=z;}
}
__device__ __forceinline__ int crow(int r,int hi){return (r&3)+8*(r>>2)+4*hi;}
#define SBAR() __builtin_amdgcn_sched_barrier(0)
__device__ __forceinline__ void cmask(f32x16&p0,f32x16&p1,int jb,int qrel,int hi){
  const float NEG=-INFINITY; int kb=64*jb+4*hi;
  #pragma unroll
  for(int r=0;r<16;++r){int kv=kb+(r&3)+8*(r>>2); if(kv>qrel)p0[r]=NEG; if(kv+32>qrel)p1[r]=NEG;}
}

constexpr int NSLOT=3, SLOTB=8192;
constexpr int LDS_K=0, LDS_V=NSLOT*SLOTB, LDS_WS=2*NSLOT*SLOTB, LDS_OST=LDS_WS+NW*64*4, LDS_CK=LDS_OST+NW*4096, LDS_PFX=LDS_CK+16384, LDS_Q=LDS_PFX+64, LDS_BYTES=LDS_Q+NW*4096;
__device__ __forceinline__ void glds16(const void*gsrc,unsigned lds_dst){unsigned keep;
  asm volatile("s_mov_b32 %0, m0\n\ts_mov_b32 m0, %2\n\ts_nop 0\n\tglobal_load_lds_dwordx4 %1, off\n\ts_mov_b32 m0, %0":"=&s"(keep):"v"(gsrc),"s"(lds_dst):"memory");}
__device__ __forceinline__ float max3f(float a,float b,float c){float r;asm("v_max3_f32 %0, %1, %2, %3":"=v"(r):"v"(a),"v"(b),"v"(c));return r;}
__device__ __forceinline__ float max2f(float a,float b){float r;asm("v_max_f32_e32 %0, %1, %2":"=v"(r):"v"(a),"v"(b));return r;}
__device__ __forceinline__ float fadd_s(float a,float b){float r;asm("v_add_f32_e32 %0, %1, %2":"=v"(r):"v"(a),"v"(b));return r;}
__device__ __forceinline__ float fsub_s(float a,float b){float r;asm("v_sub_f32_e32 %0, %1, %2":"=v"(r):"v"(a),"v"(b));return r;}
typedef float f32x2_t __attribute__((ext_vector_type(2))); typedef __bf16 bf16x2_t __attribute__((ext_vector_type(2)));
__device__ __forceinline__ unsigned cvtpk_s(float lo,float hi){f32x2_t v={lo,hi};bf16x2_t b=__builtin_convertvector(v,bf16x2_t);return __builtin_bit_cast(unsigned,b);}
#define WAIT_BAR(N) asm volatile("s_waitcnt vmcnt(" #N ") lgkmcnt(0)\n\ts_barrier":::"memory")

__device__ __forceinline__ void qkt(f32x16&p0,f32x16&p1,const char*Kslot,const bf16x8*qr,const f32x16&c0,const f32x16&c1,int r32,int hi){
  const char*kb=Kslot+hi*1024+r32*16;
  #pragma unroll
  for(int d0=0;d0<4;++d0){
    const bf16x8 b0=*reinterpret_cast<const bf16x8*>(kb+d0*2048);
    const bf16x8 b1=*reinterpret_cast<const bf16x8*>(kb+d0*2048+512);
    if(d0==0){p0=__builtin_amdgcn_mfma_f32_32x32x16_bf16(b0,qr[0],c0,0,0,0);p1=__builtin_amdgcn_mfma_f32_32x32x16_bf16(b1,qr[0],c1,0,0,0);}
    else{p0=__builtin_amdgcn_mfma_f32_32x32x16_bf16(b0,qr[d0],p0,0,0,0);p1=__builtin_amdgcn_mfma_f32_32x32x16_bf16(b1,qr[d0],p1,0,0,0);}}
}
__device__ __forceinline__ void qkt0(f32x16&p0,f32x16&p1,const char*Kslot,const bf16x8*qr,int r32,int hi){
  const char*kb=Kslot+hi*1024+r32*16;
  #pragma unroll
  for(int d0=0;d0<4;++d0){
    const bf16x8 b0=*reinterpret_cast<const bf16x8*>(kb+d0*2048);
    const bf16x8 b1=*reinterpret_cast<const bf16x8*>(kb+d0*2048+512);
    if(d0==0){p0=__builtin_amdgcn_mfma_f32_32x32x16_bf16(b0,qr[0],(f32x16){0.f,0.f,0.f,0.f,0.f,0.f,0.f,0.f,0.f,0.f,0.f,0.f,0.f,0.f,0.f,0.f},0,0,0);p1=__builtin_amdgcn_mfma_f32_32x32x16_bf16(b1,qr[0],(f32x16){0.f,0.f,0.f,0.f,0.f,0.f,0.f,0.f,0.f,0.f,0.f,0.f,0.f,0.f,0.f,0.f},0,0,0);}
    else{p0=__builtin_amdgcn_mfma_f32_32x32x16_bf16(b0,qr[d0],p0,0,0,0);p1=__builtin_amdgcn_mfma_f32_32x32x16_bf16(b1,qr[d0],p1,0,0,0);}}
}
typedef __attribute__((address_space(3))) const char* lds_cptr;
typedef short v4i16_t __attribute__((ext_vector_type(4)));
__device__ __forceinline__ void kload8(bf16x8*kf,lds_cptr kp){
  kf[0]=*(const __attribute__((address_space(3))) bf16x8*)(kp);      kf[1]=*(const __attribute__((address_space(3))) bf16x8*)(kp+512);
  kf[2]=*(const __attribute__((address_space(3))) bf16x8*)(kp+2048); kf[3]=*(const __attribute__((address_space(3))) bf16x8*)(kp+2560);
  kf[4]=*(const __attribute__((address_space(3))) bf16x8*)(kp+4096); kf[5]=*(const __attribute__((address_space(3))) bf16x8*)(kp+4608);
  kf[6]=*(const __attribute__((address_space(3))) bf16x8*)(kp+6144); kf[7]=*(const __attribute__((address_space(3))) bf16x8*)(kp+6656);
}
__device__ __forceinline__ void kload2(bf16x8*kf,lds_cptr kp,int j){ kf[2*j]=*(const __attribute__((address_space(3))) bf16x8*)(kp+j*2048); kf[2*j+1]=*(const __attribute__((address_space(3))) bf16x8*)(kp+j*2048+512); }
__device__ __forceinline__ s16x4 vtr(lds_cptr p){ return __builtin_bit_cast(s16x4,__builtin_amdgcn_ds_read_tr16_b64_v4i16((__attribute__((address_space(3))) v4i16_t*)p)); }
__device__ __forceinline__ float rowmax(const f32x16&p0,const f32x16&p1){
  float a=max3f(p0[0],p0[1],p1[0]),b=max3f(p0[2],p0[3],p1[1]);a=max3f(a,p1[2],p1[3]);
  #pragma unroll
  for(int r=4;r<16;r+=4){a=max3f(a,p0[r],p0[r+1]);b=max3f(b,p0[r+2],p0[r+3]);a=max3f(a,p1[r],p1[r+1]);b=max3f(b,p1[r+2],p1[r+3]);}
  const float m=max2f(a,b);
  auto rr=__builtin_amdgcn_permlane32_swap(__float_as_uint(m),__float_as_uint(m),false,false);
  return max2f(__uint_as_float(rr[0]),__uint_as_float(rr[1]));
}
__device__ __forceinline__ void pv(f32x16*o,int vb,bf16x8 pa0,bf16x8 pa1,bf16x8 pa2,bf16x8 pa3){
  #pragma unroll
  for(int d0=0;d0<2;++d0){s16x4 lo[4],hi[4];
    #pragma unroll
    for(int ks=0;ks<4;++ks){
      asm volatile("ds_read_b64_tr_b16 %0,%1 offset:%c2":"=&v"(lo[ks]):"v"(vb),"i"(d0*4096+ks*1024):"memory");
      asm volatile("ds_read_b64_tr_b16 %0,%1 offset:%c2":"=&v"(hi[ks]):"v"(vb),"i"(d0*4096+ks*1024+512):"memory");}
    asm volatile("s_waitcnt lgkmcnt(0)":::"memory");SBAR();
    #define PK(k) (bf16x8){lo[k][0],lo[k][1],lo[k][2],lo[k][3],hi[k][0],hi[k][1],hi[k][2],hi[k][3]}
    o[d0]=__builtin_amdgcn_mfma_f32_32x32x16_bf16(pa0,PK(0),o[d0],0,0,0);
    o[d0]=__builtin_amdgcn_mfma_f32_32x32x16_bf16(pa1,PK(1),o[d0],0,0,0);
    o[d0]=__builtin_amdgcn_mfma_f32_32x32x16_bf16(pa2,PK(2),o[d0],0,0,0);
    o[d0]=__builtin_amdgcn_mfma_f32_32x32x16_bf16(pa3,PK(3),o[d0],0,0,0);
    #undef PK
  }
}

#ifndef ATTN_STORE16
#define ATTN_STORE16(p,v) (*(u32x4*)(p)=(v))
#endif
template<int THRL,int QPI,int KPI,int OPI,bool BIAS,bool OUT8=false> __device__ __forceinline__ void attn_unit(int qb,const bf16*Qu,const bf16*__restrict__ Kh,const bf16*__restrict__ Vh,bf16*Ou,char*shm,int wid_in){
  int wid=wid_in; asm volatile("":"+s"(wid));
  const int lane=lane_id(),r32=lane&31,hi=lane>>5;
  const int q0=qb*QB;
  const bf16*Qw=Qu+(long)(wid*QBLK)*QPI;
  const unsigned lds0=(unsigned)(uintptr_t)shm;
  float*wsf=(float*)(shm+LDS_WS)+wid*64;
  const bf16*ksrc=Kh+(long)lane*KPI+wid*8;
  const bf16*vsrc=Vh+(long)(16*(wid&3)+(lane>>2))*KPI+(wid>>2)*32+(lane&3)*8;
  const unsigned kdst=lds0+LDS_K+wid*1024, vdst=lds0+LDS_V+wid*1024;
  #define DMA_K(t,slot) glds16(ksrc+(long)(t)*KVBLK*KPI,(unsigned)__builtin_amdgcn_readfirstlane(kdst+(slot)))
  #define DMA_V(t,slot) glds16(vsrc+(long)(t)*KVBLK*KPI,(unsigned)__builtin_amdgcn_readfirstlane(vdst+(slot)))
  const int vb0=(int)(lds0+LDS_V)+((lane>>4)&1)*32+(lane&3)*8+(4*hi+((lane&15)>>2))*64;
  const char*Kbase=shm+LDS_K; bf16x8 kf[8];
  const lds_cptr shm3=(lds_cptr)shm; const lds_cptr kp0=shm3+LDS_K+hi*1024+r32*16; const lds_cptr vp0=shm3+LDS_V+((lane>>4)&1)*32+(lane&3)*8+(4*hi+((lane&15)>>2))*64;
  const int NT=(q0+QB)/KVBLK;
  DMA_K(0,0);DMA_V(0,0);DMA_K(1,SLOTB);
  bf16x8 qr[4];
  #pragma unroll
  for(int d0=0;d0<4;++d0)qr[d0]=*reinterpret_cast<const bf16x8*>(&Qw[(long)r32*QPI+d0*16+hi*8]);
  float mhat=0.f,l_reg=0.f;f32x16 o[2];zero16(o[0]);zero16(o[1]);f32x16 negm;zero16(negm);
  const __attribute__((address_space(3))) unsigned*ckp=(const __attribute__((address_space(3))) unsigned*)((__attribute__((address_space(3))) const char*)shm+LDS_CK)+r32;
  const unsigned q5w=hi?0u:0x3F803F80u; unsigned ka0=0u,ka1=0u;
  #define KALD(t) do{ if(BIAS){ const unsigned a_=ckp[(t)*64], b_=ckp[(t)*64+32]; ka0=hi?0u:a_; ka1=hi?0u:b_; } }while(0)
  #define KAF(x) __builtin_bit_cast(bf16x8,(u32x4){x,0u,0u,0u})
  const int qrel=wid*QBLK+r32;
  #define CMASK(P0,P1,t) do{int jb_=(t)-(NT-4); if(jb_>=0)cmask(P0,P1,jb_,qrel,hi);}while(0)
  bool resc=false;
  #define START(P0,P1) do{ const float rm=rowmax(P0,P1); resc=false; \
    { const float dl=rm; mhat=fadd_s(mhat,dl); \
      _Pragma("unroll") for(int r=0;r<16;++r){P0[r]=fsub_s(P0[r],dl);P1[r]=fsub_s(P1[r],dl);} \
      _Pragma("unroll") for(int r=0;r<16;++r)negm[r]=-mhat; asm volatile("":"+v"(negm)); } \
    _Pragma("unroll") for(int r=0;r<16;++r)P0[r]=__builtin_amdgcn_exp2f(P0[r]); }while(0)
  #define RESC() do{ if(resc){ asm volatile("s_waitcnt lgkmcnt(0)":::"memory"); \
      _Pragma("unroll") for(int d_=0;d_<2;++d_) _Pragma("unroll") for(int r=0;r<16;++r)o[d_][r]*=wsf[crow(r,hi)]; } }while(0)
  f32x16 pA0,pA1,pB0,pB1;
  int sl_prev=0,sl_cur=0,sl_next=SLOTB;
  #define ROT() do{sl_prev=sl_cur;sl_cur=sl_next;sl_next=(sl_next==(NSLOT-1)*SLOTB)?0:sl_next+SLOTB;}while(0)
  DMA_K(2,2*SLOTB);
  WAIT_BAR(3);
  KALD(0); qkt(pA0,pA1,Kbase,qr,negm,negm,r32,hi); if(BIAS){ pA0=__builtin_amdgcn_mfma_f32_32x32x16_bf16(KAF(ka0),KAF(q5w),pA0,0,0,0); pA1=__builtin_amdgcn_mfma_f32_32x32x16_bf16(KAF(ka1),KAF(q5w),pA1,0,0,0); }asm volatile("s_nop 15\n\ts_nop 7":"+v"(pA0),"+v"(pA1));CMASK(pA0,pA1,0);
  START(pA0,pA1);
  KALD(1);
  _Pragma("unroll") for(int r=0;r<16;++r)pA1[r]=__builtin_amdgcn_exp2f(pA1[r]);
  WAIT_BAR(0);
  DMA_K(3,0);DMA_V(1,SLOTB);
  ROT();
  kload8(kf,kp0+sl_cur);
  WAIT_BAR(2);
  s16x4 vlo[8],vhi[8]; u32x4 pw0,pw1,pw2,pw3;
  #define PKW(P,B) cvtpk_s(P[B],P[B+1])
  #define PAF(k) __builtin_bit_cast(bf16x8,pw##k)
  #define VFR(i) (bf16x8){vlo[i][0],vlo[i][1],vlo[i][2],vlo[i][3],vhi[i][0],vhi[i][1],vhi[i][2],vhi[i][3]}
  #define PIN(x) asm volatile("":"+v"(x))
  #define MX3(a,b,c) __builtin_fmaxf(__builtin_fmaxf((a),(b)),(c))
  #define GAPA(MF,A0,A1,A2,A3,W0,W1,PW) do{ MF; sacc+=A0; sacc+=A1; sacc+=A2; sacc+=A3; PIN(sacc); W0; W1; PIN(PW); SBAR(); }while(0)
  #define EX(v) __builtin_amdgcn_exp2f(v)
  #define GAPB(MF,X,B) do{ MF; X[B]=EX(X[B]); X[B+1]=EX(X[B+1]); X[B+2]=EX(X[B+2]); X[B+3]=EX(X[B+3]); PIN(X); SBAR(); }while(0)
  #define GAPBS(MF,X,B,DO_,Y,G) do{ MF; X[B]=EX(X[B]); X[B+1]=EX(X[B+1]); X[B+2]=EX(X[B+2]); X[B+3]=EX(X[B+3]); PIN(X); SBAR(); }while(0)
  #define VRD(i) do{ vlo[i]=vtr(vp_+(((i)>>2)*4096+((i)&3)*1024)); vhi[i]=vtr(vp_+(((i)>>2)*4096+((i)&3)*1024+512)); }while(0)
  #define KRD(G,j) do{ if(G){ kload2(kf,kp0+sl_next,j); SBAR(); } }while(0)
  #define STEP(C0,C1,P0,P1,t,GK,GV,GL) do{ SBAR(); \
    const lds_cptr vp_=vp0+sl_prev; \
    const bf16x8 qd0=qr[0], qd1=qr[1], qd2=qr[2], qd3=qr[3]; \
    VRD(0); SBAR(); float sacc=(P0[0]+P0[1]); \
    GAPA(C0=__builtin_amdgcn_mfma_f32_32x32x16_bf16(kf[0],qd0,negm,0,0,0), P0[2],P0[3],P0[4],P0[5],     pw0[0]=PKW(P0,0), pw0[1]=PKW(P0,2), pw0); \
    VRD(4); SBAR(); GAPA(C1=__builtin_amdgcn_mfma_f32_32x32x16_bf16(kf[1],qd0,negm,0,0,0), P0[6],P0[7],P0[8],P0[9],     pw0[2]=PKW(P0,4), pw0[3]=PKW(P0,6), pw0); \
    VRD(1); SBAR(); GAPA(C0=__builtin_amdgcn_mfma_f32_32x32x16_bf16(kf[2],qd1,C0,0,0,0),   P0[10],P0[11],P0[12],P0[13], pw1[0]=PKW(P0,8), pw1[1]=PKW(P0,10), pw1); \
    VRD(5); SBAR(); GAPA(C1=__builtin_amdgcn_mfma_f32_32x32x16_bf16(kf[3],qd1,C1,0,0,0),   P0[14],P0[15],P1[0],P1[1],   pw1[2]=PKW(P0,12),pw1[3]=PKW(P0,14), pw1); \
    VRD(2); SBAR(); GAPA(C0=__builtin_amdgcn_mfma_f32_32x32x16_bf16(kf[4],qd2,C0,0,0,0),   P1[2],P1[3],P1[4],P1[5],     pw2[0]=PKW(P1,0), pw2[1]=PKW(P1,2), pw2); \
    VRD(6); SBAR(); GAPA(C1=__builtin_amdgcn_mfma_f32_32x32x16_bf16(kf[5],qd2,C1,0,0,0),   P1[6],P1[7],P1[8],P1[9],     pw2[2]=PKW(P1,4), pw2[3]=PKW(P1,6), pw2); \
    VRD(3); SBAR(); GAPA(C0=__builtin_amdgcn_mfma_f32_32x32x16_bf16(kf[6],qd3,C0,0,0,0),   P1[10],P1[11],P1[12],P1[13], pw3[0]=PKW(P1,8), pw3[1]=PKW(P1,10), pw3); \
    VRD(7); SBAR(); GAPA(C1=__builtin_amdgcn_mfma_f32_32x32x16_bf16(kf[7],qd3,C1,0,0,0),   P1[14],P1[15],0.f,0.f,       pw3[2]=PKW(P1,12),pw3[3]=PKW(P1,14), pw3); \
    if(BIAS){ C0=__builtin_amdgcn_mfma_f32_32x32x16_bf16(KAF(ka0),KAF(q5w),C0,0,0,0); C1=__builtin_amdgcn_mfma_f32_32x32x16_bf16(KAF(ka1),KAF(q5w),C1,0,0,0); SBAR(); } \
    l_reg+=sacc; \
    if(GK){DMA_K((t)+3,sl_cur);} if(GV){DMA_V((t)+1,sl_next);} \
    CMASK(C0,C1,t); \
    { float a=MX3(C0[0],C0[1],C1[0]),b=MX3(C0[2],C0[3],C1[1]); a=MX3(a,C1[2],C1[3]); \
      _Pragma("unroll") for(int r=4;r<16;r+=4){a=MX3(a,C0[r],C0[r+1]);b=MX3(b,C0[r+2],C0[r+3]);a=MX3(a,C1[r],C1[r+1]);b=MX3(b,C1[r+2],C1[r+3]);} \
      float rm=__builtin_fmaxf(a,b); { auto rr=__builtin_amdgcn_permlane32_swap(__float_as_uint(rm),__float_as_uint(rm),false,false); rm=__builtin_fmaxf(__uint_as_float(rr[0]),__uint_as_float(rr[1])); } \
      resc=false; \
      if(__builtin_expect(__any(rm>(float)THRL),0)){ const float dl=__builtin_fmaxf(rm,0.f); mhat+=dl; \
        _Pragma("unroll") for(int r=0;r<16;++r){C0[r]-=dl;C1[r]-=dl;} \
        _Pragma("unroll") for(int r=0;r<16;++r)negm[r]=-mhat; asm volatile("":"+v"(negm)); \
        const float f=__builtin_amdgcn_exp2f(-dl); l_reg*=f; if(hi==0)wsf[r32]=f; resc=true; } } \
    SBAR(); \
    GAPBS(o[0]=__builtin_amdgcn_mfma_f32_32x32x16_bf16(PAF(0),VFR(0),o[0],0,0,0), C0,0, GL,P0,0); \
    GAPBS(o[1]=__builtin_amdgcn_mfma_f32_32x32x16_bf16(PAF(0),VFR(4),o[1],0,0,0), C0,4, GL,P0,1); \
    KRD(GL,0); GAPBS(o[0]=__builtin_amdgcn_mfma_f32_32x32x16_bf16(PAF(1),VFR(1),o[0],0,0,0), C0,8, GL,P0,2); \
    KRD(GL,1); GAPBS(o[1]=__builtin_amdgcn_mfma_f32_32x32x16_bf16(PAF(1),VFR(5),o[1],0,0,0), C0,12, GL,P0,3); \
    KRD(GL,2); GAPBS(o[0]=__builtin_amdgcn_mfma_f32_32x32x16_bf16(PAF(2),VFR(2),o[0],0,0,0), C1,0, GL,P1,0); \
    KRD(GL,3); if(GL){KALD((t)+1);} SBAR(); GAPBS(o[1]=__builtin_amdgcn_mfma_f32_32x32x16_bf16(PAF(2),VFR(6),o[1],0,0,0), C1,4, GL,P1,1); \
    GAPBS(o[0]=__builtin_amdgcn_mfma_f32_32x32x16_bf16(PAF(3),VFR(3),o[0],0,0,0), C1,8, GL,P1,2); \
    GAPBS(o[1]=__builtin_amdgcn_mfma_f32_32x32x16_bf16(PAF(3),VFR(7),o[1],0,0,0), C1,12, GL,P1,3); \
    }while(0)
  int t=1;
  #undef CMASK
  #define CMASK(P0,P1,t) do{}while(0)
  for(;t+5<NT;t+=2){
    STEP(pB0,pB1,pA0,pA1,t,true,true,true);     WAIT_BAR(2); RESC(); ROT();
    STEP(pA0,pA1,pB0,pB1,t+1,true,true,true);   WAIT_BAR(2); RESC(); ROT();
  }
  #undef CMASK
  #define CMASK(P0,P1,t) do{int jb_=(t)-(NT-4); if(jb_>=0)cmask(P0,P1,jb_,qrel,hi);}while(0)
  #define ENDW(tt) do{ if((tt)+3<NT){WAIT_BAR(2);} else if((tt)+2<NT){WAIT_BAR(1);} else {WAIT_BAR(0);} }while(0)
  for(;t+1<NT;t+=2){
    STEP(pB0,pB1,pA0,pA1,t,(t+3<NT),(t+1<NT),(t+1<NT));       ENDW(t);   RESC(); ROT();
    STEP(pA0,pA1,pB0,pB1,t+1,(t+4<NT),(t+2<NT),(t+2<NT));     ENDW(t+1); RESC(); ROT();
  }
  STEP(pB0,pB1,pA0,pA1,NT-1,false,false,false); RESC();
  { float sacc=pB0[0]+pB0[1]; _Pragma("unroll") for(int r=2;r<16;++r)sacc+=pB0[r]; _Pragma("unroll") for(int r=0;r<16;++r)sacc+=pB1[r]; l_reg+=sacc;
    pw0=(u32x4){PKW(pB0,0),PKW(pB0,2),PKW(pB0,4),PKW(pB0,6)};pw1=(u32x4){PKW(pB0,8),PKW(pB0,10),PKW(pB0,12),PKW(pB0,14)};pw2=(u32x4){PKW(pB1,0),PKW(pB1,2),PKW(pB1,4),PKW(pB1,6)};pw3=(u32x4){PKW(pB1,8),PKW(pB1,10),PKW(pB1,12),PKW(pB1,14)};
    SBAR(); pv(o,vb0+sl_cur,PAF(0),PAF(1),PAF(2),PAF(3)); }
  #undef PKW
  #undef PAF
  #undef VFR
  #undef PIN
  #undef MX3
  #undef GAPA
  #undef GAPB
  #undef GAPBS
  #undef EX
  #undef VRD
  #undef KRD
  #undef STEP
  #undef ENDW
  {auto rr=__builtin_amdgcn_permlane32_swap(__float_as_uint(l_reg),__float_as_uint(l_reg),false,false);l_reg=__uint_as_float(rr[0])+__uint_as_float(rr[1]);}
  if(hi==0)wsf[32+r32]=l_reg;asm volatile("s_waitcnt lgkmcnt(0)":::"memory");
  float rli[16];
  #pragma unroll
  for(int r=0;r<16;++r)rli[r]=__builtin_amdgcn_rcpf(wsf[32+crow(r,hi)]);
  bf16*Ow=OUT8?Ou:Ou+(long)(wid*QBLK)*OPI;
  { bf16*stg=(bf16*)(shm+LDS_OST)+wid*2048;
    #pragma unroll
    for(int r=0;r<16;++r){const int orow=crow(r,hi);
      #pragma unroll
      for(int d0=0;d0<2;++d0)stg[orow*64+d0*32+r32]=(bf16)(cvtpk_s(o[d0][r]*rli[r],0.f)&0xffffu);}
    asm volatile("s_waitcnt lgkmcnt(0)":::"memory");
    if constexpr(!OUT8){
    #pragma unroll
    for(int i=0;i<4;++i){const int row=i*8+(lane>>3),ch=lane&7; const u32x4 v=*(const u32x4*)(stg+row*64+ch*8); ATTN_STORE16(Ow+(long)row*OPI+ch*8,v);}
    } else {
    unsigned char*O8=(unsigned char*)Ou+(long)(wid*QBLK)*OPI;
    #pragma unroll
    for(int i=0;i<4;++i){const int row=i*8+(lane>>3),ch=lane&7; const u32x4 v=*(const u32x4*)(stg+row*64+ch*8); u32x2 w;
      w.x=cvt4_fp8(__uint_as_float(v[0]<<16)*8.f,__uint_as_float(v[0]&0xffff0000u)*8.f,__uint_as_float(v[1]<<16)*8.f,__uint_as_float(v[1]&0xffff0000u)*8.f);
      w.y=cvt4_fp8(__uint_as_float(v[2]<<16)*8.f,__uint_as_float(v[2]&0xffff0000u)*8.f,__uint_as_float(v[3]<<16)*8.f,__uint_as_float(v[3]&0xffff0000u)*8.f);
      *(u32x2*)(O8+(long)row*OPI+ch*8)=w;}
    } }
  asm volatile("s_waitcnt lgkmcnt(0)\n\ts_barrier":::"memory");
  #undef DMA_K
  #undef DMA_V
  #undef CMASK
  #undef START
  #undef RESC
  #undef ROT
  #undef KALD
  #undef KAF
}
constexpr int U8_VSLOT=16384, U8_LV=NSLOT*SLOTB, U8_WS=U8_LV+NSLOT*U8_VSLOT, U8_Q=U8_WS+NW*256, U8_BYTES=U8_Q+NW*4096;
__device__ __forceinline__ void pv4(f32x16*o,int vb,bf16x8 pa0,bf16x8 pa1,bf16x8 pa2,bf16x8 pa3){
  #pragma unroll
  for(int d0=0;d0<4;++d0){s16x4 lo[4],hi[4];
    #pragma unroll
    for(int ks=0;ks<4;++ks){
      asm volatile("ds_read_b64_tr_b16 %0,%1 offset:%c2":"=&v"(lo[ks]):"v"(vb),"i"(d0*4096+ks*1024):"memory");
      asm volatile("ds_read_b64_tr_b16 %0,%1 offset:%c2":"=&v"(hi[ks]):"v"(vb),"i"(d0*4096+ks*1024+512):"memory");}
    asm volatile("s_waitcnt lgkmcnt(0)":::"memory");SBAR();
    #define PK(k) (bf16x8){lo[k][0],lo[k][1],lo[k][2],lo[k][3],hi[k][0],hi[k][1],hi[k][2],hi[k][3]}
    o[d0]=__builtin_amdgcn_mfma_f32_32x32x16_bf16(pa0,PK(0),o[d0],0,0,0);
    o[d0]=__builtin_amdgcn_mfma_f32_32x32x16_bf16(pa1,PK(1),o[d0],0,0,0);
    o[d0]=__builtin_amdgcn_mfma_f32_32x32x16_bf16(pa2,PK(2),o[d0],0,0,0);
    o[d0]=__builtin_amdgcn_mfma_f32_32x32x16_bf16(pa3,PK(3),o[d0],0,0,0);
    #undef PK
  }
}
template<int THRL,int QPI,int KPI,int OPI,bool FUSE,int O0PI> __device__ __forceinline__ void attn_unit128(int qb,const bf16*Qu,const bf16*__restrict__ Kh,const bf16*__restrict__ Vh,bf16*Ou,char*shm,int wid_in,const bf16*O0,const float*sg,float lam){
  int wid=wid_in; asm volatile("":"+s"(wid));
  const int lane=lane_id(),r32=lane&31,hi=lane>>5;
  const int q0=qb*QB;
  const bf16*Qw=Qu+(long)(wid*QBLK)*QPI;
  const unsigned lds0=(unsigned)(uintptr_t)shm;
  float*wsf=(float*)(shm+U8_WS)+wid*64;
  const bf16*ksrc=Kh+(long)lane*KPI+wid*8;
  const bf16*vsrc=Vh+(long)(16*(wid&3)+(lane>>2))*KPI+(wid>>2)*32+(lane&3)*8;
  const unsigned kdst=lds0+LDS_K+wid*1024, vdst=lds0+U8_LV+wid*1024;
  #define DMA_K(t,slot) glds16(ksrc+(long)(t)*KVBLK*KPI,(unsigned)__builtin_amdgcn_readfirstlane(kdst+(slot)))
  #define DMA_V(t,slot) do{ glds16(vsrc+(long)(t)*KVBLK*KPI,(unsigned)__builtin_amdgcn_readfirstlane(vdst+2*(slot))); glds16(vsrc+(long)(t)*KVBLK*KPI+64,(unsigned)__builtin_amdgcn_readfirstlane(vdst+2*(slot)+8192)); }while(0)
  const int vb0=(int)(lds0+U8_LV)+((lane>>4)&1)*32+(lane&3)*8+(4*hi+((lane&15)>>2))*64;
  const char*Kbase=shm+LDS_K; bf16x8 kf[8];
  const lds_cptr shm3=(lds_cptr)shm; const lds_cptr kp0=shm3+LDS_K+hi*1024+r32*16; const lds_cptr vp0=shm3+U8_LV+((lane>>4)&1)*32+(lane&3)*8+(4*hi+((lane&15)>>2))*64;
  const int NT=(q0+QB)/KVBLK;
  DMA_K(0,0);DMA_V(0,0);DMA_K(1,SLOTB);
  bf16x8 qr[4];
  #pragma unroll
  for(int d0=0;d0<4;++d0)qr[d0]=*reinterpret_cast<const bf16x8*>(&Qw[(long)r32*QPI+d0*16+hi*8]);
  float mhat=0.f,l_reg=0.f;f32x16 o[4];zero16(o[0]);zero16(o[1]);zero16(o[2]);zero16(o[3]);
  const int qrel=wid*QBLK+r32;
  #define CMASK(P0,P1,t) do{int jb_=(t)-(NT-4); if(jb_>=0)cmask(P0,P1,jb_,qrel,hi);}while(0)
  bool resc=false;
  #define START(P0,P1) do{ const float rm=rowmax(P0,P1); resc=false; \
    { const float dl=rm; mhat=fadd_s(mhat,dl); \
      _Pragma("unroll") for(int r=0;r<16;++r){P0[r]=fsub_s(P0[r],dl);P1[r]=fsub_s(P1[r],dl);} } \
    _Pragma("unroll") for(int r=0;r<16;++r)P0[r]=__builtin_amdgcn_exp2f(P0[r]); }while(0)
  #define RESC() do{ if(resc){ asm volatile("s_waitcnt lgkmcnt(0)":::"memory"); \
      _Pragma("unroll") for(int r=0;r<16;++r){ const float f_=wsf[crow(r,hi)]; o[0][r]*=f_; o[1][r]*=f_; o[2][r]*=f_; o[3][r]*=f_; } } }while(0)
  f32x16 pA0,pA1,pB0,pB1;
  #define MKC(X,G) do{ const float nm_=-mhat; X[4*(G)]=nm_; X[4*(G)+1]=nm_; X[4*(G)+2]=nm_; X[4*(G)+3]=nm_; }while(0)
  int sl_prev=0,sl_cur=0,sl_next=SLOTB;
  #define ROT() do{sl_prev=sl_cur;sl_cur=sl_next;sl_next=(sl_next==(NSLOT-1)*SLOTB)?0:sl_next+SLOTB;}while(0)
  DMA_K(2,2*SLOTB);
  WAIT_BAR(4);
  qkt0(pA0,pA1,Kbase,qr,r32,hi);asm volatile("s_nop 15\n\ts_nop 7":"+v"(pA0),"+v"(pA1));CMASK(pA0,pA1,0);
  START(pA0,pA1);
  MKC(pB0,0);MKC(pB0,1);MKC(pB0,2);MKC(pB0,3);MKC(pB1,0);MKC(pB1,1);MKC(pB1,2);MKC(pB1,3);
  _Pragma("unroll") for(int r=0;r<16;++r)pA1[r]=__builtin_amdgcn_exp2f(pA1[r]);
  WAIT_BAR(0);
  DMA_K(3,0);DMA_V(1,SLOTB);
  ROT();
  kload8(kf,kp0+sl_cur);
  WAIT_BAR(3);
  s16x4 vlo[8],vhi[8]; u32x4 pw0,pw1,pw2,pw3;
  #define PKW(P,B) cvtpk_s(P[B],P[B+1])
  #define PAF(k) __builtin_bit_cast(bf16x8,pw##k)
  #define VFR(i) (bf16x8){vlo[i][0],vlo[i][1],vlo[i][2],vlo[i][3],vhi[i][0],vhi[i][1],vhi[i][2],vhi[i][3]}
  #define PIN(x) asm volatile("":"+v"(x))
  #define MX3(a,b,c) __builtin_fmaxf(__builtin_fmaxf((a),(b)),(c))
  #define GAPA(MF,A0,A1,A2,A3,W0,W1,PW) do{ MF; sacc+=A0; sacc+=A1; sacc+=A2; sacc+=A3; PIN(sacc); W0; W1; PIN(PW); SBAR(); }while(0)
  #define EX(v) __builtin_amdgcn_exp2f(v)
  #define GAPB1(MF,X,B,RD) do{ MF; X[B]=EX(X[B]); X[B+1]=EX(X[B+1]); X[B+2]=EX(X[B+2]); X[B+3]=EX(X[B+3]); PIN(X); SBAR(); RD; SBAR(); }while(0)
  #define GAPB2(MF,DO_,Y,G,RD) do{ MF; if(DO_){ MKC(Y,G); PIN(Y); } SBAR(); RD; SBAR(); }while(0)
  #define VRDX(i,off) do{ vlo[i]=vtr(vp_+((off)+((i)&3)*1024)); vhi[i]=vtr(vp_+((off)+((i)&3)*1024+512)); }while(0)
  #define KRD(G,j) do{ if(G){ kload2(kf,kp0+sl_next,j); SBAR(); } }while(0)
  #define QLD(j) (*(const __attribute__((address_space(3))) bf16x8*)(qp0+(j)*1024))
  #define STEP(C0,C1,P0,P1,t,GK,GV,GL) do{ SBAR(); \
    const lds_cptr vp_=vp0+2*sl_prev; \
    VRDX(0,0); SBAR(); float sacc=(P0[0]+P0[1]); \
    GAPA(C0=__builtin_amdgcn_mfma_f32_32x32x16_bf16(kf[0],qr[0],C0,0,0,0), P0[2],P0[3],P0[4],P0[5],     pw0[0]=PKW(P0,0), pw0[1]=PKW(P0,2), pw0); \
    GAPA(C1=__builtin_amdgcn_mfma_f32_32x32x16_bf16(kf[1],qr[0],C1,0,0,0), P0[6],P0[7],P0[8],P0[9],     pw0[2]=PKW(P0,4), pw0[3]=PKW(P0,6), pw0); \
    VRDX(1,0); SBAR(); GAPA(C0=__builtin_amdgcn_mfma_f32_32x32x16_bf16(kf[2],qr[1],C0,0,0,0),   P0[10],P0[11],P0[12],P0[13], pw1[0]=PKW(P0,8), pw1[1]=PKW(P0,10), pw1); \
    GAPA(C1=__builtin_amdgcn_mfma_f32_32x32x16_bf16(kf[3],qr[1],C1,0,0,0),   P0[14],P0[15],P1[0],P1[1],   pw1[2]=PKW(P0,12),pw1[3]=PKW(P0,14), pw1); \
    VRDX(2,0); SBAR(); GAPA(C0=__builtin_amdgcn_mfma_f32_32x32x16_bf16(kf[4],qr[2],C0,0,0,0),   P1[2],P1[3],P1[4],P1[5],     pw2[0]=PKW(P1,0), pw2[1]=PKW(P1,2), pw2); \
    GAPA(C1=__builtin_amdgcn_mfma_f32_32x32x16_bf16(kf[5],qr[2],C1,0,0,0),   P1[6],P1[7],P1[8],P1[9],     pw2[2]=PKW(P1,4), pw2[3]=PKW(P1,6), pw2); \
    VRDX(3,0); SBAR(); GAPA(C0=__builtin_amdgcn_mfma_f32_32x32x16_bf16(kf[6],qr[3],C0,0,0,0),   P1[10],P1[11],P1[12],P1[13], pw3[0]=PKW(P1,8), pw3[1]=PKW(P1,10), pw3); \
    GAPA(C1=__builtin_amdgcn_mfma_f32_32x32x16_bf16(kf[7],qr[3],C1,0,0,0),   P1[14],P1[15],0.f,0.f,       pw3[2]=PKW(P1,12),pw3[3]=PKW(P1,14), pw3); \
    l_reg+=sacc; \
    if(GK){DMA_K((t)+3,sl_cur);} if(GV){DMA_V((t)+1,sl_next);} \
    CMASK(C0,C1,t); \
    { float a=MX3(C0[0],C0[1],C1[0]),b=MX3(C0[2],C0[3],C1[1]); a=MX3(a,C1[2],C1[3]); \
      _Pragma("unroll") for(int r=4;r<16;r+=4){a=MX3(a,C0[r],C0[r+1]);b=MX3(b,C0[r+2],C0[r+3]);a=MX3(a,C1[r],C1[r+1]);b=MX3(b,C1[r+2],C1[r+3]);} \
      float rm=__builtin_fmaxf(a,b); { auto rr=__builtin_amdgcn_permlane32_swap(__float_as_uint(rm),__float_as_uint(rm),false,false); rm=__builtin_fmaxf(__uint_as_float(rr[0]),__uint_as_float(rr[1])); } \
      resc=false; \
      if(__builtin_expect(__any(rm>(float)THRL),0)){ const float dl=__builtin_fmaxf(rm,0.f); mhat+=dl; \
        _Pragma("unroll") for(int r=0;r<16;++r){C0[r]-=dl;C1[r]-=dl;} \
        const float f=__builtin_amdgcn_exp2f(-dl); l_reg*=f; if(hi==0)wsf[r32]=f; resc=true; } } \
    SBAR(); \
    GAPB1(o[0]=__builtin_amdgcn_mfma_f32_32x32x16_bf16(PAF(0),VFR(0),o[0],0,0,0), C0,0,  VRDX(4,4096)); \
    GAPB1(o[0]=__builtin_amdgcn_mfma_f32_32x32x16_bf16(PAF(1),VFR(1),o[0],0,0,0), C0,4,  VRDX(5,4096)); \
    GAPB1(o[0]=__builtin_amdgcn_mfma_f32_32x32x16_bf16(PAF(2),VFR(2),o[0],0,0,0), C0,8,  VRDX(6,4096)); \
    GAPB1(o[0]=__builtin_amdgcn_mfma_f32_32x32x16_bf16(PAF(3),VFR(3),o[0],0,0,0), C0,12, VRDX(7,4096)); \
    GAPB1(o[1]=__builtin_amdgcn_mfma_f32_32x32x16_bf16(PAF(0),VFR(4),o[1],0,0,0), C1,0,  VRDX(0,8192)); \
    GAPB1(o[1]=__builtin_amdgcn_mfma_f32_32x32x16_bf16(PAF(1),VFR(5),o[1],0,0,0), C1,4,  VRDX(1,8192)); \
    GAPB1(o[1]=__builtin_amdgcn_mfma_f32_32x32x16_bf16(PAF(2),VFR(6),o[1],0,0,0), C1,8,  VRDX(2,8192)); \
    GAPB1(o[1]=__builtin_amdgcn_mfma_f32_32x32x16_bf16(PAF(3),VFR(7),o[1],0,0,0), C1,12, VRDX(3,8192)); \
    GAPB2(o[2]=__builtin_amdgcn_mfma_f32_32x32x16_bf16(PAF(0),VFR(0),o[2],0,0,0), GL,P0,0, VRDX(4,12288)); \
    GAPB2(o[2]=__builtin_amdgcn_mfma_f32_32x32x16_bf16(PAF(1),VFR(1),o[2],0,0,0), GL,P0,1, VRDX(5,12288)); \
    GAPB2(o[2]=__builtin_amdgcn_mfma_f32_32x32x16_bf16(PAF(2),VFR(2),o[2],0,0,0), GL,P0,2, VRDX(6,12288)); \
    GAPB2(o[2]=__builtin_amdgcn_mfma_f32_32x32x16_bf16(PAF(3),VFR(3),o[2],0,0,0), GL,P0,3, VRDX(7,12288)); \
    KRD(GL,0); GAPB2(o[3]=__builtin_amdgcn_mfma_f32_32x32x16_bf16(PAF(0),VFR(4),o[3],0,0,0), GL,P1,0, (void)0); \
    KRD(GL,1); GAPB2(o[3]=__builtin_amdgcn_mfma_f32_32x32x16_bf16(PAF(1),VFR(5),o[3],0,0,0), GL,P1,1, (void)0); \
    KRD(GL,2); GAPB2(o[3]=__builtin_amdgcn_mfma_f32_32x32x16_bf16(PAF(2),VFR(6),o[3],0,0,0), GL,P1,2, (void)0); \
    KRD(GL,3); GAPB2(o[3]=__builtin_amdgcn_mfma_f32_32x32x16_bf16(PAF(3),VFR(7),o[3],0,0,0), GL,P1,3, (void)0); \
    }while(0)
  int t=1;
  #undef CMASK
  #define CMASK(P0,P1,t) do{}while(0)
  for(;t+5<NT;t+=2){
    STEP(pB0,pB1,pA0,pA1,t,true,true,true);     WAIT_BAR(3); RESC(); ROT();
    STEP(pA0,pA1,pB0,pB1,t+1,true,true,true);   WAIT_BAR(3); RESC(); ROT();
  }
  #undef CMASK
  #define CMASK(P0,P1,t) do{int jb_=(t)-(NT-4); if(jb_>=0)cmask(P0,P1,jb_,qrel,hi);}while(0)
  #define ENDW(tt) do{ if((tt)+3<NT){WAIT_BAR(3);} else if((tt)+2<NT){WAIT_BAR(2);} else {WAIT_BAR(0);} }while(0)
  for(;t+1<NT;t+=2){
    STEP(pB0,pB1,pA0,pA1,t,(t+3<NT),(t+1<NT),(t+1<NT));       ENDW(t);   RESC(); ROT();
    STEP(pA0,pA1,pB0,pB1,t+1,(t+4<NT),(t+2<NT),(t+2<NT));     ENDW(t+1); RESC(); ROT();
  }
  STEP(pB0,pB1,pA0,pA1,NT-1,false,false,false); RESC();
  { float sacc=pB0[0]+pB0[1]; _Pragma("unroll") for(int r=2;r<16;++r)sacc+=pB0[r]; _Pragma("unroll") for(int r=0;r<16;++r)sacc+=pB1[r]; l_reg+=sacc;
    pw0=(u32x4){PKW(pB0,0),PKW(pB0,2),PKW(pB0,4),PKW(pB0,6)};pw1=(u32x4){PKW(pB0,8),PKW(pB0,10),PKW(pB0,12),PKW(pB0,14)};pw2=(u32x4){PKW(pB1,0),PKW(pB1,2),PKW(pB1,4),PKW(pB1,6)};pw3=(u32x4){PKW(pB1,8),PKW(pB1,10),PKW(pB1,12),PKW(pB1,14)};
    SBAR(); pv4(o,vb0+2*sl_cur,PAF(0),PAF(1),PAF(2),PAF(3)); }
  #undef PKW
  #undef PAF
  #undef VFR
  #undef PIN
  #undef MX3
  #undef GAPA
  #undef GAPB1
  #undef GAPB2
  #undef EX
  #undef VRDX
  #undef QLD
  #undef KRD
  #undef STEP
  #undef ENDW
  {auto rr=__builtin_amdgcn_permlane32_swap(__float_as_uint(l_reg),__float_as_uint(l_reg),false,false);l_reg=__uint_as_float(rr[0])+__uint_as_float(rr[1]);}
  if(hi==0)wsf[32+r32]=l_reg;asm volatile("s_waitcnt lgkmcnt(0)":::"memory");
  float rli[16];
  #pragma unroll
  for(int r=0;r<16;++r)rli[r]=__builtin_amdgcn_rcpf(wsf[32+crow(r,hi)]);
  bf16*Ow=Ou+(long)(wid*QBLK)*OPI;
  asm volatile("s_waitcnt lgkmcnt(0)\n\ts_barrier":::"memory");
  { bf16*stg=(bf16*)(shm)+wid*4096;
    #pragma unroll
    for(int r=0;r<16;++r){const int orow=crow(r,hi);
      #pragma unroll
      for(int d0=0;d0<4;++d0)stg[orow*128+d0*32+r32]=(bf16)(cvtpk_s(o[d0][r]*rli[r],0.f)&0xffffu);}
    asm volatile("s_waitcnt lgkmcnt(0)":::"memory");
    if constexpr(!FUSE){
    #pragma unroll
    for(int i=0;i<8;++i){const int row=i*4+(lane>>4),ch=lane&15; const u32x4 v=*(const u32x4*)(stg+row*128+ch*8); ATTN_STORE16(Ow+(long)row*OPI+ch*8,v);}
    } else {
    const int ch=lane&15; const bf16*O0w=O0+(long)(wid*QBLK)*O0PI;
    const f32x4 g0=*(const f32x4*)(sg+ch*8),g1=*(const f32x4*)(sg+ch*8+4);
    u32x4 a0[8];
    #pragma unroll
    for(int i=0;i<8;++i){const int row=i*4+(lane>>4); a0[i]=*(const u32x4*)(O0w+(long)row*O0PI+ch*8);}
    #pragma unroll
    for(int i=0;i<8;++i){const int row=i*4+(lane>>4); const u32x4 v=*(const u32x4*)(stg+row*128+ch*8); float y[8],ss=0.f;
      #pragma unroll
      for(int j=0;j<4;++j){ y[2*j]=__uint_as_float(a0[i][j]<<16)-lam*__uint_as_float(v[j]<<16); y[2*j+1]=__uint_as_float(a0[i][j]&0xffff0000u)-lam*__uint_as_float(v[j]&0xffff0000u); ss+=y[2*j]*y[2*j]+y[2*j+1]*y[2*j+1]; }
      ss+=__shfl_xor(ss,1);ss+=__shfl_xor(ss,2);ss+=__shfl_xor(ss,4);ss+=__shfl_xor(ss,8);
      const float r=0.8f/sqrtf(ss*(1.f/128.f)+1e-6f);
      u32x4 w; w.x=cvtpk_s(y[0]*r*g0[0],y[1]*r*g0[1]); w.y=cvtpk_s(y[2]*r*g0[2],y[3]*r*g0[3]); w.z=cvtpk_s(y[4]*r*g1[0],y[5]*r*g1[1]); w.w=cvtpk_s(y[6]*r*g1[2],y[7]*r*g1[3]);
      ATTN_STORE16(Ow+(long)row*OPI+ch*8,w);}
    } }
  asm volatile("s_waitcnt lgkmcnt(0)\n\ts_barrier":::"memory");
  #undef DMA_K
  #undef DMA_V
  #undef CMASK
  #undef START
  #undef RESC
  #undef ROT
  #undef MKC
}
#undef SBAR
#undef WAIT_BAR
}

__device__ __forceinline__ void phase2(Frame& F, const Params& P, int item_lo, int item_hi) {
    unsigned char* ws = F.ws;
    const int wid = F.wave;
#define P2_BASES() unsigned char* ws_ = ws; asm volatile("" : "+s"(ws_)); float* out_ = P.out; asm volatile("" : "+s"(out_)); \
    bf16* QB = (bf16*)(ws_ + WS_QBUF); const bf16* KVB = (const bf16*)(ws_ + WS_KVBUF); bf16* DO = (bf16*)out_; (void)QB; (void)KVB; (void)DO
    constexpr int N_DIFF = 1024, N_FOXP = 1024, N_MEM = 1024, N_ITEMS = N_DIFF + N_FOXP + N_MEM;
    float lam;
    { const int lane = lane_id(); const float* lp = P.in[7]; const float a = wave_sum(lp[lane] * lp[64 + lane]), b = wave_sum(lp[128 + lane] * lp[192 + lane]);
      lam = __uint_as_float(__builtin_amdgcn_readfirstlane(__float_as_uint(__expf(a) - __expf(b) + 0.2f))); }
    for (int i = 0;; ++i) {
        const int L4 = (item_lo >> 1) + i * F.G + F.vcu; if (L4 >= (item_hi >> 1) || L4 >= 512) break;
        {
            P2_BASES();
            const int u = L4 >> 3, pr = L4 & 7, b = u >> 2, h = u & 3;
            const long row0 = (long)b * SEQ;
            for (int which = 0; which < 2; ++which) {
                const int qb = which == 0 ? 15 - pr : pr; const long q0 = qb * 256;
                ta::attn_unit128<8, QP, KVP, 2048, false, 2048>(qb, QB + (row0 + q0) * QP + (h * 2 + 0) * 64, KVB + row0 * KVP + (h * 2 + 0) * 64, KVB + row0 * KVP + 512 + h * 128,
                                                    DO + (row0 + q0) * 2048 + h * 128, (char*)F.lds, wid, nullptr, nullptr, 0.f);
                ta::attn_unit128<8, QP, KVP, 512, true, 2048>(qb, QB + (row0 + q0) * QP + (h * 2 + 1) * 64, KVB + row0 * KVP + (h * 2 + 1) * 64, KVB + row0 * KVP + 512 + h * 128,
                                                    (bf16*)(ws_ + WS_YA) + (size_t)(row0 + q0) * 512 + h * 128, (char*)F.lds, wid, DO + (row0 + q0) * 2048 + h * 128, P.in[8], lam);
            }
        }
    }
    for (int i = 0;; ++i) {
        const int L = (item_lo > N_DIFF ? item_lo : N_DIFF) + i * F.G + F.vcu; if (L >= item_hi || L >= N_DIFF + N_FOXP) break;
        {
            P2_BASES();
            const int tid = wid * 64 + lane_id();
            const int pu = L - N_DIFF, bh = pu >> 3, pr = pu & 7, b = bh >> 3, h = bh & 7;
            const long row0 = (long)b * SEQ;
            const int qbmax = 15 - pr;
            {
                const float* CUM = (const float*)(ws_ + WS_CUM) + (size_t)(b * 8 + h) * SEQ; const float* CHTOT = (const float*)(ws_ + WS_CHTOT);
                LAS float* pfx = (LAS float*)(F.lds + ta::LDS_PFX); LAS float* keyarr = (LAS float*)(F.lds + ta::LDS_CK);
                if (tid < 16) { float a = 0.f; for (int c = 0; c < tid; ++c) a += CHTOT[(b * 16 + c) * 8 + h]; pfx[tid] = a; }
                __syncthreads();
                for (int k = tid; k < 256 * (qbmax + 1); k += 512) { const float v = -(CUM[k] + pfx[k >> 8]) * LOG2E;
                    const unsigned hb = cvt_pk_bf16(v, 0.f) & 0xffffu; const float lo = v - __uint_as_float(hb << 16);
                    ((LAS unsigned*)keyarr)[k] = hb | (cvt_pk_bf16(lo, 0.f) << 16); }
                __syncthreads();
            }
            for (int which = 0; which < 2; ++which) {
                const int qb = which == 0 ? qbmax : pr; const long q0 = qb * 256;
                ta::attn_unit<32, QP, KVP, 1024, true, true>(qb, QB + (row0 + q0) * QP + 512 + h * 64, KVB + row0 * KVP + 1024 + h * 64, KVB + row0 * KVP + 1536 + h * 64,
                                                     (bf16*)(ws_ + WS_Y8 + (size_t)(row0 + q0) * 1024 + h * 64), (char*)F.lds, wid);
            }
        }
    }
    for (int i = 0;; ++i) {
        const int L = (item_lo > N_DIFF + N_FOXP ? item_lo : N_DIFF + N_FOXP) + i * F.G + F.vcu; if (L >= item_hi) break;
        {
            P2_BASES();
            const int lane = lane_id(), tid = wid * 64 + lane, r32 = lane & 31, hi = lane >> 5;
            const int mu0 = L - N_DIFF - N_FOXP; const int mu = (F.G == 256) ? ((mu0 & 255) * 4 + (mu0 >> 8)) : mu0;
            const int b = mu >> 6, h = (mu >> 4) & 3, qb = mu & 15;
            const long row0 = (long)b * SEQ, q0 = qb * 256;
            const bf16* MKV = (const bf16*)(ws_ + WS_MEMKV) + (long)b * MEML * DM;
            const float* gq = P.in[14]; const float* gk = P.in[15];
            if (i == 0 || F.G != 256) {
                __syncthreads();
                sa::fill_kv_res(MKV + h * 128, MKV + 512 + h * 128, DM, F.lds, wid);
                LAS float* keyarr = (LAS float*)(F.lds + sa::R_KEY);
                const int key = tid >> 1, half = tid & 1; const bf16* kr = MKV + (long)key * DM + h * 128 + half * 64; float ss = 0.f;
#pragma unroll
                for (int c = 0; c < 8; ++c) { const bf16x8 v = *(const bf16x8*)(kr + c * 8);
#pragma unroll
                    for (int j = 0; j < 8; ++j) { const float f = bf2f((unsigned short)v[j]); ss += f * f; } }
                ss += __shfl_xor(ss, 1);
                if (half == 0) keyarr[key] = 1.0f / sqrtf(ss * (1.f / 128.f) + EPS);
                __syncthreads();
            }
            const bf16* Q = QB + (row0 + q0 + wid * 32 + r32) * QP + 1024 + h * 128 + hi * 8;
            bf16x8 qr[8]; float qf[8][8]; float ss = 0.f;
#pragma unroll
            for (int d0 = 0; d0 < 8; ++d0) { const bf16x8 v = *(const bf16x8*)(Q + d0 * 16);
#pragma unroll
                for (int j = 0; j < 8; ++j) { qf[d0][j] = bf2f((unsigned short)v[j]); ss += qf[d0][j] * qf[d0][j]; } }
            ss += __shfl_xor(ss, 32);
            const float rq = (0.08838834764831845f * LOG2E) / sqrtf(ss * (1.f / 128.f) + EPS);
#pragma unroll
            for (int d0 = 0; d0 < 8; ++d0) { const int ch = d0 * 16 + hi * 8; u32x4 w;
#pragma unroll
                for (int e = 0; e < 4; ++e) w[e] = cvt_pk_bf16(qf[d0][2 * e] * rq * gq[ch + 2 * e] * gk[ch + 2 * e], qf[d0][2 * e + 1] * rq * gq[ch + 2 * e + 1] * gk[ch + 2 * e + 1]);
                qr[d0] = __builtin_bit_cast(bf16x8, w); }
            sa::unit_res(qr, ws_ + WS_Y8 + (size_t)(row0 + q0) * 1024 + 512 + h * 128, 1024, F.lds, wid);
        }
    }
}

struct Sched3a { long a0; int pm;
    __device__ bool next(int j, pg8::Unit& u) const { if (j >= 12) return false; const int pn = j / 3, i = j % 3;
        u.aoff = a0 + (i == 0 ? (long)(WS_YA - WS_Y8) : (long)(i - 1) * 512); u.boff = (i == 0 ? 0 : (long)MiB + (long)(i - 1) * (1024 * 1024)) + (long)pn * 256 * 1024;
        u.gofs = i == 0 ? 0 : 1; u.pm = pm; u.pn = pn; u.sub = i; return true; } };
struct Sched3b { long a0; int pm;
    __device__ bool next(int j, pg8::Unit& u) const { if (j >= 4) return false; u.aoff = a0; u.boff = (long)j * 256 * 2048; u.gofs = 0; u.pm = pm; u.pn = j; u.sub = 0; return true; } };

struct EpiMerge {
    static constexpr bool PERM = true;
    const unsigned char* GT; bf16* MG;
    __device__ __forceinline__ bool operator()(f32x4 (&acc)[2][2][4][2], const pg8::Unit& u, int wr, int wc, int fr_in, int fq_in) const {
        int fr = fr_in, fq = fq_in; asm volatile("" : "+v"(fr), "+v"(fq));
        const int row0 = u.pm * 256 + wr * 64 + fr, i = u.sub;
        const unsigned char* ta_ = GT + (size_t)(u.pm * 12 + i * 4 + u.pn) * 65536 + (size_t)((wr * 4 + wc) * 64 + fq * 16 + fr) * 16;
        if (i < 2) {
            const float sc = i == 0 ? 128.f : 1.f;
#pragma unroll
            for (int ai = 0; ai < 2; ++ai) {
                u32x4 ga[4], gb[4];
#pragma unroll
                for (int m = 0; m < 4; ++m) { ga[m] = *(const u32x4*)(ta_ + (ai * 4 + m) * 8192); gb[m] = *(const u32x4*)(ta_ + 4 * 65536 + (ai * 4 + m) * 8192); }
#pragma unroll
                for (int m = 0; m < 4; ++m)
#pragma unroll
                    for (int bj = 0; bj < 2; ++bj)
#pragma unroll
                        for (int n = 0; n < 2; ++n) { const unsigned a = ga[m][bj * 2 + n], b = gb[m][bj * 2 + n];
#pragma unroll
                            for (int j = 0; j < 4; ++j) acc[ai][bj][m][n][j] *= (float)((a >> (8 * j)) & 255u) * sc * __builtin_amdgcn_rcpf((float)((b >> (8 * j)) & 255u)); }
            }
            return true;
        }
        const int col = u.pn * 256 + g64_col(wc, 0, fq);
        u32x4 ga[8];
#pragma unroll
        for (int jj = 0; jj < 8; ++jj) ga[jj] = *(const u32x4*)(ta_ + jj * 8192);
#pragma unroll
        for (int ai = 0; ai < 2; ++ai)
#pragma unroll
            for (int m = 0; m < 4; ++m) { const int row = row0 + ai * 128 + m * 16; const int jj = ai * 4 + m;
#pragma unroll
                for (int bj = 0; bj < 2; ++bj) { f32x4 v0 = acc[ai][bj][m][0], v1 = acc[ai][bj][m][1]; const unsigned a0 = ga[jj][bj * 2], a1 = ga[jj][bj * 2 + 1];
#pragma unroll
                    for (int j = 0; j < 4; ++j) { v0[j] *= (float)((a0 >> (8 * j)) & 255u) * (1.f / (255.f * 128.f)); v1[j] *= (float)((a1 >> (8 * j)) & 255u) * (1.f / (255.f * 128.f)); }
                    u32x4 w; w.x = cvt_pk_bf16(v0[0], v0[1]); w.y = cvt_pk_bf16(v0[2], v0[3]); w.z = cvt_pk_bf16(v1[0], v1[1]); w.w = cvt_pk_bf16(v1[2], v1[3]);
                    *(u32x4*)(MG + (size_t)row * DM + col + 32 * bj) = w; } }
        return false;
    }
};

struct EpiOut {
    static constexpr bool PERM = true;
    const float* X; float* rowss; bf16* X1B; const float* g2; unsigned char* H2U8;
    __device__ __forceinline__ bool operator()(f32x4 (&acc)[2][2][4][2], const pg8::Unit& u, int wr, int wc, int fr, int fq) const {
        const int col0 = u.pn * 256 + wc * 32 + 8 * fq;
        f32x4 gv[2][2];
#pragma unroll
        for (int bj = 0; bj < 2; ++bj)
#pragma unroll
            for (int n = 0; n < 2; ++n) gv[bj][n] = *(const f32x4*)(g2 + col0 + bj * 128 + n * 4);
#pragma unroll
        for (int am = 0; am < 2; ++am) { const int ai = am, m0 = 0;
            f32x4 xr[4][2][2];
#pragma unroll
            for (int m = m0; m < m0 + 4; ++m) { const size_t off = (size_t)(u.pm * 256 + ai * 128 + wr * 64 + m * 16 + fr) * DM + col0;
#pragma unroll
                for (int bj = 0; bj < 2; ++bj)
#pragma unroll
                    for (int n = 0; n < 2; ++n) xr[m][bj][n] = *(const f32x4*)(X + off + bj * 128 + n * 4); }
#pragma unroll
            for (int m = m0; m < m0 + 4; ++m) { const int rl = ai * 128 + wr * 64 + m * 16 + fr; const size_t off = (size_t)(u.pm * 256 + rl) * DM + col0; float ss = 0.f;
#pragma unroll
                for (int bj = 0; bj < 2; ++bj) { u32x4 w; u32x2 w8;
#pragma unroll
                    for (int n = 0; n < 2; ++n) { const f32x4 o = xr[m][bj][n] + acc[ai][bj][m][n];
                        ss += (o[0] * o[0] + o[1] * o[1]) + (o[2] * o[2] + o[3] * o[3]);
                        w[2 * n] = cvt_pk_bf16(o[0], o[1]); w[2 * n + 1] = cvt_pk_bf16(o[2], o[3]);
                        const f32x4 hv = o * gv[bj][n]; w8[n] = cvt4_fp8(hv[0], hv[1], hv[2], hv[3]); }
                    *(u32x4*)(X1B + off + bj * 128) = w; *(u32x2*)(H2U8 + off + bj * 128) = w8; }
                ss += __shfl_xor(ss, 16); ss += __shfl_xor(ss, 32);
                if (fq == 0) rowss[(size_t)(u.pm * 256 + rl) * 16 + u.pn * 4 + wc] = ss; }
            asm volatile("" ::: "memory");
        }
        return false;
    }
};

__device__ __forceinline__ void phase3(Frame& F, const Params& P) {
    unsigned char* ws = F.ws;
    bf16* QB = (bf16*)(ws + WS_QBUF);
    bf16* H2 = (bf16*)(ws + WS_KVBUF); bf16* MG = (bf16*)(ws + WS_KVBUF + 128 * MiB);
#ifndef NO3A
    if (!(P.dummy & 4)) for (int pm = blockIdx.x; pm < T / 256; pm += F.G) {
        {
            pg8::Gemm g{(const char*)(ws + WS_Y8), (const char*)(ws + WS_WO), 1024, 1024, 512 / 128, nullptr};
            Sched3a S{(long)pm * 256 * 1024, pm}; EpiMerge E{(const unsigned char*)(ws + WS_GATES), MG};
            pg8::gemm_phase<EpiMerge, Sched3a, true, false, true, true>(F.lds, g, S, E, F.wave);
        }
    }
#endif
#ifndef NO3B
    if (!(P.dummy & 8)) for (int pm = blockIdx.x; pm < T / 256; pm += F.G) {
        {
            pg8::Gemm g{(const char*)MG, (const char*)(ws + WS_WOUT), DM * 2, DM * 2, DM / 64, nullptr};
            Sched3b S{(long)pm * 256 * DM * 2, pm}; EpiOut E{P.in[0], (float*)(ws + WS_ROPE), H2, P.in[20], ws + WS_H2U8};
            pg8::gemm_phase<EpiOut, Sched3b, true, false>(F.lds, g, S, E, F.wave);
        }
    }
#endif
#ifndef NO3C
    if (!(P.dummy & 16)) for (int pm = blockIdx.x; pm < T / 256; pm += F.G) {
        {
            const int lane = lane_id(), wid = F.wave, tid = wid * 64 + lane, r32 = lane & 31, hi = lane >> 5;
            const float* rowss = (const float*)(ws + WS_ROPE);
            LAS float* LG = (LAS float*)F.lds;
            LAS int* cnt = (LAS int*)(F.lds + X_TAB);
            LAS float* rs = (LAS float*)(F.lds + 40960) + wid * 32;
            LAS unsigned char* at = F.lds + 45056 + wid * 4608;
            if (tid < 64) cnt[tid] = 0;
            const size_t prow0 = (size_t)pm * 256 + wid * 32;
            if (lane < 32) { const f32x4* rp = (const f32x4*)(rowss + (prow0 + lane) * 16); const f32x4 a = rp[0], b = rp[1], c = rp[2], d = rp[3];
                const float ss = ((a[0] + a[1]) + (a[2] + a[3])) + ((b[0] + b[1]) + (b[2] + b[3])) + ((c[0] + c[1]) + (c[2] + c[3])) + ((d[0] + d[1]) + (d[2] + d[3]));
                rs[lane] = 1.0f / sqrtf(ss * (1.f / DM) + EPS); }
            LDS_WAIT();
            if (lane < 32) ((float*)(ws + WS_RSTD))[prow0 + lane] = rs[lane];
            const int lr8 = lane >> 3, c8 = lane & 7;
            const bf16* hp = H2 + (prow0 + lr8) * DM + 8 * c8;
            const bf16* WR = (const bf16*)(ws + WS_WR) + (size_t)r32 * DM + hi * 8;
            f32x16 a0 = f32x16{}, a1 = f32x16{};
            u32x4 xv[4], xn[4];
#pragma unroll
            for (int i = 0; i < 4; ++i) xv[i] = *(const u32x4*)(hp + (size_t)(8 * i) * DM);
            for (int c = 0; c < 16; ++c) {
                if (c + 1 < 16) {
#pragma unroll
                    for (int i = 0; i < 4; ++i) xn[i] = *(const u32x4*)(hp + (size_t)(8 * i) * DM + (c + 1) * 64);
                }
#pragma unroll
                for (int i = 0; i < 4; ++i) *(LAS u32x4*)(at + (8 * i + lr8) * 144 + c8 * 16) = xv[i];
                LDS_WAIT();
#pragma unroll
                for (int kk = 0; kk < 4; ++kk) {
                    const bf16x8 af = *(const LAS bf16x8*)(at + r32 * 144 + kk * 32 + hi * 16);
                    const bf16x8 b0 = *(const bf16x8*)(WR + c * 64 + kk * 16), b1 = *(const bf16x8*)(WR + (size_t)32 * DM + c * 64 + kk * 16);
                    a0 = __builtin_amdgcn_mfma_f32_32x32x16_bf16(af, b0, a0, 0, 0, 0);
                    a1 = __builtin_amdgcn_mfma_f32_32x32x16_bf16(af, b1, a1, 0, 0, 0);
                }
#pragma unroll
                for (int i = 0; i < 4; ++i) xv[i] = xn[i];
            }
#pragma unroll
            for (int r = 0; r < 16; ++r) { const float sc = rs[sa::crow(r, hi)]; a0[r] *= sc; a1[r] *= sc; }
            __syncthreads();
#pragma unroll
            for (int r = 0; r < 16; ++r) { const int lr = wid * 32 + sa::crow(r, hi); LG[lr * 37 + r32] = a0[r]; if (r32 < 4) LG[lr * 37 + 32 + r32] = a1[r]; }
            __syncthreads();
            if (tid < 256) {
                const float* brg = P.in[22]; const float* bre = P.in[24];
                const LAS float* lg = LG + tid * 37;
                float gl[4]; int gi = 0;
#pragma unroll
                for (int j = 0; j < 4; ++j) gl[j] = lg[j] + brg[j];
#pragma unroll
                for (int j = 1; j < 4; ++j) if (gl[j] > gl[gi]) gi = j;
                float den = 0.f;
#pragma unroll
                for (int j = 0; j < 4; ++j) den += __expf(gl[j] - gl[gi]);
                const float gate = 1.0f / den;
                float el[8];
#pragma unroll
                for (int j = 0; j < 8; ++j) el[j] = lg[4 + 8 * gi + j] + bre[8 * gi + j];
                int i0 = 0;
#pragma unroll
                for (int j = 1; j < 8; ++j) if (el[j] > el[i0]) i0 = j;
                int i1 = i0 == 0 ? 1 : 0;
#pragma unroll
                for (int j = 0; j < 8; ++j) if (j != i0 && el[j] > el[i1]) i1 = j;
                const float w0 = 1.0f / (1.0f + __expf(el[i1] - el[i0])), w1 = 1.0f - w0;
                const int e0 = gi * 8 + i0, e1 = gi * 8 + i1;
                const int r0 = atomicAdd((int*)&cnt[e0], 1), r1 = atomicAdd((int*)&cnt[32 + e1], 1);
                int* RT = (int*)(ws + WS_ROUTE) + ((size_t)pm * 256 + tid) * 8;
                RT[0] = e0; RT[1] = e1; RT[2] = __float_as_int(gate * w0); RT[3] = __float_as_int(gate * w1); RT[4] = r0; RT[5] = r1;
            }
            __syncthreads();
            if (tid < 64) ((int*)(ws + WS_BLKCNT))[pm * 64 + tid] = cnt[tid];
            __syncthreads();
        }
#endif
    }
}

__device__ __forceinline__ void build_bins(Frame& F, int pm_for_prefix) {
    unsigned char* ws = F.ws; const int tid = F.wave * 64 + lane_id();
    LAS int* tab = (LAS int*)(F.lds + X_TAB);
    const int* BC = (const int*)(ws + WS_BLKCNT);
    if (tid < 64) { int tot = 0, pre = 0; for (int p = 0; p < T / 256; ++p) { const int c = BC[p * 64 + tid]; if (p < pm_for_prefix) pre += c; tot += c; } tab[tid] = tot; tab[128 + tid] = pre; }
    __syncthreads();
    if (tid == 0) { int tl = 0; for (int b = 0; b < 64; ++b) { tab[64 + b] = tl * 256; tab[192 + b] = tl; tl += (tab[b] + 255) >> 8; } tab[192 + 64] = tl; }
    __syncthreads();
}

__device__ __forceinline__ void phase4(Frame& F, const Params& P) {
    unsigned char* ws = F.ws; const int tid = F.wave * 64 + lane_id();
    LAS int* tab = (LAS int*)(F.lds + X_TAB);
    int* TOK = (int*)(ws + WS_TOK); float* WL = (float*)(ws + WS_WL);
    for (int pm = blockIdx.x; pm < T / 256; pm += F.G) {
        build_bins(F, pm);
        if (tid < 256) {
            const int tok = pm * 256 + tid; const int* RT = (const int*)(ws + WS_ROUTE) + (size_t)tok * 8;
            const int e0 = RT[0], e1 = RT[1];
            const int d0 = tab[64 + e0] + tab[128 + e0] + RT[4], d1 = tab[64 + 32 + e1] + tab[128 + 32 + e1] + RT[5];
            TOK[d0] = tok; WL[d0] = __int_as_float(RT[2]); TOK[d1] = tok; WL[d1] = __int_as_float(RT[3]);
        }
        __syncthreads();
    }
}

struct SchedMoe { const LAS int* rec; int n; long astep, bstep_e, bstep_pn; bool gather;
    __device__ bool next(int j, pg8::Unit& u) const { if (j >= n) return false; const int rt = __builtin_amdgcn_readfirstlane(rec[4 * j]), pn = __builtin_amdgcn_readfirstlane(rec[4 * j + 1]), bin = __builtin_amdgcn_readfirstlane(rec[4 * j + 2]);
        u.aoff = gather ? 0 : (long)rt * astep; u.boff = (long)(bin & 31) * bstep_e + (long)pn * bstep_pn; u.gofs = j * 256; u.pm = rt; u.pn = pn; u.sub = j; return true; } };

struct EpiUp {
    static constexpr bool PERM = true;
    bf16* ACT; const float* RSTD; const LAS int* gl;
    __device__ __forceinline__ bool operator()(f32x4 (&acc)[2][2][4][2], const pg8::Unit& u, int wr, int wc, int fr, int fq) const {
        const int row0 = u.pm * 256 + wr * 64 + fr;
        float rr[2][4];
#pragma unroll
        for (int ai = 0; ai < 2; ++ai)
#pragma unroll
            for (int m = 0; m < 4; ++m) rr[ai][m] = RSTD[gl[u.gofs + ai * 128 + wr * 64 + m * 16 + fr]] * (1.f / 32.f);
#pragma unroll
        for (int ai = 0; ai < 2; ++ai)
#pragma unroll
            for (int m = 0; m < 4; ++m) { float v[8]; const float r = rr[ai][m];
#pragma unroll
                for (int n = 0; n < 2; ++n)
#pragma unroll
                    for (int j = 0; j < 4; ++j) { const float a = acc[ai][0][m][n][j] * r, b = acc[ai][1][m][n][j] * r; v[4 * n + j] = a * __builtin_amdgcn_rcpf(1.f + __expf(-a)) * b; }
                u32x2 w; w.x = cvt4_fp8(v[0] * 8.f, v[1] * 8.f, v[2] * 8.f, v[3] * 8.f); w.y = cvt4_fp8(v[4] * 8.f, v[5] * 8.f, v[6] * 8.f, v[7] * 8.f);
                *(u32x2*)((unsigned char*)ACT + (size_t)(row0 + ai * 128 + m * 16) * EFF + u.pn * 128 + wc * 32 + fq * 8) = w; }
        return false;
    }
};

struct EpiDown0 {
    static constexpr bool PERM = true;
    bf16* Y0_; const int* TOK_; const float* WL_; const LAS int* rec;
    __device__ __forceinline__ bool operator()(f32x4 (&acc)[2][2][4][2], const pg8::Unit& u, int wr, int wc, int fr, int fq) const {
        bf16* Y0 = Y0_; const int* TOK = TOK_; const float* WL = WL_; asm volatile("" : "+s"(Y0), "+s"(TOK), "+s"(WL));
        const int nvalid = rec[4 * u.sub + 3]; const int col0 = u.pn * 256 + wc * 32 + 8 * fq;
        int tok[2][4]; float w[2][4];
#pragma unroll
        for (int ai = 0; ai < 2; ++ai)
#pragma unroll
            for (int m = 0; m < 4; ++m) { const int rl = ai * 128 + wr * 64 + m * 16 + fr; const bool ok = rl < nvalid;
                tok[ai][m] = ok ? TOK[u.pm * 256 + rl] : -1; w[ai][m] = ok ? WL[u.pm * 256 + rl] * (1.f / 128.f) : 0.f; }
#pragma unroll
        for (int ai = 0; ai < 2; ++ai)
#pragma unroll
            for (int m = 0; m < 4; ++m) { if (tok[ai][m] >= 0) { bf16* op = Y0 + (size_t)tok[ai][m] * DM + col0; const float ww = w[ai][m];
#pragma unroll
                for (int bj = 0; bj < 2; ++bj) { const f32x4 v0 = acc[ai][bj][m][0] * ww, v1 = acc[ai][bj][m][1] * ww;
                    u32x4 o; o.x = cvt_pk_bf16(v0[0], v0[1]); o.y = cvt_pk_bf16(v0[2], v0[3]); o.z = cvt_pk_bf16(v1[0], v1[1]); o.w = cvt_pk_bf16(v1[2], v1[3]);
                    *(u32x4*)(op + bj * 128) = o; } } }
        return false;
    }
};
struct EpiDown1 {
    static constexpr bool PERM = true;
    float* O_; const bf16* Y0_; const bf16* X1_; const int* TOK_; const float* WL_; const LAS int* rec;
    __device__ __forceinline__ bool operator()(f32x4 (&acc)[2][2][4][2], const pg8::Unit& u, int wr, int wc, int fr, int fq) const {
        float* O = O_; const bf16* Y0 = Y0_; const bf16* X1 = X1_; const int* TOK = TOK_; const float* WL = WL_; asm volatile("" : "+s"(O), "+s"(Y0), "+s"(X1), "+s"(TOK), "+s"(WL));
        const int nvalid = rec[4 * u.sub + 3]; const int col0 = u.pn * 256 + wc * 32 + 8 * fq;
#pragma unroll
        for (int am = 0; am < 2; ++am) { const int ai = am;
            int tok[4]; float w[4]; u32x4 xr[4][2]; u32x4 yr[4][2];
#pragma unroll
            for (int m = 0; m < 4; ++m) { const int rl = ai * 128 + wr * 64 + m * 16 + fr; const bool ok = rl < nvalid;
                tok[m] = ok ? TOK[u.pm * 256 + rl] : -1; w[m] = ok ? WL[u.pm * 256 + rl] * (1.f / 128.f) : 0.f; }
#pragma unroll
            for (int m = 0; m < 4; ++m) { const size_t ro = (size_t)(tok[m] < 0 ? 0 : tok[m]) * DM + col0;
#pragma unroll
                for (int bj = 0; bj < 2; ++bj) { yr[m][bj] = *(const u32x4*)(Y0 + ro + bj * 128); xr[m][bj] = *(const u32x4*)(X1 + ro + bj * 128); } }
#pragma unroll
            for (int m = 0; m < 4; ++m) { if (tok[m] >= 0) { float* op = O + (size_t)tok[m] * DM + col0;
#pragma unroll
                for (int bj = 0; bj < 2; ++bj)
#pragma unroll
                    for (int n = 0; n < 2; ++n) { const unsigned ya = yr[m][bj][2 * n], yb = yr[m][bj][2 * n + 1], xa = xr[m][bj][2 * n], xb = xr[m][bj][2 * n + 1];
                        const f32x4 yv = {__uint_as_float(ya << 16), __uint_as_float(ya & 0xffff0000u), __uint_as_float(yb << 16), __uint_as_float(yb & 0xffff0000u)};
                        const f32x4 xv = {__uint_as_float(xa << 16), __uint_as_float(xa & 0xffff0000u), __uint_as_float(xb << 16), __uint_as_float(xb & 0xffff0000u)};
                        *(f32x4*)(op + bj * 128 + n * 4) = xv + yv + acc[ai][bj][m][n] * w[m]; } } }
            asm volatile("" ::: "memory");
        }
        return false;
    }
};

__device__ __forceinline__ void phase_moe(Frame& F, const Params& P, int mode, int sub = 0) {
    unsigned char* ws = F.ws;
#if MK_N_LAUNCHES == 1
    if ((int)blockIdx.x >= T / 256) build_bins(F, 0);
#else
    build_bins(F, 0);
#endif
    LAS int* tab = (LAS int*)(F.lds + X_TAB); LAS int* rec = tab + 512; LAS int* gl = (LAS int*)(F.lds + X_ROWSS);
    const int b_lo = mode == 0 ? 32 * sub : (mode == 2 ? 32 : 0), b_hi = b_lo + 32;
    const int t_lo = __builtin_amdgcn_readfirstlane(tab[192 + b_lo]), t_hi = __builtin_amdgcn_readfirstlane(tab[192 + b_hi]), nunits = (t_hi - t_lo) * 4;
    const int u0 = __builtin_amdgcn_readfirstlane(tab[192 + 32]) * 4, u1 = __builtin_amdgcn_readfirstlane(tab[192 + 64]) * 4 - u0;
    const int rot = (mode == 0 ? (sub ? u0 : 0) : (mode == 1 ? u0 + u1 : 2 * u0 + u1)) % F.G;
    const int vc = (F.vcu + F.G - rot) % F.G;
    const int* TOK = (const int*)(ws + WS_TOK);
    for (int base = 0;; base += 16) {
        const int Lb = base * F.G + vc; if (Lb >= nunits) break;
        __syncthreads();
        const int tid = F.wave * 64 + lane_id();
        if (tid < 16) { const int L = (base + tid) * F.G + vc;
            if (L < nunits) { const int rt = t_lo + (L >> 2), pn = L & 3; int bin = b_lo; while (tab[192 + bin + 1] <= rt) ++bin;
                int nv = tab[bin] - (rt - tab[192 + bin]) * 256; nv = nv > 256 ? 256 : nv;
                rec[4 * tid] = rt; rec[4 * tid + 1] = pn; rec[4 * tid + 2] = bin; rec[4 * tid + 3] = nv; }
            else rec[4 * tid] = -1; }
        __syncthreads();
        int n = 0;
        _Pragma("nounroll") while (n < 16 && __builtin_amdgcn_readfirstlane(rec[4 * n]) >= 0) ++n;
        if (mode == 0) {
            for (int e = tid; e < n * 256; e += 512) { const int j = e >> 8, r = e & 255; gl[e] = r < rec[4 * j + 3] ? TOK[rec[4 * j] * 256 + r] : 0; }
            __syncthreads();
            pg8::Gemm g{(const char*)(ws + WS_H2U8), (const char*)(ws + WS_WUP), DM, DM, DM / 128, gl};
            SchedMoe S{rec, n, 0, 1024L * 1024, 256L * 1024, true}; EpiUp E{(bf16*)(ws + WS_GATES), (const float*)(ws + WS_RSTD), gl};
            pg8::gemm_phase<EpiUp, SchedMoe, true, true, true>(F.lds, g, S, E, F.wave);
        } else {
            pg8::Gemm g{(const char*)(ws + WS_GATES), (const char*)(ws + WS_WDN), EFF, EFF, EFF / 128, gl};
            SchedMoe S{rec, n, 256L * EFF, 1024L * 512, 256L * 512, false};
            bf16* Y0 = (bf16*)(ws + WS_KVBUF + 128 * MiB);
            if (mode == 1) { EpiDown0 E{Y0, TOK, (const float*)(ws + WS_WL), rec}; pg8::gemm_phase<EpiDown0, SchedMoe, true, false, true>(F.lds, g, S, E, F.wave); }
            else { EpiDown1 E{P.out, Y0, (const bf16*)(ws + WS_KVBUF), TOK, (const float*)(ws + WS_WL), rec}; pg8::gemm_phase<EpiDown1, SchedMoe, true, false, true>(F.lds, g, S, E, F.wave); }
        }
    }
}

__global__ void __launch_bounds__(512, 2) fwd_kernel(Params P) {
    extern __shared__ __attribute__((aligned(16))) unsigned char lds_raw[];
    Frame F;
    F.lds = (LAS unsigned char*)lds_raw;
    F.wave = __builtin_amdgcn_readfirstlane((int)threadIdx.x >> 6);
    F.G = gridDim.x; { const int bx = blockIdx.x; F.vcu = (F.G % 8 == 0) ? (bx % 8) * (F.G / 8) + bx / 8 : bx; }
    F.ws = P.ws;
    const int lo = P.ph_lo, hi = P.ph_hi;
#if MK_N_LAUNCHES == 1
    volatile LAS unsigned* bst = (volatile LAS unsigned*)(F.lds + X_BARST);
    { const int t_ = F.wave * 64 + lane_id(); if (t_ < 2) bst[t_] = 0u; }
    __syncthreads();
    XcdBarrier bar = xcd_barrier_post((unsigned*)(P.ws + WS_CTL) + CW_BAR, bst, F.wave == 0 && lane_id() == 0);
#endif
#ifndef PH_MASK
#define PH_MASK 0xff
#endif
#define IN(k) (((PH_MASK >> (k)) & 1) && lo <= (k) && (k) < hi)
#if MK_N_LAUNCHES == 1
#define SEAM(k) do { if (IN(k) && IN((k) + 1)) { xcd_barrier(bar, F.wave == 0 && lane_id() == 0); } } while (0)
#else
#define SEAM(k) do { } while (0)
#endif
    if (IN(0)) phase0(F, P);
    SEAM(0);
    if (IN(1)) phase1(F, P);
    SEAM(1);
    if (IN(2)) phase2(F, P, P.item_lo, P.item_hi);
    SEAM(2);
    if (IN(3)) phase3(F, P);
    SEAM(3);
    if (IN(4)) phase4(F, P);
    SEAM(4);
    if (IN(5)) { phase_moe(F, P, 0, 0); flag_signal((unsigned*)(P.ws + WS_CTL) + CW_BAR, XB_FLAG_A, F.wave == 0 && lane_id() == 0); phase_moe(F, P, 0, 1); }
    if (IN(6)) { flag_wait((unsigned*)(P.ws + WS_CTL) + CW_BAR, XB_FLAG_A, F.wave == 0 && lane_id() == 0); phase_moe(F, P, 1); }
    SEAM(6);
    if (IN(7)) phase_moe(F, P, 2);
#undef IN
#undef SEAM
}

extern "C" void kernel_launch(void* const* d_in, const int* in_sizes, int n_in, void* d_out, int out_size, void* d_ws, size_t ws_size, hipStream_t stream) {
    static int grid = 0;
    if (grid == 0) {
        if (n_in != 27 || out_size != T * DM || ws_size < WS_END) { fprintf(stderr, "kernel_launch: unexpected shapes (n_in %d out %d ws %zu)\n", n_in, out_size, ws_size); grid = -1; return; }
        int dev = 0, cus = 0, per_cu = 0;
        hipGetDevice(&dev); hipDeviceGetAttribute(&cus, hipDeviceAttributeMultiprocessorCount, dev);
        hipFuncSetAttribute((const void*)fwd_kernel, hipFuncAttributeMaxDynamicSharedMemorySize, LDS_BYTES);
        hipOccupancyMaxActiveBlocksPerMultiprocessor(&per_cu, (const void*)fwd_kernel, 512, LDS_BYTES);
        if (per_cu < 1) { fprintf(stderr, "kernel_launch: occupancy query says %d blocks per CU\n", per_cu); per_cu = 1; }
        grid = cus * 1;
        (void)hipGetLastError();
    }
    if (grid < 0) return;
    Params p{};
    for (int i = 0; i < 27; ++i) p.in[i] = (const float*)d_in[i];
    p.out = (float*)d_out; p.ws = (unsigned char*)d_ws; p.item_lo = 0; p.item_hi = 3072;
#if MK_N_LAUNCHES == 1
    p.ph_lo = 0; p.ph_hi = 8;
    (void)hipMemsetAsync((char*)d_ws + WS_CTL, 0, CTL_ZERO_BYTES, stream);
    void* args[] = {&p};
    hipError_t e = hipLaunchCooperativeKernel((const void*)fwd_kernel, dim3(grid), dim3(512), args, LDS_BYTES, stream);
    if (e != hipSuccess) fprintf(stderr, "cooperative launch failed: %s (grid %d)\n", hipGetErrorString(e), grid);
#else
#ifndef PHASE_LIST
#define PHASE_LIST {0, 1, 2, 3, 4, 5, 6, 7}
#endif
    const int plist[] = PHASE_LIST;
    for (int ph : plist) { p.item_lo = 0; p.item_hi = 3072; p.dummy = 0; int k = ph;
        if (ph == 100) { k = 2; p.item_hi = 1024; } else if (ph == 200) { k = 2; p.item_lo = 1024; p.item_hi = 2048; p.dummy = 1; } else if (ph == 201) { k = 2; p.item_lo = 2048; p.dummy = 1; }
        else if (ph == 150) { k = 1; p.dummy = 1; }
        else if (ph >= 300 && ph < 400) { k = 3; p.dummy = 1 | (ph - 300); }
        else if (ph >= 400) { k = ph / 100; p.dummy = 1; }
        p.ph_lo = k; p.ph_hi = k + 1; hipLaunchKernelGGL(fwd_kernel, dim3(grid), dim3(512), LDS_BYTES, stream, p); }
#endif
}
```

```cpp
#include <hip/hip_runtime.h>
#include <type_traits>
#include <hip/hip_cooperative_groups.h>
#include <cstdio>
#include <cstdint>
namespace cg = cooperative_groups;

#ifndef MK_N_LAUNCHES
#define MK_N_LAUNCHES 1
#endif

#define LAS __attribute__((address_space(3)))
typedef unsigned short bf16;
typedef short bf16x8 __attribute__((ext_vector_type(8)));
typedef short s16x4 __attribute__((ext_vector_type(4)));
typedef float f32x4 __attribute__((ext_vector_type(4)));
typedef float f32x16 __attribute__((ext_vector_type(16)));
typedef unsigned u32x4 __attribute__((ext_vector_type(4)));
typedef unsigned u32x2 __attribute__((ext_vector_type(2)));

constexpr int DM = 1024, NB = 16, SEQ = 4096, T = NB * SEQ, MEML = 256;
constexpr int NEXP = 32, EFF = 512;
constexpr float EPS = 1e-6f;
constexpr float LOG2E = 1.4426950408889634f;
constexpr int IN_COLS = 6664;
constexpr int N1 = 1536;
constexpr int QP = 1536, KVP = 2048, GP = 3072;
constexpr int MAXROWS = 2 * T + 64 * 256;

constexpr size_t MiB = 1u << 20;
constexpr size_t WS_CTL = 0;
constexpr size_t WS_WIN = 1 * MiB;
constexpr size_t WS_W8 = 8 * MiB;
constexpr size_t WS_WQK8 = 12 * MiB;
constexpr size_t WS_WMKV = 14 * MiB;
constexpr size_t WS_WO = 16 * MiB;
constexpr size_t WS_WOUT = 19 * MiB;
constexpr size_t WS_WR = 21 * MiB;
constexpr size_t WS_ROPE = 22 * MiB;
constexpr size_t WS_CUM = 26 * MiB;
constexpr size_t WS_CHTOT = 28 * MiB;
constexpr size_t WS_BLKCNT = 28 * MiB + 65536;
constexpr size_t WS_RSTD = 28 * MiB + 262144;
constexpr size_t WS_ROUTE = 29 * MiB;
constexpr size_t WS_TOK = 31 * MiB;
constexpr size_t WS_WL = 32 * MiB;
constexpr size_t WS_MEMN = 33 * MiB;
constexpr size_t WS_MEMKV = 41 * MiB;
constexpr size_t WS_WUP = 49 * MiB;
constexpr size_t WS_WDN = 113 * MiB;
constexpr size_t WS_QBUF = 145 * MiB;
constexpr size_t WS_KVBUF = 337 * MiB;
constexpr size_t WS_GATES = 593 * MiB;
constexpr size_t WS_H2U8 = WS_GATES + 192 * MiB;
constexpr size_t WS_Y8 = WS_H2U8 + 64 * MiB;
constexpr size_t WS_YA = WS_Y8 + 64 * MiB;
constexpr size_t WS_END = 977 * MiB;

constexpr int RING_BYTES = 131072;
constexpr int XOFF = RING_BYTES;
constexpr int X_ROWSS = XOFF;
constexpr int X_TAB = XOFF + 16384;
constexpr int X_BARST = X_TAB + 4096;
constexpr int LDS_BYTES = XOFF + 24576;
constexpr int CW_BAR = 4096;
constexpr size_t CTL_ZERO_BYTES = 65536;

struct Params {
    const float* in[27];
    float* out;
    unsigned char* ws;
    int ph_lo, ph_hi, item_lo, item_hi, dummy, pad_;
};

__device__ __forceinline__ unsigned cvt_pk_bf16(float lo, float hi) { unsigned r; asm volatile("v_cvt_pk_bf16_f32 %0, %1, %2" : "=v"(r) : "v"(lo), "v"(hi)); return r; }
__device__ __forceinline__ float bf2f(unsigned short h) { return __uint_as_float((unsigned)h << 16); }
__device__ __forceinline__ float wave_sum(float v) {
#pragma unroll
    for (int o = 1; o < 64; o <<= 1) v += __shfl_xor(v, o);
    return v;
}
__device__ __forceinline__ int lane_id() { int l; asm volatile("v_mbcnt_lo_u32_b32 %0, -1, 0\n\tv_mbcnt_hi_u32_b32 %0, -1, %0" : "=v"(l)); return l; }
__device__ __forceinline__ unsigned cvt4_fp8(float a, float b, float c, float d) { int p = __builtin_amdgcn_cvt_pk_fp8_f32(a, b, 0, false); p = __builtin_amdgcn_cvt_pk_fp8_f32(c, d, p, true); return (unsigned)p; }
#define LDS_WAIT() asm volatile("s_waitcnt lgkmcnt(0)" ::: "memory")
#define VM_WAIT() asm volatile("s_waitcnt vmcnt(0)" ::: "memory")


#define RLX_AGENT __ATOMIC_RELAXED, __HIP_MEMORY_SCOPE_AGENT
#define XB_TMO      128
#define XB_XCNT(j)  (256  + 64 * (j))
#define XB_XSUB(j)  (1280 + 64 * (j))
#define XB_XGEN(j)  (2304 + 64 * (j))
#define XB_TOP      3328
#define XB_TOPGEN   3392
#define XCD_BAR_WORDS 3456
#define XB_SPIN_CAP (1u << 20)
__device__ __forceinline__ unsigned xb_ld(unsigned* p)              { return __hip_atomic_load(p, __ATOMIC_RELAXED, __HIP_MEMORY_SCOPE_AGENT); }
__device__ __forceinline__ unsigned xb_add(unsigned* p, unsigned v) { return __hip_atomic_fetch_add(p, v, __ATOMIC_RELAXED, __HIP_MEMORY_SCOPE_AGENT); }
__device__ __forceinline__ unsigned xb_xcc_id() { return (unsigned)__builtin_amdgcn_s_getreg((3 << 11) | 20) & 0xFu; }
#define XB_SPIN(cond, bar) do { unsigned _sp = 0; while (cond) { __builtin_amdgcn_s_sleep(1); \
    if ((++_sp & 255u) == 0u) { if (xb_ld(&(bar)[XB_TMO])) break; if (_sp > XB_SPIN_CAP) { atomicAdd(&(bar)[XB_TMO], 1u); break; } } } } while (0)
struct XcdBarrier { unsigned* bar; unsigned x; volatile LAS unsigned* st; };
__device__ __forceinline__ XcdBarrier xcd_barrier_post(unsigned* bar, volatile LAS unsigned* st, bool t0) {
    XcdBarrier b; b.bar = bar; b.x = xb_xcc_id(); b.st = st;
    if (t0) (void)xb_add(&bar[XB_XCNT(b.x)], 1u);
    return b;
}
__device__ __forceinline__ void xcd_barrier_complete(unsigned* bar, unsigned x, unsigned& nloc, unsigned& nx) {
    const unsigned G = gridDim.x * gridDim.y * gridDim.z;
    unsigned sum, cnt, mine, sp = 0u;
    for (;;) {
        sum = 0u; cnt = 0u; mine = 0u;
#pragma unroll
        for (unsigned j = 0; j < 16; ++j) { const unsigned c = xb_ld(&bar[XB_XCNT(j)]); sum += c; cnt += (c > 0u) ? 1u : 0u; mine = (j == x) ? c : mine; }
        if (sum == G) break;
        __builtin_amdgcn_s_sleep(1);
        if ((++sp & 255u) == 0u) { if (xb_ld(&bar[XB_TMO])) break; if (sp > XB_SPIN_CAP) { atomicAdd(&bar[XB_TMO], 1u); break; } }
    }
    nloc = mine > 0u ? mine : 1u; nx = cnt > 0u ? cnt : 1u;
}
__device__ __forceinline__ void xcd_barrier(const XcdBarrier& b, bool t0) {
    asm volatile("s_waitcnt vmcnt(0)" ::: "memory");
    __syncthreads();
    if (t0) {
        unsigned* bar = b.bar;
        __builtin_amdgcn_s_waitcnt(0);
        unsigned nloc = b.st[0], nx = b.st[1];
        if (nloc == 0u) { xcd_barrier_complete(bar, b.x, nloc, nx); b.st[0] = nloc; b.st[1] = nx; }
        const unsigned old = xb_add(&bar[XB_XSUB(b.x)], 1u);
        const unsigned gen = old / nloc;
        if (old + 1u == (gen + 1u) * nloc) {
            __builtin_amdgcn_fence(__ATOMIC_RELEASE, "agent");
            asm volatile("s_waitcnt vmcnt(0)" ::: "memory");
            const unsigned og = xb_add(&bar[XB_TOP], 1u);
            const unsigned tg = og / nx;
            if (og + 1u == (tg + 1u) * nx) xb_add(&bar[XB_TOPGEN], 1u);
            else XB_SPIN(xb_ld(&bar[XB_TOPGEN]) == tg, bar);
            __builtin_amdgcn_fence(__ATOMIC_ACQUIRE, "agent");
            xb_add(&bar[XB_XGEN(b.x)], 1u);
            asm volatile("s_waitcnt vmcnt(0)" ::: "memory");
        } else {
            XB_SPIN(xb_ld(&bar[XB_XGEN(b.x)]) == gen, bar);
            __builtin_amdgcn_fence(__ATOMIC_ACQUIRE, "agent");
            asm volatile("s_waitcnt vmcnt(0)" ::: "memory");
        }
    }
    __syncthreads();
}
#define XB_FLAG_A (XCD_BAR_WORDS + 64)
__device__ __forceinline__ void flag_signal(unsigned* bar, int word, bool t0) {
    asm volatile("s_waitcnt vmcnt(0)" ::: "memory");
    __syncthreads();
    if (t0) { __builtin_amdgcn_fence(__ATOMIC_RELEASE, "agent"); asm volatile("s_waitcnt vmcnt(0)" ::: "memory"); (void)xb_add(&bar[word], 1u); }
}
__device__ __forceinline__ void flag_wait(unsigned* bar, int word, bool t0) {
    if (t0) { const unsigned G = gridDim.x; XB_SPIN(xb_ld(&bar[word]) < G, bar); __builtin_amdgcn_fence(__ATOMIC_ACQUIRE, "agent"); asm volatile("s_waitcnt vmcnt(0)" ::: "memory"); }
    __syncthreads();
}

namespace pg8 {
typedef int v4i_t __attribute__((ext_vector_type(4)));
typedef int v8i_t __attribute__((ext_vector_type(8)));
constexpr int BM = 256, BK = 64, HALF = 128, HTB = HALF * BK * 2, STAGE_BYTES = 8 * HTB;
__host__ __device__ __forceinline__ int lds_byte(int r, int c) { const int st = (r >> 4) * 2 + (c >> 5), rr = r & 15, cc = c & 31, ob = rr * 64 + cc * 2; return st * 1024 + (ob ^ (((ob >> 9) & 1) << 5)); }
__host__ __device__ __forceinline__ void stage_rc(int b, int& R, int& C) { const int st = b / 1024, sb = b % 1024, swz = sb ^ (((sb >> 9) & 1) << 5); R = (st >> 1) * 16 + swz / 64; C = (st & 1) * 32 + (swz % 64) / 2; }
__device__ __forceinline__ const char* uni_ptr64(const char* p) { const unsigned long u = (unsigned long)p;
    const unsigned lo = __builtin_amdgcn_readfirstlane((unsigned)u), hi = __builtin_amdgcn_readfirstlane((unsigned)(u >> 32)); return (const char*)(((unsigned long)hi << 32) | lo); }
__device__ __forceinline__ void glds16_s(const char* sbase, unsigned voff, unsigned lds_dst) { unsigned keep;
    asm volatile("s_mov_b32 %0, m0\n\ts_mov_b32 m0, %3\n\ts_nop 0\n\tglobal_load_lds_dwordx4 %1, %2\n\ts_mov_b32 m0, %0" : "=&s"(keep) : "v"(voff), "s"(sbase), "s"(lds_dst) : "memory"); }
__host__ __device__ __forceinline__ int perm32(int rho) { const int n = rho >> 4, i = rho & 15; return 8 * (i >> 2) + 4 * n + (i & 3); }

struct Unit { long aoff, boff; int gofs; int pm, pn, sub; };
struct Gemm { const char* A; const char* Bt; int lda, ldb, nt; const LAS int* gl; };

template <class Epi, class Sched, bool ALIGN_EPI, bool GATHER, bool FP8 = false, bool MIXED = false>
__device__ __forceinline__ void gemm_phase(LAS unsigned char* lds, const Gemm g, const Sched& S, Epi& E, int wid) {
    const int lane = lane_id(), tid = wid * 64 + lane, wr = wid >> 2, wc = wid & 3, fr = lane & 15, fq = lane >> 4;
    const int nt = g.nt;
    int Rr[2], Cb[2]; unsigned voffB[2], voffA[2][2];
#pragma unroll
    for (int i = 0; i < 2; ++i) { int R, C; stage_rc(tid * 16 + i * 8192, R, C); const int Rb = Epi::PERM ? ((R & ~31) + perm32(R & 31)) : R;
        Rr[i] = R; Cb[i] = C * 2; voffB[i] = (unsigned)(Rb * g.ldb + C * 2); }
    const size_t kstep = (size_t)(BK * 2);
    const size_t hstepB = (size_t)HALF * g.ldb;
    const unsigned ldsw = (unsigned)wid * 1024u;
    const unsigned lds_u = (unsigned)(unsigned long)(LAS unsigned char*)lds;

#define PG8_SETA(u) do { _Pragma("unroll") for (int _h = 0; _h < 2; ++_h) _Pragma("unroll") for (int _i = 0; _i < 2; ++_i) { const int _row = _h * HALF + Rr[_i]; \
        const int _src = GATHER ? g.gl[(u).gofs + _row] : _row; voffA[_h][_i] = (unsigned)_src * (unsigned)g.lda + (unsigned)Cb[_i]; } } while (0)
#define PG8_SA(b, h) (((b) * 2 + (h)) * HTB)
#define PG8_SB(b, h) ((4 + (b) * 2 + (h)) * HTB)
#define PG8_STAGE_A(bufoff, gbase, h) do { _Pragma("unroll") for (int _i = 0; _i < 2; ++_i) \
        glds16_s((const char*)(gbase), voffA[h][_i], lds_u + (unsigned)(bufoff) + ldsw + _i * 8192u); } while (0)
#define PG8_STAGE_B(bufoff, gbase) do { _Pragma("unroll") for (int _i = 0; _i < 2; ++_i) \
        glds16_s((const char*)(gbase), voffB[_i], lds_u + (unsigned)(bufoff) + ldsw + _i * 8192u); } while (0)
#define PG8_LDA(dst, b, h) do { if constexpr (FP8) { _Pragma("unroll") for (int m = 0; m < 4; ++m) { const LAS unsigned char* p_ = lds + PG8_SA(b, h) + aoff + m * 2048; \
            dst##8[m] = __builtin_shufflevector(*(const LAS v4i_t*)p_, *(const LAS v4i_t*)(p_ + 1024), 0, 1, 2, 3, 4, 5, 6, 7); } } \
        else { _Pragma("unroll") for (int m = 0; m < 4; ++m) _Pragma("unroll") for (int k = 0; k < 2; ++k) dst[m][k] = *(const LAS bf16x8*)(lds + PG8_SA(b, h) + aoff + m * 2048 + k * 1024); } } while (0)
#define PG8_LDB(dst, b, h) do { if constexpr (FP8) { _Pragma("unroll") for (int n = 0; n < 2; ++n) { const LAS unsigned char* p_ = lds + PG8_SB(b, h) + boff + n * 2048; \
            dst##8[n] = __builtin_shufflevector(*(const LAS v4i_t*)p_, *(const LAS v4i_t*)(p_ + 1024), 0, 1, 2, 3, 4, 5, 6, 7); } } \
        else { _Pragma("unroll") for (int n = 0; n < 2; ++n) _Pragma("unroll") for (int k = 0; k < 2; ++k) dst[n][k] = *(const LAS bf16x8*)(lds + PG8_SB(b, h) + boff + n * 2048 + k * 1024); } } while (0)
#define PG8_MMA(ai, bj, At, Bt) do { __builtin_amdgcn_s_setprio(1); if constexpr (F8U) { _Pragma("unroll") for (int m = 0; m < 4; ++m) _Pragma("unroll") for (int n = 0; n < 2; ++n) \
        acc[ai][bj][m][n] = __builtin_amdgcn_mfma_scale_f32_16x16x128_f8f6f4(Bt##8[n], At##8[m], acc[ai][bj][m][n], 0, 0, 0, 0, 0, 0); } \
        else if constexpr (FP8) { _Pragma("unroll") for (int m = 0; m < 4; ++m) _Pragma("unroll") for (int n = 0; n < 2; ++n) {   \
        acc[ai][bj][m][n] = __builtin_amdgcn_mfma_f32_16x16x32_bf16(__builtin_bit_cast(bf16x8, __builtin_shufflevector(Bt##8[n], Bt##8[n], 0, 1, 2, 3)), __builtin_bit_cast(bf16x8, __builtin_shufflevector(At##8[m], At##8[m], 0, 1, 2, 3)), acc[ai][bj][m][n], 0, 0, 0); \
        acc[ai][bj][m][n] = __builtin_amdgcn_mfma_f32_16x16x32_bf16(__builtin_bit_cast(bf16x8, __builtin_shufflevector(Bt##8[n], Bt##8[n], 4, 5, 6, 7)), __builtin_bit_cast(bf16x8, __builtin_shufflevector(At##8[m], At##8[m], 4, 5, 6, 7)), acc[ai][bj][m][n], 0, 0, 0); } } \
        else { _Pragma("unroll") for (int m = 0; m < 4; ++m) _Pragma("unroll") for (int n = 0; n < 2; ++n) _Pragma("unroll") for (int k = 0; k < 2; ++k) \
        acc[ai][bj][m][n] = __builtin_amdgcn_mfma_f32_16x16x32_bf16(Bt[n][k], At[m][k], acc[ai][bj][m][n], 0, 0, 0); } __builtin_amdgcn_s_setprio(0); } while (0)
#define PG8_WR_NOW() ({ int w_ = wid; asm volatile("" : "+s"(w_)); w_ >> 2; })
#define PG8_WAIT_V(n) asm volatile("s_waitcnt vmcnt(" #n ")" ::: "memory")
#define PG8_WAIT_L(n) asm volatile("s_waitcnt lgkmcnt(" #n ")" ::: "memory")
#define PG8_BAR __builtin_amdgcn_s_barrier()
#define PG8_SCHED __builtin_amdgcn_sched_barrier(0)
#define PG8_KLOOP(F8U_, NTU_) do { constexpr bool F8U = (F8U_); const int nt_u = (NTU_); \
_Pragma("nounroll") for (int t = 0; t < nt_u; t += 2) { \
            const bool last = (t == nt_u - 2); \
            const char* a1 = cA + (size_t)(t + 1) * kstep; \
            const char* a2 = last ? nA : cA + (size_t)(t + 2) * kstep; const char* b2 = last ? nB : cB + (size_t)(t + 2) * kstep; \
            const char* a3 = a2 + kstep; const char* b3 = b2 + kstep; \
            PG8_LDB(B0, 0, 0); PG8_LDB(B1, 0, 1); PG8_SCHED; PG8_LDA(At, 0, 0); PG8_STAGE_A(PG8_SA(1, 1), a1, 1); \
            if (GATHER) { if (last && has_next) PG8_SETA(nxt); } \
            PG8_WAIT_V(8); PG8_WAIT_L(0); PG8_BAR; PG8_MMA(0, 0, At, B0); PG8_MMA(0, 1, At, B1); PG8_BAR; PG8_SCHED; \
            PG8_LDA(At, 0, 1); PG8_STAGE_B(PG8_SB(0, 0), b2); PG8_STAGE_B(PG8_SB(0, 1), b2 + hstepB); PG8_STAGE_A(PG8_SA(0, 0), a2, 0); \
            PG8_WAIT_V(8); PG8_WAIT_L(0); PG8_BAR; PG8_MMA(1, 0, At, B0); PG8_MMA(1, 1, At, B1); PG8_BAR; PG8_SCHED; \
            PG8_LDB(B0, 1, 0); PG8_LDB(B1, 1, 1); PG8_SCHED; PG8_LDA(At, 1, 0); PG8_STAGE_A(PG8_SA(0, 1), a2, 1); \
            PG8_WAIT_V(8); PG8_WAIT_L(0); PG8_BAR; PG8_MMA(0, 0, At, B0); PG8_MMA(0, 1, At, B1); PG8_BAR; PG8_SCHED; \
            PG8_LDA(At, 1, 1); PG8_STAGE_B(PG8_SB(1, 0), b3); PG8_STAGE_B(PG8_SB(1, 1), b3 + hstepB); PG8_STAGE_A(PG8_SA(1, 0), a3, 0); \
            PG8_WAIT_V(8); PG8_WAIT_L(0); PG8_BAR; PG8_MMA(1, 0, At, B0); PG8_MMA(1, 1, At, B1); PG8_BAR; PG8_SCHED; \
        } } while (0)
    Unit cur, nxt; int ui = 0;
    if (!S.next(0, cur)) return;
    f32x4 acc[2][2][4][2];
    bf16x8 At[4][2], B0[2][2], B1[2][2];
    v8i_t At8[4], B08[2], B18[2];
    const char* cA = g.A + cur.aoff; const char* cB = g.Bt + cur.boff;
    PG8_SETA(cur);
    if (GATHER) PG8_WAIT_L(0);
    PG8_STAGE_B(PG8_SB(0, 0), cB); PG8_STAGE_B(PG8_SB(0, 1), cB + hstepB); PG8_STAGE_A(PG8_SA(0, 0), cA, 0); PG8_STAGE_A(PG8_SA(0, 1), cA, 1);
    if (PG8_WR_NOW() == 1) PG8_BAR;
    PG8_WAIT_V(2); PG8_BAR;
    PG8_STAGE_B(PG8_SB(1, 0), cB + kstep); PG8_STAGE_A(PG8_SA(1, 0), cA + kstep, 0); PG8_STAGE_B(PG8_SB(1, 1), cB + hstepB + kstep);
    PG8_WAIT_V(6); PG8_BAR;
#pragma unroll
    for (int a = 0; a < 2; ++a)
#pragma unroll
        for (int b = 0; b < 2; ++b)
#pragma unroll
            for (int m = 0; m < 4; ++m)
#pragma unroll
                for (int n = 0; n < 2; ++n) acc[a][b][m][n] = (f32x4){0.f, 0.f, 0.f, 0.f};
    const int aoff = lds_byte(wr * 64 + fr, fq * 8), boff = lds_byte(wc * 32 + fr, fq * 8);
#define PG8_UNIT(F8V_, NTV_) { \
        const bool has_next = S.next(ui + 1, nxt); \
        const char* nA = has_next ? g.A + nxt.aoff : cA; const char* nB = has_next ? g.Bt + nxt.boff : cB; \
        PG8_KLOOP(F8V_, NTV_); \
        if constexpr (ALIGN_EPI) { if (PG8_WR_NOW() == 0) PG8_BAR; } \
        const int le_ = lane_id(); \
        const bool keep = E(acc, cur, wr, wc, le_ & 15, le_ >> 4); \
        if (!has_next) break; \
        if (!keep) { \
            _Pragma("unroll") for (int a = 0; a < 2; ++a) _Pragma("unroll") for (int b = 0; b < 2; ++b) _Pragma("unroll") for (int m = 0; m < 4; ++m) _Pragma("unroll") for (int n = 0; n < 2; ++n) acc[a][b][m][n] = (f32x4){0.f, 0.f, 0.f, 0.f}; \
        } \
        cur = nxt; cA = nA; cB = nB; ++ui; \
        if constexpr (ALIGN_EPI) { if (PG8_WR_NOW() == 1) PG8_BAR; } }
    for (;;) {
        if constexpr (MIXED) { PG8_UNIT(false, 2 * nt) PG8_UNIT(true, nt) PG8_UNIT(true, nt) }
        else { PG8_UNIT(FP8, nt) }
    }
#undef PG8_UNIT
    PG8_WAIT_V(0);
    if constexpr (!ALIGN_EPI) { if (PG8_WR_NOW() == 0) PG8_BAR; }
    PG8_BAR;
#undef PG8_SETA
#undef PG8_SA
#undef PG8_SB
#undef PG8_STAGE_A
#undef PG8_STAGE_B
#undef PG8_LDA
#undef PG8_LDB
#undef PG8_MMA
#undef PG8_WAIT_V
#undef PG8_WR_NOW
#undef PG8_WAIT_L
#undef PG8_BAR
#undef PG8_SCHED
}
}

__device__ __forceinline__ int g64_col(int wc, int bj, int fq) { return 64 * wc + 32 * bj + 8 * fq; }
__host__ __device__ __forceinline__ int map_g64(int L) { const int l = L & 255; return (L & ~255) + 128 * ((l & 63) >> 5) + 32 * (l >> 6) + (l & 31); }
__host__ __device__ __forceinline__ int map_up(int n) { const int half = n >> 9, c = n & 511; return 256 * (c >> 7) + 128 * half + (c & 127); }

struct Frame {
    LAS unsigned char* lds;
    int wave, vcu, G;
    unsigned char* ws;
};

template <int MAP>
__device__ __forceinline__ int p0_rowmap(int Lbase, int n) {
    if (MAP == 0) return n;
    if (MAP == 2) return map_up(n);
    int L = Lbase + n;
    if (MAP == 3 && L >= 512) { const int a = L & 127; L = (L & ~127) + (a & 3) * 32 + (a >> 2); }
    return map_g64(L);
}
template <int MAP>
__device__ __forceinline__ void p0_transpose_item(const float* W, int ldw, int ncols, int K, bf16* WT, int Lbase, LAS float* scr, int item, int lane) {
    const int nblk = ncols / 32, kb = item / nblk, nb = item % nblk, k0 = 64 * kb, n0 = 32 * nb;
    const float* wp = W + (size_t)(k0 + (lane >> 5)) * ldw + n0 + (lane & 31);
#pragma unroll
    for (int hb = 0; hb < 2; ++hb) {
        float v[16];
#pragma unroll
        for (int i = 0; i < 16; ++i) v[i] = __builtin_nontemporal_load(wp + (size_t)(2 * (16 * hb + i)) * ldw);
        __builtin_amdgcn_sched_barrier(0);
#pragma unroll
        for (int i = 0; i < 16; ++i) scr[(2 * (16 * hb + i) + (lane >> 5)) * 33 + (lane & 31)] = v[i];
        __builtin_amdgcn_sched_barrier(0);
    }
    LDS_WAIT(); asm volatile("" ::: "memory");
    const int c = lane & 7;
#pragma unroll
    for (int j = 0; j < 4; ++j) { const int n = (lane >> 3) + 8 * j; const LAS float* s = scr + (8 * c) * 33 + n;
        u32x4 o; o.x = cvt_pk_bf16(s[0 * 33], s[1 * 33]); o.y = cvt_pk_bf16(s[2 * 33], s[3 * 33]); o.z = cvt_pk_bf16(s[4 * 33], s[5 * 33]); o.w = cvt_pk_bf16(s[6 * 33], s[7 * 33]);
        *(u32x4*)(WT + (size_t)p0_rowmap<MAP>(Lbase, n0 + n) * K + k0 + 8 * c) = o; }
    LDS_WAIT(); asm volatile("" ::: "memory");
}

template <int MAP>
__device__ __forceinline__ void p0_transpose_item8(const float* W, int ldw, int ncols, int K, unsigned char* WT8, int Lbase, float scale, LAS float* scr, int item, int lane) {
    const int nblk = ncols / 32, kb = item / nblk, nb = item % nblk, k0 = 64 * kb, n0 = 32 * nb;
    const float* wp = W + (size_t)(k0 + (lane >> 5)) * ldw + n0 + (lane & 31);
#pragma unroll
    for (int hb = 0; hb < 2; ++hb) {
        float v[16];
#pragma unroll
        for (int i = 0; i < 16; ++i) v[i] = __builtin_nontemporal_load(wp + (size_t)(2 * (16 * hb + i)) * ldw);
        __builtin_amdgcn_sched_barrier(0);
#pragma unroll
        for (int i = 0; i < 16; ++i) scr[(2 * (16 * hb + i) + (lane >> 5)) * 33 + (lane & 31)] = v[i] * scale;
        __builtin_amdgcn_sched_barrier(0);
    }
    LDS_WAIT(); asm volatile("" ::: "memory");
    const int c = lane & 3;
#pragma unroll
    for (int j = 0; j < 2; ++j) { const int n = (lane >> 2) + 16 * j; const LAS float* s = scr + (16 * c) * 33 + n;
        u32x4 o; o.x = cvt4_fp8(s[0 * 33], s[1 * 33], s[2 * 33], s[3 * 33]); o.y = cvt4_fp8(s[4 * 33], s[5 * 33], s[6 * 33], s[7 * 33]);
        o.z = cvt4_fp8(s[8 * 33], s[9 * 33], s[10 * 33], s[11 * 33]); o.w = cvt4_fp8(s[12 * 33], s[13 * 33], s[14 * 33], s[15 * 33]);
        *(u32x4*)(WT8 + (size_t)p0_rowmap<MAP>(Lbase, n0 + n) * K + k0 + 16 * c) = o; }
    LDS_WAIT(); asm volatile("" ::: "memory");
}

__device__ __forceinline__ void phase0(Frame& F, const Params& P) {
    const float* x = P.in[0]; const float* mem = P.in[1]; const int* pos = (const int*)P.in[2];
    const float* g_attn = P.in[3]; const float* w_in = P.in[4]; const float* fbias = P.in[11]; const float* g_mem = P.in[12];
    unsigned char* ws = F.ws;
    bf16* H = (bf16*)P.out;
    unsigned char* H8 = (unsigned char*)P.out + 128 * MiB;
    const int tid0 = F.wave * 64 + lane_id();
    const int lane = tid0 & 63, wave = F.wave;
    const int gw_ = F.vcu * 8 + wave, NGW = F.G * 8;
    {
        unsigned char* MEMN = ws + WS_MEMN;
        for (int m = gw_; m < NB * MEML; m += NGW) {
            const f32x4* xr = (const f32x4*)(mem + (size_t)m * DM) + lane; f32x4 v[4]; float ss = 0.f;
#pragma unroll
            for (int j = 0; j < 4; ++j) { v[j] = xr[64 * j]; ss += (v[j][0] * v[j][0] + v[j][1] * v[j][1]) + (v[j][2] * v[j][2] + v[j][3] * v[j][3]); }
            const float rstd = 1.0f / sqrtf(wave_sum(ss) * (1.f / DM) + EPS);
            unsigned* o4 = (unsigned*)(MEMN + (size_t)m * DM) + lane;
#pragma unroll
            for (int j = 0; j < 4; ++j) { const f32x4 hn = v[j] * rstd * *(const f32x4*)(g_mem + 256 * j + 4 * lane);
                o4[64 * j] = cvt4_fp8(hn[0], hn[1], hn[2], hn[3]); }
        }
    }
    {
        float* ROPE = (float*)(ws + WS_ROPE);
        const int gt = (blockIdx.x * 512 + tid0), NT_ = F.G * 512;
        for (int e = gt; e < T * 8; e += NT_) {
            const int t = e >> 3, i = e & 7;
            const double inv_rev = exp2(-(double)i * (18.931568569324174 / 8.0)) * 0.15915494309189535;
            double r = (double)pos[t] * inv_rev; r -= floor(r);
            const float rf = (float)r;
            ROPE[(size_t)t * 16 + i] = __builtin_amdgcn_cosf(rf); ROPE[(size_t)t * 16 + 8 + i] = __builtin_amdgcn_sinf(rf);
        }
    }
    {
        bf16* WR = (bf16*)(ws + WS_WR); const float* wrg = P.in[21]; const float* wre = P.in[23]; const float* gffn = P.in[20];
        const int gt = (blockIdx.x * 512 + tid0), NT_ = F.G * 512;
        for (int e = gt; e < 64 * 1024; e += NT_) { const int n = e >> 10, k = e & 1023;
            const float v = (n < 4 ? wrg[k * 4 + n] : (n < 36 ? wre[k * 32 + (n - 4)] : 0.f)) * gffn[k];
            WR[e] = (bf16)(cvt_pk_bf16(v, 0.f) & 0xffffu); }
    }
    {
        LAS float* scr = (LAS float*)(F.lds + 8192 + wave * 12288);
        constexpr int I_IN1 = 16 * 48, I_IN2 = 16 * 16, I_IN4 = 16 * 32, I_ING = 16 * 96, I_MKV = 16 * 32, I_WO = 8 * 32, I_WOUT = 16 * 32, I_UP = 16 * 32, I_DN = 8 * 32;
        constexpr int NITEMS = I_IN1 + I_IN4 + 2 * I_IN2 + I_ING + I_MKV + 3 * I_WO + I_WOUT + NEXP * I_UP + NEXP * I_DN;
        for (int it = gw_; it < NITEMS; it += NGW) {
            int r = it;
            if (r < I_IN1) { p0_transpose_item<1>(w_in, IN_COLS, 1536, DM, (bf16*)(ws + WS_WIN), 0, scr, r, lane); continue; } r -= I_IN1;
            if (r < I_IN4) { p0_transpose_item8<1>(w_in + 1536, IN_COLS, 1024, DM, ws + WS_WQK8, 0, 32.f, scr, r, lane); continue; } r -= I_IN4;
            if (r < I_IN2) { p0_transpose_item8<1>(w_in + 2560, IN_COLS, 512, DM, ws + WS_W8, 0, 32.f, scr, r, lane); continue; } r -= I_IN2;
            if (r < I_IN2) { p0_transpose_item8<1>(w_in + 3080, IN_COLS, 512, DM, ws + WS_W8, 512, 32.f, scr, r, lane); continue; } r -= I_IN2;
            if (r < I_ING) { p0_transpose_item8<1>(w_in + 3592, IN_COLS, 3072, DM, ws + WS_W8, 1024, 32.f, scr, r, lane); continue; } r -= I_ING;
            if (r < I_MKV) { p0_transpose_item8<3>(P.in[13], 1024, 1024, DM, ws + WS_WMKV, 0, 32.f, scr, r, lane); continue; } r -= I_MKV;
            if (r < I_WO) { p0_transpose_item<1>(P.in[16], 1024, 1024, 512, (bf16*)(ws + WS_WO), 0, scr, r, lane); continue; } r -= I_WO;
            if (r < 2 * I_WO) { const int w = r / I_WO; p0_transpose_item8<1>(P.in[17 + w], 1024, 1024, 1024, ws + WS_WO + MiB + (size_t)w * 1024 * 1024, 0, 16.f, scr, r % I_WO, lane); continue; } r -= 2 * I_WO;
            if (r < I_WOUT) { p0_transpose_item<0>(P.in[19], 1024, 1024, DM, (bf16*)(ws + WS_WOUT), 0, scr, r, lane); continue; } r -= I_WOUT;
            if (r < NEXP * I_UP) { const int e = r / I_UP; p0_transpose_item8<2>(P.in[25] + (size_t)e * 1024 * 1024, 1024, 1024, DM, ws + WS_WUP + (size_t)e * 1024 * 1024, 0, 32.f, scr, r % I_UP, lane); continue; } r -= NEXP * I_UP;
            { const int e = r / I_DN; p0_transpose_item8<0>(P.in[26] + (size_t)e * 512 * 1024, 1024, 1024, 512, ws + WS_WDN + (size_t)e * 1024 * 512, 0, 16.f, scr, r % I_DN, lane); }
        }
    }
    __syncthreads();
    {
        float gw[4][4][8];
#pragma unroll
        for (int j = 0; j < 4; ++j)
#pragma unroll
            for (int e = 0; e < 4; ++e) { const int k = 256 * j + 4 * lane + e; const float gk = g_attn[k];
                const f32x4 w0 = *(const f32x4*)(w_in + (size_t)k * IN_COLS + 3072), w1 = *(const f32x4*)(w_in + (size_t)k * IN_COLS + 3076);
                gw[j][e][0] = gk * w0[0]; gw[j][e][1] = gk * w0[1]; gw[j][e][2] = gk * w0[2]; gw[j][e][3] = gk * w0[3];
                gw[j][e][4] = gk * w1[0]; gw[j][e][5] = gk * w1[1]; gw[j][e][6] = gk * w1[2]; gw[j][e][7] = gk * w1[3]; }
        f32x4 gv[4];
#pragma unroll
        for (int j = 0; j < 4; ++j) gv[j] = *(const f32x4*)(g_attn + 256 * j + 4 * lane);
        const float fb = fbias[lane & 7];
        LAS float* lf = (LAS float*)(F.lds);
        float* CUM = (float*)(ws + WS_CUM); float* CHTOT = (float*)(ws + WS_CHTOT);
        for (int ch = blockIdx.x; ch < T / 256; ch += F.G) {
            f32x4 vn[4];
            { const f32x4* xr0 = (const f32x4*)(x + (size_t)(ch * 256 + wave * 32) * DM) + lane;
#pragma unroll
              for (int j = 0; j < 4; ++j) vn[j] = __builtin_nontemporal_load(xr0 + 64 * j); }
            for (int rr = 0; rr < 32; ++rr) {
                const int row = ch * 256 + wave * 32 + rr;
                f32x4 v[4]; float ss = 0.f;
#pragma unroll
                for (int j = 0; j < 4; ++j) v[j] = vn[j];
                if (rr + 1 < 32) { const f32x4* xr1 = (const f32x4*)(x + (size_t)(row + 1) * DM) + lane;
#pragma unroll
                    for (int j = 0; j < 4; ++j) vn[j] = __builtin_nontemporal_load(xr1 + 64 * j); }
#pragma unroll
                for (int j = 0; j < 4; ++j) ss += (v[j][0] * v[j][0] + v[j][1] * v[j][1]) + (v[j][2] * v[j][2] + v[j][3] * v[j][3]);
                const float rstd = 1.0f / sqrtf(wave_sum(ss) * (1.f / DM) + EPS);
                float f[8];
#pragma unroll
                for (int h = 0; h < 8; ++h) f[h] = 0.f;
                unsigned long long* o8 = (unsigned long long*)(H + (size_t)row * DM) + lane;
#pragma unroll
                for (int j = 0; j < 4; ++j) {
#pragma unroll
                    for (int e = 0; e < 4; ++e) {
#pragma unroll
                        for (int h = 0; h < 8; ++h) f[h] += v[j][e] * gw[j][e][h]; }
                    const f32x4 hn = v[j] * rstd * gv[j];
                    o8[64 * j] = (unsigned long long)cvt_pk_bf16(hn[0], hn[1]) | ((unsigned long long)cvt_pk_bf16(hn[2], hn[3]) << 32);
                    ((unsigned*)(H8 + (size_t)row * DM))[64 * j + lane] = cvt4_fp8(hn[0], hn[1], hn[2], hn[3]);
                }
                float mine = 0.f;
#pragma unroll
                for (int h = 0; h < 8; ++h) { const float s = wave_sum(f[h]); if ((lane & 7) == h) mine = s; }
                if (lane < 8) { const float z = mine * rstd + fb; lf[(wave * 32 + rr) * 8 + lane] = -log1pf(__expf(-z)); }
            }
            __syncthreads();
            if (wave == 0) {
                const int seg = lane >> 3, h = lane & 7; float a = 0.f;
                for (int i = 0; i < 32; ++i) { a += lf[(seg * 32 + i) * 8 + h]; lf[(seg * 32 + i) * 8 + h] = a; }
                float incl = a, t;
                t = __shfl_up(incl, 8); if (seg >= 1) incl += t;
                t = __shfl_up(incl, 16); if (seg >= 2) incl += t;
                t = __shfl_up(incl, 32); if (seg >= 4) incl += t;
                const float excl = incl - a;
                const int b = ch >> 4, s0 = (ch & 15) * 256;
                float* dst = CUM + ((size_t)(b * 8 + h) * SEQ + s0 + seg * 32);
                for (int i = 0; i < 32; ++i) dst[i] = lf[(seg * 32 + i) * 8 + h] + excl;
                if (seg == 7) CHTOT[ch * 8 + h] = incl;
            }
            __syncthreads();
        }
    }
}

struct GridOrder {
    int nM, nN, nwg, G, c; long astep, bstep;
    __device__ void init(int nM_, int nN_, int G_, int c_, long astep_, long bstep_) { nM = nM_; nN = nN_; nwg = nM * nN; G = G_; c = c_; astep = astep_; bstep = bstep_; }
    __device__ bool next(int i, pg8::Unit& u) const {
        const long L = (long)i * G + c; if (L >= nwg) return false;
        int wgid = (int)L; { const int q = nwg / 8, r = nwg % 8, xcd = wgid % 8, off = wgid / 8; wgid = (xcd < r ? xcd * (q + 1) : r * (q + 1) + (xcd - r) * q) + off; }
        const int nig = 8 * nN, gid = wgid / nig, fm = gid * 8, gsz = (nM - fm) < 8 ? (nM - fm) : 8;
        u.pm = fm + ((wgid % nig) % gsz); u.pn = (wgid % nig) / gsz; u.aoff = (long)u.pm * astep; u.boff = (long)u.pn * bstep; u.gofs = 0; u.sub = 0; return true;
    }
};

struct EpiProj {
    static constexpr bool PERM = true;
    bf16* QB; bf16* KVB; bf16* GT; const float* rope; const float* g_dq; const float* g_dk; const float* g_fq; const float* g_fk; int fp8part;
    __device__ __forceinline__ bool operator()(f32x4 (&acc)[2][2][4][2], const pg8::Unit& u, int wr, int wc, int fr_in, int fq_in) const {
        int fr = fr_in, fq = fq_in; asm volatile("" : "+v"(fr), "+v"(fq));
        const int pn = fp8part ? u.pn + 10 : u.pn;
        int kind; const float* gptr = g_dq; bf16* base; int pitch, colt; float qs = 1.f; float ps = 1.f;
        if (pn < 2)       { kind = 0; gptr = g_dq; base = QB;  pitch = QP;  colt = pn * 256;               qs = 0.125f * LOG2E; }
        else if (pn < 4)  { kind = 0; gptr = g_dk; base = KVB; pitch = KVP; colt = (pn - 2) * 256; }
        else if (pn < 6)  { kind = 2;         base = KVB; pitch = KVP; colt = 512 + (pn - 4) * 256; }
        else if (pn < 8)  { kind = 1; gptr = g_fq; base = QB;  pitch = QP;  colt = 512 + (pn - 6) * 256;   qs = 0.125f * LOG2E; }
        else if (pn < 10) { kind = 1; gptr = g_fk; base = KVB; pitch = KVP; colt = 1024 + (pn - 8) * 256; }
        else if (pn < 12) { kind = 2;         base = KVB; pitch = KVP; colt = 1536 + (pn - 10) * 256; ps = fp8part ? (1.f / 32.f) : 1.f; }
        else if (pn < 14) { kind = 2;         base = QB;  pitch = QP;  colt = 1024 + (pn - 12) * 256; }
        else              { kind = 3;         base = GT;  pitch = GP;  colt = (pn - 14) * 256; }
        const int row0 = u.pm * 256 + wr * 64 + fr;
        f32x4 gn[2][2];
        if (kind < 2) {
#pragma unroll
            for (int bj = 0; bj < 2; ++bj)
#pragma unroll
                for (int n = 0; n < 2; ++n) gn[bj][n] = *(const f32x4*)(gptr + 32 * bj + 8 * fq + 4 * n);
        }
#pragma unroll
        for (int am = 0; am < 4; ++am) { const int ai = am >> 1, m0 = (am & 1) * 2;
            f32x4 rc[4][2], rsn[4][2];
            if (kind == 0) {
#pragma unroll
                for (int m = m0; m < m0 + 2; ++m)
#pragma unroll
                    for (int n = 0; n < 2; ++n) { const size_t rw = (size_t)(row0 + ai * 128 + m * 16) * 16; rc[m][n] = *(const f32x4*)(rope + rw + 4 * n); rsn[m][n] = *(const f32x4*)(rope + rw + 8 + 4 * n); }
            }
#pragma unroll
            for (int m = m0; m < m0 + 2; ++m) {
                const int row = row0 + ai * 128 + m * 16;
                f32x4 v[2][2];
#pragma unroll
                for (int bj = 0; bj < 2; ++bj)
#pragma unroll
                    for (int n = 0; n < 2; ++n) v[bj][n] = acc[ai][bj][m][n];
                if (kind < 2) {
                    float ss = 0.f;
#pragma unroll
                    for (int bj = 0; bj < 2; ++bj)
#pragma unroll
                        for (int n = 0; n < 2; ++n) ss += (v[bj][n][0] * v[bj][n][0] + v[bj][n][1] * v[bj][n][1]) + (v[bj][n][2] * v[bj][n][2] + v[bj][n][3] * v[bj][n][3]);
                    ss += __shfl_xor(ss, 16); ss += __shfl_xor(ss, 32);
                    const float r = qs / sqrtf(ss * (1.f / 64.f) + EPS);
#pragma unroll
                    for (int bj = 0; bj < 2; ++bj)
#pragma unroll
                        for (int n = 0; n < 2; ++n) v[bj][n] = v[bj][n] * gn[bj][n] * r;
                    if (kind == 0) {
#pragma unroll
                        for (int n = 0; n < 2; ++n) {
                            const f32x4 c = rc[m][n], s = rsn[m][n];
                            f32x4 o;
#pragma unroll
                            for (int j = 0; j < 4; ++j) { const float mine = v[0][n][j], oth = __shfl_xor(mine, 16);
                                o[j] = fq == 0 ? mine * c[j] - oth * s[j] : (fq == 1 ? mine * c[j] + oth * s[j] : mine); }
                            v[0][n] = o;
                        }
                    }
                } else if (kind == 3) {
                    const int t16 = ((wr * 4 + wc) * 64 + lane_id()) * 16;
                    u32x4 w;
#pragma unroll
                    for (int bj = 0; bj < 2; ++bj)
#pragma unroll
                        for (int n = 0; n < 2; ++n) { unsigned pk = 0;
#pragma unroll
                            for (int j = 0; j < 4; ++j) { const float sg = __builtin_amdgcn_rcpf(1.f + __expf(v[bj][n][j] * (-1.f / 32.f))); unsigned q = (unsigned)(sg * 255.f + 0.5f); q = q < 1u ? 1u : q; pk |= q << (8 * j); }
                            w[bj * 2 + n] = pk; }
                    *(u32x4*)((unsigned char*)GT + ((size_t)(u.pm * 12 + (pn - 14)) * 8 + (ai * 4 + m)) * 8192 + (unsigned)t16) = w;
                    continue;
                }
                if (kind == 2) {
#pragma unroll
                    for (int bj = 0; bj < 2; ++bj)
#pragma unroll
                        for (int n = 0; n < 2; ++n) v[bj][n] = v[bj][n] * ps; }
                bf16* rp = base + (size_t)row * pitch + colt + g64_col(wc, 0, fq);
#pragma unroll
                for (int bj = 0; bj < 2; ++bj) { u32x4 w; w.x = cvt_pk_bf16(v[bj][0][0], v[bj][0][1]); w.y = cvt_pk_bf16(v[bj][0][2], v[bj][0][3]); w.z = cvt_pk_bf16(v[bj][1][0], v[bj][1][1]); w.w = cvt_pk_bf16(v[bj][1][2], v[bj][1][3]);
                    *(u32x4*)(rp + 32 * bj) = w; }
            }
        }
        return false;
    }
};

struct EpiNorm {
    static constexpr bool PERM = true;
    bf16* QB; bf16* KVB; const float* g_fq; const float* g_fk;
    __device__ __forceinline__ bool operator()(f32x4 (&acc)[2][2][4][2], const pg8::Unit& u, int wr, int wc, int fr_in, int fq_in) const {
        int fr = fr_in, fq = fq_in; asm volatile("" : "+v"(fr), "+v"(fq));
        const bool isq = u.pn < 2;
        bf16* base = isq ? QB : KVB; const int pitch = isq ? QP : KVP; const int colt = isq ? 512 + u.pn * 256 : 1024 + (u.pn - 2) * 256;
        const float qs = isq ? 0.125f * LOG2E : 1.f; const float* gptr = isq ? g_fq : g_fk;
        const int row0 = u.pm * 256 + wr * 64 + fr;
#pragma unroll
        for (int ai = 0; ai < 2; ++ai)
#pragma unroll
            for (int m = 0; m < 4; ++m) {
                const int row = row0 + ai * 128 + m * 16; float ss = 0.f;
#pragma unroll
                for (int bj = 0; bj < 2; ++bj)
#pragma unroll
                    for (int n = 0; n < 2; ++n) { const f32x4 v = acc[ai][bj][m][n]; ss += (v[0] * v[0] + v[1] * v[1]) + (v[2] * v[2] + v[3] * v[3]); }
                ss += __shfl_xor(ss, 16); ss += __shfl_xor(ss, 32);
                const float r = qs / sqrtf(ss * (1.f / 64.f) + EPS * 1024.f);
                bf16* rp = base + (size_t)row * pitch + colt + g64_col(wc, 0, fq);
#pragma unroll
                for (int bj = 0; bj < 2; ++bj) { const f32x4 g0 = *(const f32x4*)(gptr + 32 * bj + 8 * fq), g1 = *(const f32x4*)(gptr + 32 * bj + 8 * fq + 4);
                    const f32x4 v0 = acc[ai][bj][m][0] * g0 * r, v1 = acc[ai][bj][m][1] * g1 * r;
                    u32x4 w; w.x = cvt_pk_bf16(v0[0], v0[1]); w.y = cvt_pk_bf16(v0[2], v0[3]); w.z = cvt_pk_bf16(v1[0], v1[1]); w.w = cvt_pk_bf16(v1[2], v1[3]);
                    *(u32x4*)(rp + 32 * bj) = w; }
            }
        return false;
    }
};

struct EpiGates {
    static constexpr bool PERM = true;
    unsigned char* GT;
    __device__ __forceinline__ bool operator()(f32x4 (&acc)[2][2][4][2], const pg8::Unit& u, int wr, int wc, int fr, int fq) const {
        const int t16 = ((wr * 4 + wc) * 64 + lane_id()) * 16;
#pragma unroll
        for (int ai = 0; ai < 2; ++ai)
#pragma unroll
            for (int m = 0; m < 4; ++m) { u32x4 w;
#pragma unroll
                for (int bj = 0; bj < 2; ++bj)
#pragma unroll
                    for (int n = 0; n < 2; ++n) { unsigned pk = 0;
#pragma unroll
                        for (int j = 0; j < 4; ++j) { const float sg = __builtin_amdgcn_rcpf(1.f + __expf(acc[ai][bj][m][n][j] * (-1.f / 32.f))); unsigned q = (unsigned)(sg * 255.f + 0.5f); q = q < 1u ? 1u : q; pk |= q << (8 * j); }
                        w[bj * 2 + n] = pk; }
                *(u32x4*)(GT + ((size_t)(u.pm * 12 + u.pn) * 8 + (ai * 4 + m)) * 8192 + (unsigned)t16) = w; }
        return false;
    }
};

struct EpiPlain {
    static constexpr bool PERM = true;
    bf16* O; int pitch; float sc;
    __device__ __forceinline__ bool operator()(f32x4 (&acc)[2][2][4][2], const pg8::Unit& u, int wr, int wc, int fr, int fq) const {
        const int row0 = u.pm * 256 + wr * 64 + fr;
#pragma unroll
        for (int ai = 0; ai < 2; ++ai)
#pragma unroll
            for (int m = 0; m < 4; ++m) { bf16* rp = O + (size_t)(row0 + ai * 128 + m * 16) * pitch + u.pn * 256 + g64_col(wc, 0, fq);
#pragma unroll
                for (int bj = 0; bj < 2; ++bj) { const f32x4 v0 = acc[ai][bj][m][0] * sc, v1 = acc[ai][bj][m][1] * sc; u32x4 w; w.x = cvt_pk_bf16(v0[0], v0[1]); w.y = cvt_pk_bf16(v0[2], v0[3]); w.z = cvt_pk_bf16(v1[0], v1[1]); w.w = cvt_pk_bf16(v1[2], v1[3]);
                    *(u32x4*)(rp + 32 * bj) = w; } }
        return false;
    }
};

struct EpiPlain8 {
    static constexpr bool PERM = true;
    bf16* O; int pitch;
    __device__ __forceinline__ bool operator()(f32x4 (&acc)[2][2][4][2], const pg8::Unit& u, int wr, int wc, int fr, int fq) const {
        const int row0 = u.pm * 256 + wr * 64 + fr;
#pragma unroll
        for (int ai = 0; ai < 2; ++ai)
#pragma unroll
            for (int m = 0; m < 4; ++m) { bf16* rp = O + (size_t)(row0 + ai * 128 + m * 16) * pitch + (u.pn & 7) * 256 + g64_col(wc, 0, fq);
#pragma unroll
                for (int bj = 0; bj < 2; ++bj) { const f32x4 v0 = acc[ai][bj][m][0], v1 = acc[ai][bj][m][1]; u32x4 w; w.x = cvt_pk_bf16(v0[0], v0[1]); w.y = cvt_pk_bf16(v0[2], v0[3]); w.z = cvt_pk_bf16(v1[0], v1[1]); w.w = cvt_pk_bf16(v1[2], v1[3]);
                    *(u32x4*)(rp + 32 * bj) = w; } }
        return false;
    }
};
__device__ __forceinline__ void phase1(Frame& F, const Params& P) {
    unsigned char* ws = F.ws;
    {
        pg8::Gemm g{(const char*)P.out, (const char*)(ws + WS_WIN), DM * 2, DM * 2, DM / 64, nullptr};
        GridOrder S; S.init(T / 256, N1 / 256, F.G, (int)blockIdx.x, 256L * DM * 2, 256L * DM * 2);
#ifdef EXP_P1PLAIN
#ifdef EXP_P1SAME
        if (P.dummy) { EpiPlain8 E{(bf16*)(ws + WS_KVBUF), 2048}; S.astep = 0; S.bstep = 0; pg8::gemm_phase<EpiPlain8, GridOrder, true, false>(F.lds, g, S, E, F.wave); return; }
#endif
        if (P.dummy) { EpiPlain8 E{(bf16*)(ws + WS_KVBUF), 2048}; pg8::gemm_phase<EpiPlain8, GridOrder, true, false>(F.lds, g, S, E, F.wave); return; }
#endif
        EpiProj E{(bf16*)(ws + WS_QBUF), (bf16*)(ws + WS_KVBUF), (bf16*)(ws + WS_GATES), (const float*)(ws + WS_ROPE), P.in[5], P.in[6], P.in[9], P.in[10], 0};
        pg8::gemm_phase<EpiProj, GridOrder, true, false>(F.lds, g, S, E, F.wave);
    }
    {
        pg8::Gemm g{(const char*)P.out + 128 * MiB, (const char*)(ws + WS_WQK8), DM, DM, DM / 128, nullptr};
        GridOrder S; S.init(T / 256, 4, F.G, (int)blockIdx.x, 256L * DM, 256L * DM);
        EpiNorm E{(bf16*)(ws + WS_QBUF), (bf16*)(ws + WS_KVBUF), P.in[9], P.in[10]};
        pg8::gemm_phase<EpiNorm, GridOrder, true, false, true>(F.lds, g, S, E, F.wave);
    }
    {
        pg8::Gemm g{(const char*)P.out + 128 * MiB, (const char*)(ws + WS_W8), DM, DM, DM / 128, nullptr};
        GridOrder S; S.init(T / 256, 16, F.G, (int)blockIdx.x, 256L * DM, 256L * DM);
        EpiProj E{(bf16*)(ws + WS_QBUF), (bf16*)(ws + WS_KVBUF), (bf16*)(ws + WS_GATES), (const float*)(ws + WS_ROPE), P.in[5], P.in[6], P.in[9], P.in[10], 1};
        pg8::gemm_phase<EpiProj, GridOrder, true, false, true>(F.lds, g, S, E, F.wave);
    }
    {
        pg8::Gemm g{(const char*)(ws + WS_MEMN), (const char*)(ws + WS_WMKV), DM, DM, DM / 128, nullptr};
        GridOrder S; S.init(NB * MEML / 256, 4, F.G, (int)blockIdx.x, 256L * DM, 256L * DM);
        EpiPlain E{(bf16*)(ws + WS_MEMKV), DM, 1.f / 32.f};
        pg8::gemm_phase<EpiPlain, GridOrder, true, false, true>(F.lds, g, S, E, F.wave);
    }
}

__device__ __forceinline__ void ta_zero16(f32x16& x) {
#pragma unroll
    for (int r = 0; r < 16; ++r) { float z; asm volatile("v_mov_b32 %0, 0" : "=v"(z)); x[r] = z; }
}
namespace sa {
__device__ __forceinline__ int crow(int r, int hi) { return (r & 3) + 8 * (r >> 2) + 4 * hi; }
constexpr int L_K = 0, L_V = 32768, L_KEY = 65536, L_WSF = 81920, L_PFX = 81920 + 2048;
typedef short v4i16_t __attribute__((ext_vector_type(4)));
__device__ __forceinline__ s16x4 vtr(const LAS unsigned char* p) { return __builtin_bit_cast(s16x4, __builtin_amdgcn_ds_read_tr16_b64_v4i16((LAS v4i16_t*)p)); }

template <int DQK, int DV, int KEYMODE>
__device__ __forceinline__ void unit(const bf16x8* qr, const bf16* Kg, long kpitch, const bf16* Vg, long vpitch, bf16* Og, long opitch,
                                     int NT, int band0, LAS unsigned char* lds, int wid) {
    const int lane = lane_id(), tid = wid * 64 + lane;
    constexpr int NKL = DQK / 64, NVL = DV / 64, KSLOT = 64 * DQK * 2, VSLOT = 64 * DV * 2, ND = DV / 32, NKS = DQK / 16;
    const int r32 = lane & 31, hi = lane >> 5;
    LAS float* wsf = (LAS float*)(lds + L_WSF) + wid * 64;
    const LAS float* keyarr = (const LAS float*)(lds + L_KEY);
    u32x4 kreg[NKL], vreg[NVL];
    const bf16* ksrc = Kg + (long)lane * kpitch + wid * 8;
    const bf16* vsrc = Vg + (long)(16 * (wid & 3) + (lane >> 2)) * vpitch + (wid >> 2) * 32 + (lane & 3) * 8;
#define SA_LOAD(t) do { _Pragma("unroll") for (int c = 0; c < NKL; ++c) kreg[c] = *(const u32x4*)(ksrc + (long)(t) * 64 * kpitch + c * 64); \
                        _Pragma("unroll") for (int c = 0; c < NVL; ++c) vreg[c] = *(const u32x4*)(vsrc + (long)(t) * 64 * vpitch + c * 64); } while (0)
#define SA_WRITE(s) do { _Pragma("unroll") for (int c = 0; c < NKL; ++c) *(LAS u32x4*)(lds + L_K + (s) * KSLOT + (wid + 8 * c) * 1024 + lane * 16) = kreg[c]; \
                         _Pragma("unroll") for (int c = 0; c < NVL; ++c) *(LAS u32x4*)(lds + L_V + (s) * VSLOT + ((wid >> 2) + 2 * c) * 4096 + (wid & 3) * 1024 + lane * 16) = vreg[c]; } while (0)
    float m_run = -INFINITY, l_run = 0.f;
    f32x16 o[ND];
#pragma unroll
    for (int d = 0; d < ND; ++d) o[d] = f32x16{};
    const int vb0 = ((lane >> 4) & 1) * 32 + (lane & 3) * 8 + (4 * hi + ((lane & 15) >> 2)) * 64;
    SA_LOAD(0); SA_WRITE(0);
    __syncthreads();
    for (int t = 0; t < NT; ++t) {
        const int s = t & 1;
        if (t + 1 < NT) SA_LOAD(t + 1);
        const int jb = t - band0;
        const bool active = (jb < 0) || (64 * jb <= 32 * wid + 31);
        if (active) {
            const LAS unsigned char* kb = lds + L_K + s * KSLOT + hi * 1024 + r32 * 16;
            f32x16 p0 = f32x16{}, p1 = f32x16{};
#pragma unroll
            for (int d0 = 0; d0 < NKS; ++d0) {
                const bf16x8 b0 = *(const LAS bf16x8*)(kb + d0 * 2048), b1 = *(const LAS bf16x8*)(kb + d0 * 2048 + 512);
                p0 = __builtin_amdgcn_mfma_f32_32x32x16_bf16(b0, qr[d0], p0, 0, 0, 0);
                p1 = __builtin_amdgcn_mfma_f32_32x32x16_bf16(b1, qr[d0], p1, 0, 0, 0);
            }
            if (KEYMODE != 0) {
#pragma unroll
                for (int r = 0; r < 16; ++r) { const float k0 = keyarr[64 * t + crow(r, hi)], k1 = keyarr[64 * t + 32 + crow(r, hi)];
                    if (KEYMODE == 1) { p0[r] -= k0; p1[r] -= k1; } else { p0[r] *= k0; p1[r] *= k1; } }
            }
            if (jb >= 0) {
                const int qrel = 32 * wid + r32, kb0 = 64 * jb + 4 * hi;
#pragma unroll
                for (int r = 0; r < 16; ++r) { const int kv = kb0 + (r & 3) + 8 * (r >> 2); if (kv > qrel) p0[r] = -INFINITY; if (kv + 32 > qrel) p1[r] = -INFINITY; }
            }
            float rm = fmaxf(p0[0], p1[0]);
#pragma unroll
            for (int r = 1; r < 16; ++r) rm = fmaxf(rm, fmaxf(p0[r], p1[r]));
            rm = fmaxf(rm, __shfl_xor(rm, 32));
            const float m_new = fmaxf(m_run, rm);
            const float alpha = __builtin_amdgcn_exp2f(m_run - m_new);
            m_run = m_new;
            float rs = 0.f;
#pragma unroll
            for (int r = 0; r < 16; ++r) { p0[r] = __builtin_amdgcn_exp2f(p0[r] - m_new); p1[r] = __builtin_amdgcn_exp2f(p1[r] - m_new); rs += p0[r] + p1[r]; }
            l_run = l_run * alpha + rs;
            if (__any(alpha != 1.f)) {
                if (hi == 0) wsf[r32] = alpha;
                LDS_WAIT();
#pragma unroll
                for (int r = 0; r < 16; ++r) { const float a = wsf[crow(r, hi)];
#pragma unroll
                    for (int d = 0; d < ND; ++d) o[d][r] *= a; }
            }
            u32x4 pw[4];
#pragma unroll
            for (int e = 0; e < 4; ++e) { pw[0][e] = cvt_pk_bf16(p0[2 * e], p0[2 * e + 1]); pw[1][e] = cvt_pk_bf16(p0[8 + 2 * e], p0[9 + 2 * e]);
                                          pw[2][e] = cvt_pk_bf16(p1[2 * e], p1[2 * e + 1]); pw[3][e] = cvt_pk_bf16(p1[8 + 2 * e], p1[9 + 2 * e]); }
            const LAS unsigned char* vb = lds + L_V + s * VSLOT + vb0;
#pragma unroll
            for (int d = 0; d < ND; ++d)
#pragma unroll
                for (int ks = 0; ks < 4; ++ks) {
                    const s16x4 lo = vtr(vb + d * 4096 + ks * 1024), hh = vtr(vb + d * 4096 + ks * 1024 + 512);
                    const bf16x8 vf = (bf16x8){lo[0], lo[1], lo[2], lo[3], hh[0], hh[1], hh[2], hh[3]};
                    o[d] = __builtin_amdgcn_mfma_f32_32x32x16_bf16(__builtin_bit_cast(bf16x8, pw[ks]), vf, o[d], 0, 0, 0);
                }
        }
        if (t + 1 < NT) SA_WRITE(s ^ 1);
        __syncthreads();
    }
    l_run += __shfl_xor(l_run, 32);
    if (hi == 0) wsf[32 + r32] = l_run;
    LDS_WAIT();
    LAS unsigned short* stg = (LAS unsigned short*)(lds + wid * (32 * DV * 2));
#pragma unroll
    for (int r = 0; r < 16; ++r) { const float rl = 1.0f / wsf[32 + crow(r, hi)]; const int orow = crow(r, hi);
#pragma unroll
        for (int d = 0; d < ND; ++d) stg[orow * DV + d * 32 + r32] = (unsigned short)(cvt_pk_bf16(o[d][r] * rl, 0.f) & 0xffffu); }
    LDS_WAIT();
    constexpr int CH = DV / 8;
#pragma unroll
    for (int i = 0; i < 32 * CH / 64; ++i) { const int piece = i * 64 + lane, row = piece / CH, ch = piece % CH;
        const u32x4 v = *(const LAS u32x4*)(stg + row * DV + ch * 8);
        *(u32x4*)(Og + (long)(wid * 32 + row) * opitch + ch * 8) = v; }
    __syncthreads();
#undef SA_LOAD
#undef SA_WRITE
}
constexpr int R_KEY = XOFF, R_WSF = XOFF + 1024, R_GQK = XOFF + 3072;
__device__ __forceinline__ void fill_kv_res(const bf16* Kg, const bf16* Vg, long pitch, LAS unsigned char* lds, int wid, const LAS float* keyarr) {
    const int lane = lane_id();
    const bf16* ksrc = Kg + (long)lane * pitch + wid * 8;
    const bf16* vsrc = Vg + (long)(16 * (wid & 3) + (lane >> 2)) * pitch + (wid >> 2) * 32 + (lane & 3) * 8;
    u32x4 kr[4][2], vr[4][2];
#pragma unroll
    for (int t = 0; t < 4; ++t)
#pragma unroll
        for (int c = 0; c < 2; ++c) { kr[t][c] = *(const u32x4*)(ksrc + (long)t * 64 * pitch + c * 64); vr[t][c] = *(const u32x4*)(vsrc + (long)t * 64 * pitch + c * 64); }
#pragma unroll
    for (int t = 0; t < 4; ++t) { const float sc = keyarr[t * 64 + lane];
#pragma unroll
        for (int c = 0; c < 2; ++c) { u32x4 k = kr[t][c];
#pragma unroll
            for (int e = 0; e < 4; ++e) k[e] = cvt_pk_bf16(__uint_as_float(k[e] << 16) * sc, __uint_as_float(k[e] & 0xffff0000u) * sc);
            *(LAS u32x4*)(lds + t * 16384 + (wid + 8 * c) * 1024 + lane * 16) = k;
            *(LAS u32x4*)(lds + 65536 + t * 16384 + ((wid >> 2) + 2 * c) * 4096 + (wid & 3) * 1024 + lane * 16) = vr[t][c]; } }
}
__device__ __forceinline__ void unit_res(const bf16x8* qr, unsigned char* Og, long opitch, LAS unsigned char* lds, int wid) {
    const int lane = lane_id(), r32 = lane & 31, hi = lane >> 5;
    LAS float* wsf = (LAS float*)(lds + R_WSF) + wid * 64;
    f32x16 p[4][2];
#pragma unroll
    for (int t = 0; t < 4; ++t) {
        const LAS unsigned char* kb = lds + t * 16384 + hi * 1024 + r32 * 16;
        ta_zero16(p[t][0]); ta_zero16(p[t][1]);
#pragma unroll
        for (int d0 = 0; d0 < 8; ++d0) {
            const bf16x8 b0 = *(const LAS bf16x8*)(kb + d0 * 2048), b1 = *(const LAS bf16x8*)(kb + d0 * 2048 + 512);
            p[t][0] = __builtin_amdgcn_mfma_f32_32x32x16_bf16(b0, qr[d0], p[t][0], 0, 0, 0);
            p[t][1] = __builtin_amdgcn_mfma_f32_32x32x16_bf16(b1, qr[d0], p[t][1], 0, 0, 0);
        }
    }
    float rm = fmaxf(p[0][0][0], p[0][1][0]);
#pragma unroll
    for (int t = 0; t < 4; ++t)
#pragma unroll
        for (int r = 0; r < 16; ++r) rm = fmaxf(rm, fmaxf(p[t][0][r], p[t][1][r]));
    rm = fmaxf(rm, __shfl_xor(rm, 32));
    float rs = 0.f;
    u32x4 pw[4][4];
#pragma unroll
    for (int t = 0; t < 4; ++t) {
#pragma unroll
        for (int r = 0; r < 16; ++r) { p[t][0][r] = __builtin_amdgcn_exp2f(p[t][0][r] - rm); p[t][1][r] = __builtin_amdgcn_exp2f(p[t][1][r] - rm); rs += p[t][0][r] + p[t][1][r]; }
#pragma unroll
        for (int e = 0; e < 4; ++e) { pw[t][0][e] = cvt_pk_bf16(p[t][0][2 * e], p[t][0][2 * e + 1]); pw[t][1][e] = cvt_pk_bf16(p[t][0][8 + 2 * e], p[t][0][9 + 2 * e]);
                                      pw[t][2][e] = cvt_pk_bf16(p[t][1][2 * e], p[t][1][2 * e + 1]); pw[t][3][e] = cvt_pk_bf16(p[t][1][8 + 2 * e], p[t][1][9 + 2 * e]); }
    }
    f32x16 o[4];
#pragma unroll
    for (int d = 0; d < 4; ++d) ta_zero16(o[d]);
    const int vb0 = ((lane >> 4) & 1) * 32 + (lane & 3) * 8 + (4 * hi + ((lane & 15) >> 2)) * 64;
#pragma unroll
    for (int t = 0; t < 4; ++t) {
        const LAS unsigned char* vb = lds + 65536 + t * 16384 + vb0;
#pragma unroll
        for (int d = 0; d < 4; ++d)
#pragma unroll
            for (int ks = 0; ks < 4; ++ks) {
                const s16x4 lo = vtr(vb + d * 4096 + ks * 1024), hh = vtr(vb + d * 4096 + ks * 1024 + 512);
                const bf16x8 vf = (bf16x8){lo[0], lo[1], lo[2], lo[3], hh[0], hh[1], hh[2], hh[3]};
                o[d] = __builtin_amdgcn_mfma_f32_32x32x16_bf16(__builtin_bit_cast(bf16x8, pw[t][ks]), vf, o[d], 0, 0, 0);
            }
    }
    rs += __shfl_xor(rs, 32);
    if (hi == 0) wsf[32 + r32] = rs;
    LDS_WAIT();
#pragma unroll
    for (int r = 0; r < 16; ++r) { const float rl = 8.0f / wsf[32 + crow(r, hi)];
        *(unsigned*)(Og + (long)(wid * 32 + crow(r, hi)) * opitch + 4 * r32) = cvt4_fp8(o[0][r] * rl, o[1][r] * rl, o[2][r] * rl, o[3][r] * rl); }
}
}

namespace ta {
constexpr int NW=8,QBLK=32,QB=QBLK*NW,KVBLK=64;
__device__ __forceinline__ void zero16(f32x16&x){
  #pragma unroll
  for(int r=0;r<16;++r){float z;asm volatile("v_mov_b32 %0, 0":"=v"(z));x[r]=z;}
}
__device__ __forceinline__ int crow(int r,int hi){return (r&3)+8*(r>>2)+4*hi;}
#define SBAR() __builtin_amdgcn_sched_barrier(0)
__device__ __forceinline__ void cmask(f32x16&p0,f32x16&p1,int jb,int qrel,int hi){
  const float NEG=-INFINITY; int kb=64*jb+4*hi;
  #pragma unroll
  for(int r=0;r<16;++r){int kv=kb+(r&3)+8*(r>>2); if(kv>qrel)p0[r]=NEG; if(kv+32>qrel)p1[r]=NEG;}
}

constexpr int NSLOT=3, SLOTB=8192;
constexpr int LDS_K=0, LDS_V=NSLOT*SLOTB, LDS_WS=2*NSLOT*SLOTB, LDS_OST=LDS_WS+NW*64*4, LDS_CK=LDS_OST+NW*4096, LDS_PFX=LDS_CK+16384, LDS_Q=LDS_PFX+64, LDS_BYTES=LDS_Q+NW*4096;
__device__ __forceinline__ void glds16(const void*gsrc,unsigned lds_dst){unsigned keep;
  asm volatile("s_mov_b32 %0, m0\n\ts_mov_b32 m0, %2\n\ts_nop 0\n\tglobal_load_lds_dwordx4 %1, off\n\ts_mov_b32 m0, %0":"=&s"(keep):"v"(gsrc),"s"(lds_dst):"memory");}
__device__ __forceinline__ float max3f(float a,float b,float c){float r;asm("v_max3_f32 %0, %1, %2, %3":"=v"(r):"v"(a),"v"(b),"v"(c));return r;}
__device__ __forceinline__ float max2f(float a,float b){float r;asm("v_max_f32_e32 %0, %1, %2":"=v"(r):"v"(a),"v"(b));return r;}
__device__ __forceinline__ float fadd_s(float a,float b){float r;asm("v_add_f32_e32 %0, %1, %2":"=v"(r):"v"(a),"v"(b));return r;}
__device__ __forceinline__ float fsub_s(float a,float b){float r;asm("v_sub_f32_e32 %0, %1, %2":"=v"(r):"v"(a),"v"(b));return r;}
typedef float f32x2_t __attribute__((ext_vector_type(2))); typedef __bf16 bf16x2_t __attribute__((ext_vector_type(2)));
__device__ __forceinline__ unsigned cvtpk_s(float lo,float hi){f32x2_t v={lo,hi};bf16x2_t b=__builtin_convertvector(v,bf16x2_t);return __builtin_bit_cast(unsigned,b);}
#define WAIT_BAR(N) asm volatile("s_waitcnt vmcnt(" #N ") lgkmcnt(0)\n\ts_barrier":::"memory")

__device__ __forceinline__ void qkt(f32x16&p0,f32x16&p1,const char*Kslot,const bf16x8*qr,const f32x16&c0,const f32x16&c1,int r32,int hi){
  const char*kb=Kslot+hi*1024+r32*16;
  #pragma unroll
  for(int d0=0;d0<4;++d0){
    const bf16x8 b0=*reinterpret_cast<const bf16x8*>(kb+d0*2048);
    const bf16x8 b1=*reinterpret_cast<const bf16x8*>(kb+d0*2048+512);
    if(d0==0){p0=__builtin_amdgcn_mfma_f32_32x32x16_bf16(b0,qr[0],c0,0,0,0);p1=__builtin_amdgcn_mfma_f32_32x32x16_bf16(b1,qr[0],c1,0,0,0);}
    else{p0=__builtin_amdgcn_mfma_f32_32x32x16_bf16(b0,qr[d0],p0,0,0,0);p1=__builtin_amdgcn_mfma_f32_32x32x16_bf16(b1,qr[d0],p1,0,0,0);}}
}
__device__ __forceinline__ void qkt0(f32x16&p0,f32x16&p1,const char*Kslot,const bf16x8*qr,int r32,int hi){
  const char*kb=Kslot+hi*1024+r32*16;
  #pragma unroll
  for(int d0=0;d0<4;++d0){
    const bf16x8 b0=*reinterpret_cast<const bf16x8*>(kb+d0*2048);
    const bf16x8 b1=*reinterpret_cast<const bf16x8*>(kb+d0*2048+512);
    if(d0==0){p0=__builtin_amdgcn_mfma_f32_32x32x16_bf16(b0,qr[0],(f32x16){0.f,0.f,0.f,0.f,0.f,0.f,0.f,0.f,0.f,0.f,0.f,0.f,0.f,0.f,0.f,0.f},0,0,0);p1=__builtin_amdgcn_mfma_f32_32x32x16_bf16(b1,qr[0],(f32x16){0.f,0.f,0.f,0.f,0.f,0.f,0.f,0.f,0.f,0.f,0.f,0.f,0.f,0.f,0.f,0.f},0,0,0);}
    else{p0=__builtin_amdgcn_mfma_f32_32x32x16_bf16(b0,qr[d0],p0,0,0,0);p1=__builtin_amdgcn_mfma_f32_32x32x16_bf16(b1,qr[d0],p1,0,0,0);}}
}
typedef __attribute__((address_space(3))) const char* lds_cptr;
typedef short v4i16_t __attribute__((ext_vector_type(4)));
__device__ __forceinline__ void kload8(bf16x8*kf,lds_cptr kp){
  kf[0]=*(const __attribute__((address_space(3))) bf16x8*)(kp);      kf[1]=*(const __attribute__((address_space(3))) bf16x8*)(kp+512);
  kf[2]=*(const __attribute__((address_space(3))) bf16x8*)(kp+2048); kf[3]=*(const __attribute__((address_space(3))) bf16x8*)(kp+2560);
  kf[4]=*(const __attribute__((address_space(3))) bf16x8*)(kp+4096); kf[5]=*(const __attribute__((address_space(3))) bf16x8*)(kp+4608);
  kf[6]=*(const __attribute__((address_space(3))) bf16x8*)(kp+6144); kf[7]=*(const __attribute__((address_space(3))) bf16x8*)(kp+6656);
}
__device__ __forceinline__ void kload2(bf16x8*kf,lds_cptr kp,int j){ kf[2*j]=*(const __attribute__((address_space(3))) bf16x8*)(kp+j*2048); kf[2*j+1]=*(const __attribute__((address_space(3))) bf16x8*)(kp+j*2048+512); }
__device__ __forceinline__ s16x4 vtr(lds_cptr p){ return __builtin_bit_cast(s16x4,__builtin_amdgcn_ds_read_tr16_b64_v4i16((__attribute__((address_space(3))) v4i16_t*)p)); }
__device__ __forceinline__ float rowmax(const f32x16&p0,const f32x16&p1){
  float a=max3f(p0[0],p0[1],p1[0]),b=max3f(p0[2],p0[3],p1[1]);a=max3f(a,p1[2],p1[3]);
  #pragma unroll
  for(int r=4;r<16;r+=4){a=max3f(a,p0[r],p0[r+1]);b=max3f(b,p0[r+2],p0[r+3]);a=max3f(a,p1[r],p1[r+1]);b=max3f(b,p1[r+2],p1[r+3]);}
  const float m=max2f(a,b);
  auto rr=__builtin_amdgcn_permlane32_swap(__float_as_uint(m),__float_as_uint(m),false,false);
  return max2f(__uint_as_float(rr[0]),__uint_as_float(rr[1]));
}
__device__ __forceinline__ void pv(f32x16*o,int vb,bf16x8 pa0,bf16x8 pa1,bf16x8 pa2,bf16x8 pa3){
  #pragma unroll
  for(int d0=0;d0<2;++d0){s16x4 lo[4],hi[4];
    #pragma unroll
    for(int ks=0;ks<4;++ks){
      asm volatile("ds_read_b64_tr_b16 %0,%1 offset:%c2":"=&v"(lo[ks]):"v"(vb),"i"(d0*4096+ks*1024):"memory");
      asm volatile("ds_read_b64_tr_b16 %0,%1 offset:%c2":"=&v"(hi[ks]):"v"(vb),"i"(d0*4096+ks*1024+512):"memory");}
    asm volatile("s_waitcnt lgkmcnt(0)":::"memory");SBAR();
    #define PK(k) (bf16x8){lo[k][0],lo[k][1],lo[k][2],lo[k][3],hi[k][0],hi[k][1],hi[k][2],hi[k][3]}
    o[d0]=__builtin_amdgcn_mfma_f32_32x32x16_bf16(pa0,PK(0),o[d0],0,0,0);
    o[d0]=__builtin_amdgcn_mfma_f32_32x32x16_bf16(pa1,PK(1),o[d0],0,0,0);
    o[d0]=__builtin_amdgcn_mfma_f32_32x32x16_bf16(pa2,PK(2),o[d0],0,0,0);
    o[d0]=__builtin_amdgcn_mfma_f32_32x32x16_bf16(pa3,PK(3),o[d0],0,0,0);
    #undef PK
  }
}

#ifndef ATTN_STORE16
#define ATTN_STORE16(p,v) (*(u32x4*)(p)=(v))
#endif
template<int THRL,int QPI,int KPI,int OPI,bool BIAS,bool OUT8=false> __device__ __forceinline__ void attn_unit(int qb,const bf16*Qu,const bf16*__restrict__ Kh,const bf16*__restrict__ Vh,bf16*Ou,char*shm,int wid_in){
  int wid=wid_in; asm volatile("":"+s"(wid));
  const int lane=lane_id(),r32=lane&31,hi=lane>>5;
  const int q0=qb*QB;
  const bf16*Qw=Qu+(long)(wid*QBLK)*QPI;
  const unsigned lds0=(unsigned)(uintptr_t)shm;
  float*wsf=(float*)(shm+LDS_WS)+wid*64;
  const bf16*ksrc=Kh+(long)lane*KPI+wid*8;
  const bf16*vsrc=Vh+(long)(16*(wid&3)+(lane>>2))*KPI+(wid>>2)*32+(lane&3)*8;
  const unsigned kdst=lds0+LDS_K+wid*1024, vdst=lds0+LDS_V+wid*1024;
  #define DMA_K(t,slot) glds16(ksrc+(long)(t)*KVBLK*KPI,(unsigned)__builtin_amdgcn_readfirstlane(kdst+(slot)))
  #define DMA_V(t,slot) glds16(vsrc+(long)(t)*KVBLK*KPI,(unsigned)__builtin_amdgcn_readfirstlane(vdst+(slot)))
  const int vb0=(int)(lds0+LDS_V)+((lane>>4)&1)*32+(lane&3)*8+(4*hi+((lane&15)>>2))*64;
  const char*Kbase=shm+LDS_K; bf16x8 kf[8];
  const lds_cptr shm3=(lds_cptr)shm; const lds_cptr kp0=shm3+LDS_K+hi*1024+r32*16; const lds_cptr vp0=shm3+LDS_V+((lane>>4)&1)*32+(lane&3)*8+(4*hi+((lane&15)>>2))*64;
  const int NT=(q0+QB)/KVBLK;
  DMA_K(0,0);DMA_V(0,0);DMA_K(1,SLOTB);
  bf16x8 qr[4];
  #pragma unroll
  for(int d0=0;d0<4;++d0)qr[d0]=*reinterpret_cast<const bf16x8*>(&Qw[(long)r32*QPI+d0*16+hi*8]);
  float mhat=0.f,l_reg=0.f;f32x16 o[2];zero16(o[0]);zero16(o[1]);f32x16 negm;zero16(negm);
  const __attribute__((address_space(3))) unsigned*ckp=(const __attribute__((address_space(3))) unsigned*)((__attribute__((address_space(3))) const char*)shm+LDS_CK)+r32;
  const unsigned q5w=hi?0u:0x3F803F80u; unsigned ka0=0u,ka1=0u;
  #define KALD(t) do{ if(BIAS){ const unsigned a_=ckp[(t)*64], b_=ckp[(t)*64+32]; ka0=hi?0u:a_; ka1=hi?0u:b_; } }while(0)
  #define KAF(x) __builtin_bit_cast(bf16x8,(u32x4){x,0u,0u,0u})
  const int qrel=wid*QBLK+r32;
  #define CMASK(P0,P1,t) do{int jb_=(t)-(NT-4); if(jb_>=0)cmask(P0,P1,jb_,qrel,hi);}while(0)
  bool resc=false;
  #define START(P0,P1) do{ const float rm=rowmax(P0,P1); resc=false; \
    { const float dl=rm; mhat=fadd_s(mhat,dl); \
      _Pragma("unroll") for(int r=0;r<16;++r){P0[r]=fsub_s(P0[r],dl);P1[r]=fsub_s(P1[r],dl);} \
      _Pragma("unroll") for(int r=0;r<16;++r)negm[r]=-mhat; asm volatile("":"+v"(negm)); } \
    _Pragma("unroll") for(int r=0;r<16;++r)P0[r]=__builtin_amdgcn_exp2f(P0[r]); }while(0)
  #define RESC() do{ if(resc){ asm volatile("s_waitcnt lgkmcnt(0)":::"memory"); \
      _Pragma("unroll") for(int d_=0;d_<2;++d_) _Pragma("unroll") for(int r=0;r<16;++r)o[d_][r]*=wsf[crow(r,hi)]; } }while(0)
  f32x16 pA0,pA1,pB0,pB1;
  int sl_prev=0,sl_cur=0,sl_next=SLOTB;
  #define ROT() do{sl_prev=sl_cur;sl_cur=sl_next;sl_next=(sl_next==(NSLOT-1)*SLOTB)?0:sl_next+SLOTB;}while(0)
  DMA_K(2,2*SLOTB);
  WAIT_BAR(3);
  KALD(0); qkt(pA0,pA1,Kbase,qr,negm,negm,r32,hi); if(BIAS){ pA0=__builtin_amdgcn_mfma_f32_32x32x16_bf16(KAF(ka0),KAF(q5w),pA0,0,0,0); pA1=__builtin_amdgcn_mfma_f32_32x32x16_bf16(KAF(ka1),KAF(q5w),pA1,0,0,0); }asm volatile("s_nop 15\n\ts_nop 7":"+v"(pA0),"+v"(pA1));CMASK(pA0,pA1,0);
  START(pA0,pA1);
  KALD(1);
  _Pragma("unroll") for(int r=0;r<16;++r)pA1[r]=__builtin_amdgcn_exp2f(pA1[r]);
  WAIT_BAR(0);
  DMA_K(3,0);DMA_V(1,SLOTB);
  ROT();
  kload8(kf,kp0+sl_cur);
  WAIT_BAR(2);
  s16x4 vlo[8],vhi[8]; u32x4 pw0,pw1,pw2,pw3;
  #define PKW(P,B) cvtpk_s(P[B],P[B+1])
  #define PAF(k) __builtin_bit_cast(bf16x8,pw##k)
  #define VFR(i) (bf16x8){vlo[i][0],vlo[i][1],vlo[i][2],vlo[i][3],vhi[i][0],vhi[i][1],vhi[i][2],vhi[i][3]}
  #define PIN(x) asm volatile("":"+v"(x))
  #define MX3(a,b,c) __builtin_fmaxf(__builtin_fmaxf((a),(b)),(c))
  #define GAPA(MF,A0,A1,A2,A3,W0,W1,PW) do{ MF; sacc+=A0; sacc+=A1; sacc+=A2; sacc+=A3; PIN(sacc); W0; W1; PIN(PW); SBAR(); }while(0)
  #define EX(v) __builtin_amdgcn_exp2f(v)
  #define GAPB(MF,X,B) do{ MF; X[B]=EX(X[B]); X[B+1]=EX(X[B+1]); X[B+2]=EX(X[B+2]); X[B+3]=EX(X[B+3]); PIN(X); SBAR(); }while(0)
  #define GAPBS(MF,X,B,DO_,Y,G) do{ MF; X[B]=EX(X[B]); X[B+1]=EX(X[B+1]); X[B+2]=EX(X[B+2]); X[B+3]=EX(X[B+3]); PIN(X); SBAR(); }while(0)
  #define VRD(i) do{ vlo[i]=vtr(vp_+(((i)>>2)*4096+((i)&3)*1024)); vhi[i]=vtr(vp_+(((i)>>2)*4096+((i)&3)*1024+512)); }while(0)
  #define KRD(G,j) do{ if(G){ kload2(kf,kp0+sl_next,j); SBAR(); } }while(0)
  #define STEP(C0,C1,P0,P1,t,GK,GV,GL) do{ SBAR(); \
    const lds_cptr vp_=vp0+sl_prev; \
    const bf16x8 qd0=qr[0], qd1=qr[1], qd2=qr[2], qd3=qr[3]; \
    VRD(0); SBAR(); float sacc=(P0[0]+P0[1]); \
    GAPA(C0=__builtin_amdgcn_mfma_f32_32x32x16_bf16(kf[0],qd0,negm,0,0,0), P0[2],P0[3],P0[4],P0[5],     pw0[0]=PKW(P0,0), pw0[1]=PKW(P0,2), pw0); \
    VRD(4); SBAR(); GAPA(C1=__builtin_amdgcn_mfma_f32_32x32x16_bf16(kf[1],qd0,negm,0,0,0), P0[6],P0[7],P0[8],P0[9],     pw0[2]=PKW(P0,4), pw0[3]=PKW(P0,6), pw0); \
    VRD(1); SBAR(); GAPA(C0=__builtin_amdgcn_mfma_f32_32x32x16_bf16(kf[2],qd1,C0,0,0,0),   P0[10],P0[11],P0[12],P0[13], pw1[0]=PKW(P0,8), pw1[1]=PKW(P0,10), pw1); \
    VRD(5); SBAR(); GAPA(C1=__builtin_amdgcn_mfma_f32_32x32x16_bf16(kf[3],qd1,C1,0,0,0),   P0[14],P0[15],P1[0],P1[1],   pw1[2]=PKW(P0,12),pw1[3]=PKW(P0,14), pw1); \
    VRD(2); SBAR(); GAPA(C0=__builtin_amdgcn_mfma_f32_32x32x16_bf16(kf[4],qd2,C0,0,0,0),   P1[2],P1[3],P1[4],P1[5],     pw2[0]=PKW(P1,0), pw2[1]=PKW(P1,2), pw2); \
    VRD(6); SBAR(); GAPA(C1=__builtin_amdgcn_mfma_f32_32x32x16_bf16(kf[5],qd2,C1,0,0,0),   P1[6],P1[7],P1[8],P1[9],     pw2[2]=PKW(P1,4), pw2[3]=PKW(P1,6), pw2); \
    VRD(3); SBAR(); GAPA(C0=__builtin_amdgcn_mfma_f32_32x32x16_bf16(kf[6],qd3,C0,0,0,0),   P1[10],P1[11],P1[12],P1[13], pw3[0]=PKW(P1,8), pw3[1]=PKW(P1,10), pw3); \
    VRD(7); SBAR(); GAPA(C1=__builtin_amdgcn_mfma_f32_32x32x16_bf16(kf[7],qd3,C1,0,0,0),   P1[14],P1[15],0.f,0.f,       pw3[2]=PKW(P1,12),pw3[3]=PKW(P1,14), pw3); \
    if(BIAS){ C0=__builtin_amdgcn_mfma_f32_32x32x16_bf16(KAF(ka0),KAF(q5w),C0,0,0,0); C1=__builtin_amdgcn_mfma_f32_32x32x16_bf16(KAF(ka1),KAF(q5w),C1,0,0,0); SBAR(); } \
    l_reg+=sacc; \
    if(GK){DMA_K((t)+3,sl_cur);} if(GV){DMA_V((t)+1,sl_next);} \
    CMASK(C0,C1,t); \
    { float a=MX3(C0[0],C0[1],C1[0]),b=MX3(C0[2],C0[3],C1[1]); a=MX3(a,C1[2],C1[3]); \
      _Pragma("unroll") for(int r=4;r<16;r+=4){a=MX3(a,C0[r],C0[r+1]);b=MX3(b,C0[r+2],C0[r+3]);a=MX3(a,C1[r],C1[r+1]);b=MX3(b,C1[r+2],C1[r+3]);} \
      float rm=__builtin_fmaxf(a,b); { auto rr=__builtin_amdgcn_permlane32_swap(__float_as_uint(rm),__float_as_uint(rm),false,false); rm=__builtin_fmaxf(__uint_as_float(rr[0]),__uint_as_float(rr[1])); } \
      resc=false; \
      if(__builtin_expect(__any(rm>(float)THRL),0)){ const float dl=__builtin_fmaxf(rm,0.f); mhat+=dl; \
        _Pragma("unroll") for(int r=0;r<16;++r){C0[r]-=dl;C1[r]-=dl;} \
        _Pragma("unroll") for(int r=0;r<16;++r)negm[r]=-mhat; asm volatile("":"+v"(negm)); \
        const float f=__builtin_amdgcn_exp2f(-dl); l_reg*=f; if(hi==0)wsf[r32]=f; resc=true; } } \
    SBAR(); \
    GAPBS(o[0]=__builtin_amdgcn_mfma_f32_32x32x16_bf16(PAF(0),VFR(0),o[0],0,0,0), C0,0, GL,P0,0); \
    GAPBS(o[1]=__builtin_amdgcn_mfma_f32_32x32x16_bf16(PAF(0),VFR(4),o[1],0,0,0), C0,4, GL,P0,1); \
    KRD(GL,0); GAPBS(o[0]=__builtin_amdgcn_mfma_f32_32x32x16_bf16(PAF(1),VFR(1),o[0],0,0,0), C0,8, GL,P0,2); \
    KRD(GL,1); GAPBS(o[1]=__builtin_amdgcn_mfma_f32_32x32x16_bf16(PAF(1),VFR(5),o[1],0,0,0), C0,12, GL,P0,3); \
    KRD(GL,2); GAPBS(o[0]=__builtin_amdgcn_mfma_f32_32x32x16_bf16(PAF(2),VFR(2),o[0],0,0,0), C1,0, GL,P1,0); \
    KRD(GL,3); if(GL){KALD((t)+1);} SBAR(); GAPBS(o[1]=__builtin_amdgcn_mfma_f32_32x32x16_bf16(PAF(2),VFR(6),o[1],0,0,0), C1,4, GL,P1,1); \
    GAPBS(o[0]=__builtin_amdgcn_mfma_f32_32x32x16_bf16(PAF(3),VFR(3),o[0],0,0,0), C1,8, GL,P1,2); \
    GAPBS(o[1]=__builtin_amdgcn_mfma_f32_32x32x16_bf16(PAF(3),VFR(7),o[1],0,0,0), C1,12, GL,P1,3); \
    }while(0)
  int t=1;
  #undef CMASK
  #define CMASK(P0,P1,t) do{}while(0)
  for(;t+5<NT;t+=2){
    STEP(pB0,pB1,pA0,pA1,t,true,true,true);     WAIT_BAR(2); RESC(); ROT();
    STEP(pA0,pA1,pB0,pB1,t+1,true,true,true);   WAIT_BAR(2); RESC(); ROT();
  }
  #undef CMASK
  #define CMASK(P0,P1,t) do{int jb_=(t)-(NT-4); if(jb_>=0)cmask(P0,P1,jb_,qrel,hi);}while(0)
  #define ENDW(tt) do{ if((tt)+3<NT){WAIT_BAR(2);} else if((tt)+2<NT){WAIT_BAR(1);} else {WAIT_BAR(0);} }while(0)
  for(;t+1<NT;t+=2){
    STEP(pB0,pB1,pA0,pA1,t,(t+3<NT),(t+1<NT),(t+1<NT));       ENDW(t);   RESC(); ROT();
    STEP(pA0,pA1,pB0,pB1,t+1,(t+4<NT),(t+2<NT),(t+2<NT));     ENDW(t+1); RESC(); ROT();
  }
  STEP(pB0,pB1,pA0,pA1,NT-1,false,false,false); RESC();
  { float sacc=pB0[0]+pB0[1]; _Pragma("unroll") for(int r=2;r<16;++r)sacc+=pB0[r]; _Pragma("unroll") for(int r=0;r<16;++r)sacc+=pB1[r]; l_reg+=sacc;
    pw0=(u32x4){PKW(pB0,0),PKW(pB0,2),PKW(pB0,4),PKW(pB0,6)};pw1=(u32x4){PKW(pB0,8),PKW(pB0,10),PKW(pB0,12),PKW(pB0,14)};pw2=(u32x4){PKW(pB1,0),PKW(pB1,2),PKW(pB1,4),PKW(pB1,6)};pw3=(u32x4){PKW(pB1,8),PKW(pB1,10),PKW(pB1,12),PKW(pB1,14)};
    SBAR(); pv(o,vb0+sl_cur,PAF(0),PAF(1),PAF(2),PAF(3)); }
  #undef PKW
  #undef PAF
  #undef VFR
  #undef PIN
  #undef MX3
  #undef GAPA
  #undef GAPB
  #undef GAPBS
  #undef EX
  #undef VRD
  #undef KRD
  #undef STEP
  #undef ENDW
  {auto rr=__builtin_amdgcn_permlane32_swap(__float_as_uint(l_reg),__float_as_uint(l_reg),false,false);l_reg=__uint_as_float(rr[0])+__uint_as_float(rr[1]);}
  if(hi==0)wsf[32+r32]=l_reg;asm volatile("s_waitcnt lgkmcnt(0)":::"memory");
  float rli[16];
  #pragma unroll
  for(int r=0;r<16;++r)rli[r]=__builtin_amdgcn_rcpf(wsf[32+crow(r,hi)]);
  bf16*Ow=OUT8?Ou:Ou+(long)(wid*QBLK)*OPI;
  { bf16*stg=(bf16*)(shm+LDS_OST)+wid*2048;
    #pragma unroll
    for(int r=0;r<16;++r){const int orow=crow(r,hi);
      #pragma unroll
      for(int d0=0;d0<2;++d0)stg[orow*64+d0*32+r32]=(bf16)(cvtpk_s(o[d0][r]*rli[r],0.f)&0xffffu);}
    asm volatile("s_waitcnt lgkmcnt(0)":::"memory");
    if constexpr(!OUT8){
    #pragma unroll
    for(int i=0;i<4;++i){const int row=i*8+(lane>>3),ch=lane&7; const u32x4 v=*(const u32x4*)(stg+row*64+ch*8); ATTN_STORE16(Ow+(long)row*OPI+ch*8,v);}
    } else {
    unsigned char*O8=(unsigned char*)Ou+(long)(wid*QBLK)*OPI;
    #pragma unroll
    for(int i=0;i<4;++i){const int row=i*8+(lane>>3),ch=lane&7; const u32x4 v=*(const u32x4*)(stg+row*64+ch*8); u32x2 w;
      w.x=cvt4_fp8(__uint_as_float(v[0]<<16)*8.f,__uint_as_float(v[0]&0xffff0000u)*8.f,__uint_as_float(v[1]<<16)*8.f,__uint_as_float(v[1]&0xffff0000u)*8.f);
      w.y=cvt4_fp8(__uint_as_float(v[2]<<16)*8.f,__uint_as_float(v[2]&0xffff0000u)*8.f,__uint_as_float(v[3]<<16)*8.f,__uint_as_float(v[3]&0xffff0000u)*8.f);
      *(u32x2*)(O8+(long)row*OPI+ch*8)=w;}
    } }
  asm volatile("s_waitcnt lgkmcnt(0)\n\ts_barrier":::"memory");
  #undef DMA_K
  #undef DMA_V
  #undef CMASK
  #undef START
  #undef RESC
  #undef ROT
  #undef KALD
  #undef KAF
}
constexpr int U8_VSLOT=16384, U8_LV=NSLOT*SLOTB, U8_WS=U8_LV+NSLOT*U8_VSLOT, U8_Q=U8_WS+NW*256, U8_BYTES=U8_Q+NW*4096;
__device__ __forceinline__ void pv4(f32x16*o,int vb,bf16x8 pa0,bf16x8 pa1,bf16x8 pa2,bf16x8 pa3){
  #pragma unroll
  for(int d0=0;d0<4;++d0){s16x4 lo[4],hi[4];
    #pragma unroll
    for(int ks=0;ks<4;++ks){
      asm volatile("ds_read_b64_tr_b16 %0,%1 offset:%c2":"=&v"(lo[ks]):"v"(vb),"i"(d0*4096+ks*1024):"memory");
      asm volatile("ds_read_b64_tr_b16 %0,%1 offset:%c2":"=&v"(hi[ks]):"v"(vb),"i"(d0*4096+ks*1024+512):"memory");}
    asm volatile("s_waitcnt lgkmcnt(0)":::"memory");SBAR();
    #define PK(k) (bf16x8){lo[k][0],lo[k][1],lo[k][2],lo[k][3],hi[k][0],hi[k][1],hi[k][2],hi[k][3]}
    o[d0]=__builtin_amdgcn_mfma_f32_32x32x16_bf16(pa0,PK(0),o[d0],0,0,0);
    o[d0]=__builtin_amdgcn_mfma_f32_32x32x16_bf16(pa1,PK(1),o[d0],0,0,0);
    o[d0]=__builtin_amdgcn_mfma_f32_32x32x16_bf16(pa2,PK(2),o[d0],0,0,0);
    o[d0]=__builtin_amdgcn_mfma_f32_32x32x16_bf16(pa3,PK(3),o[d0],0,0,0);
    #undef PK
  }
}
template<int THRL,int QPI,int KPI,int OPI,bool FUSE,int O0PI> __device__ __forceinline__ void attn_unit128(int qb,const bf16*Qu,const bf16*__restrict__ Kh,const bf16*__restrict__ Vh,bf16*Ou,char*shm,int wid_in,const bf16*O0,const float*sg,float lam){
  int wid=wid_in; asm volatile("":"+s"(wid));
  const int lane=lane_id(),r32=lane&31,hi=lane>>5;
  const int q0=qb*QB;
  const bf16*Qw=Qu+(long)(wid*QBLK)*QPI;
  const unsigned lds0=(unsigned)(uintptr_t)shm;
  float*wsf=(float*)(shm+U8_WS)+wid*64;
  const bf16*ksrc=Kh+(long)lane*KPI+wid*8;
  const bf16*vsrc=Vh+(long)(16*(wid&3)+(lane>>2))*KPI+(wid>>2)*32+(lane&3)*8;
  const unsigned kdst=lds0+LDS_K+wid*1024, vdst=lds0+U8_LV+wid*1024;
  #define DMA_K(t,slot) glds16(ksrc+(long)(t)*KVBLK*KPI,(unsigned)__builtin_amdgcn_readfirstlane(kdst+(slot)))
  #define DMA_V(t,slot) do{ glds16(vsrc+(long)(t)*KVBLK*KPI,(unsigned)__builtin_amdgcn_readfirstlane(vdst+2*(slot))); glds16(vsrc+(long)(t)*KVBLK*KPI+64,(unsigned)__builtin_amdgcn_readfirstlane(vdst+2*(slot)+8192)); }while(0)
  const int vb0=(int)(lds0+U8_LV)+((lane>>4)&1)*32+(lane&3)*8+(4*hi+((lane&15)>>2))*64;
  const char*Kbase=shm+LDS_K; bf16x8 kf[8];
  const lds_cptr shm3=(lds_cptr)shm; const lds_cptr kp0=shm3+LDS_K+hi*1024+r32*16; const lds_cptr vp0=shm3+U8_LV+((lane>>4)&1)*32+(lane&3)*8+(4*hi+((lane&15)>>2))*64;
  const int NT=(q0+QB)/KVBLK;
  DMA_K(0,0);DMA_V(0,0);DMA_K(1,SLOTB);
  bf16x8 qr[4];
  #pragma unroll
  for(int d0=0;d0<4;++d0)qr[d0]=*reinterpret_cast<const bf16x8*>(&Qw[(long)r32*QPI+d0*16+hi*8]);
  float mhat=0.f,l_reg=0.f;f32x16 o[4];zero16(o[0]);zero16(o[1]);zero16(o[2]);zero16(o[3]);
  const int qrel=wid*QBLK+r32;
  #define CMASK(P0,P1,t) do{int jb_=(t)-(NT-4); if(jb_>=0)cmask(P0,P1,jb_,qrel,hi);}while(0)
  bool resc=false;
  #define START(P0,P1) do{ const float rm=rowmax(P0,P1); resc=false; \
    { const float dl=rm; mhat=fadd_s(mhat,dl); \
      _Pragma("unroll") for(int r=0;r<16;++r){P0[r]=fsub_s(P0[r],dl);P1[r]=fsub_s(P1[r],dl);} } \
    _Pragma("unroll") for(int r=0;r<16;++r)P0[r]=__builtin_amdgcn_exp2f(P0[r]); }while(0)
  #define RESC() do{ if(resc){ asm volatile("s_waitcnt lgkmcnt(0)":::"memory"); \
      _Pragma("unroll") for(int r=0;r<16;++r){ const float f_=wsf[crow(r,hi)]; o[0][r]*=f_; o[1][r]*=f_; o[2][r]*=f_; o[3][r]*=f_; } } }while(0)
  f32x16 pA0,pA1,pB0,pB1;
  #define MKC(X,G) do{ const float nm_=-mhat; X[4*(G)]=nm_; X[4*(G)+1]=nm_; X[4*(G)+2]=nm_; X[4*(G)+3]=nm_; }while(0)
  int sl_prev=0,sl_cur=0,sl_next=SLOTB;
  #define ROT() do{sl_prev=sl_cur;sl_cur=sl_next;sl_next=(sl_next==(NSLOT-1)*SLOTB)?0:sl_next+SLOTB;}while(0)
  DMA_K(2,2*SLOTB);
  WAIT_BAR(4);
  qkt0(pA0,pA1,Kbase,qr,r32,hi);asm volatile("s_nop 15\n\ts_nop 7":"+v"(pA0),"+v"(pA1));CMASK(pA0,pA1,0);
  START(pA0,pA1);
  MKC(pB0,0);MKC(pB0,1);MKC(pB0,2);MKC(pB0,3);MKC(pB1,0);MKC(pB1,1);MKC(pB1,2);MKC(pB1,3);
  _Pragma("unroll") for(int r=0;r<16;++r)pA1[r]=__builtin_amdgcn_exp2f(pA1[r]);
  WAIT_BAR(0);
  DMA_K(3,0);DMA_V(1,SLOTB);
  ROT();
  kload8(kf,kp0+sl_cur);
  WAIT_BAR(3);
  s16x4 vlo[8],vhi[8]; u32x4 pw0,pw1,pw2,pw3;
  #define PKW(P,B) cvtpk_s(P[B],P[B+1])
  #define PAF(k) __builtin_bit_cast(bf16x8,pw##k)
  #define VFR(i) (bf16x8){vlo[i][0],vlo[i][1],vlo[i][2],vlo[i][3],vhi[i][0],vhi[i][1],vhi[i][2],vhi[i][3]}
  #define PIN(x) asm volatile("":"+v"(x))
  #define MX3(a,b,c) __builtin_fmaxf(__builtin_fmaxf((a),(b)),(c))
  #define GAPA(MF,A0,A1,A2,A3,W0,W1,PW) do{ MF; sacc+=A0; sacc+=A1; sacc+=A2; sacc+=A3; PIN(sacc); W0; W1; PIN(PW); SBAR(); }while(0)
  #define EX(v) __builtin_amdgcn_exp2f(v)
  #define GAPB1(MF,X,B,RD) do{ MF; X[B]=EX(X[B]); X[B+1]=EX(X[B+1]); X[B+2]=EX(X[B+2]); X[B+3]=EX(X[B+3]); PIN(X); SBAR(); RD; SBAR(); }while(0)
  #define GAPB2(MF,DO_,Y,G,RD) do{ MF; if(DO_){ MKC(Y,G); PIN(Y); } SBAR(); RD; SBAR(); }while(0)
  #define VRDX(i,off) do{ vlo[i]=vtr(vp_+((off)+((i)&3)*1024)); vhi[i]=vtr(vp_+((off)+((i)&3)*1024+512)); }while(0)
  #define KRD(G,j) do{ if(G){ kload2(kf,kp0+sl_next,j); SBAR(); } }while(0)
  #define QLD(j) (*(const __attribute__((address_space(3))) bf16x8*)(qp0+(j)*1024))
  #define STEP(C0,C1,P0,P1,t,GK,GV,GL) do{ SBAR(); \
    const lds_cptr vp_=vp0+2*sl_prev; \
    VRDX(0,0); SBAR(); float sacc=(P0[0]+P0[1]); \
    GAPA(C0=__builtin_amdgcn_mfma_f32_32x32x16_bf16(kf[0],qr[0],C0,0,0,0), P0[2],P0[3],P0[4],P0[5],     pw0[0]=PKW(P0,0), pw0[1]=PKW(P0,2), pw0); \
    GAPA(C1=__builtin_amdgcn_mfma_f32_32x32x16_bf16(kf[1],qr[0],C1,0,0,0), P0[6],P0[7],P0[8],P0[9],     pw0[2]=PKW(P0,4), pw0[3]=PKW(P0,6), pw0); \
    VRDX(1,0); SBAR(); GAPA(C0=__builtin_amdgcn_mfma_f32_32x32x16_bf16(kf[2],qr[1],C0,0,0,0),   P0[10],P0[11],P0[12],P0[13], pw1[0]=PKW(P0,8), pw1[1]=PKW(P0,10), pw1); \
    GAPA(C1=__builtin_amdgcn_mfma_f32_32x32x16_bf16(kf[3],qr[1],C1,0,0,0),   P0[14],P0[15],P1[0],P1[1],   pw1[2]=PKW(P0,12),pw1[3]=PKW(P0,14), pw1); \
    VRDX(2,0); SBAR(); GAPA(C0=__builtin_amdgcn_mfma_f32_32x32x16_bf16(kf[4],qr[2],C0,0,0,0),   P1[2],P1[3],P1[4],P1[5],     pw2[0]=PKW(P1,0), pw2[1]=PKW(P1,2), pw2); \
    GAPA(C1=__builtin_amdgcn_mfma_f32_32x32x16_bf16(kf[5],qr[2],C1,0,0,0),   P1[6],P1[7],P1[8],P1[9],     pw2[2]=PKW(P1,4), pw2[3]=PKW(P1,6), pw2); \
    VRDX(3,0); SBAR(); GAPA(C0=__builtin_amdgcn_mfma_f32_32x32x16_bf16(kf[6],qr[3],C0,0,0,0),   P1[10],P1[11],P1[12],P1[13], pw3[0]=PKW(P1,8), pw3[1]=PKW(P1,10), pw3); \
    GAPA(C1=__builtin_amdgcn_mfma_f32_32x32x16_bf16(kf[7],qr[3],C1,0,0,0),   P1[14],P1[15],0.f,0.f,       pw3[2]=PKW(P1,12),pw3[3]=PKW(P1,14), pw3); \
    l_reg+=sacc; \
    if(GK){DMA_K((t)+3,sl_cur);} if(GV){DMA_V((t)+1,sl_next);} \
    CMASK(C0,C1,t); \
    { float a=MX3(C0[0],C0[1],C1[0]),b=MX3(C0[2],C0[3],C1[1]); a=MX3(a,C1[2],C1[3]); \
      _Pragma("unroll") for(int r=4;r<16;r+=4){a=MX3(a,C0[r],C0[r+1]);b=MX3(b,C0[r+2],C0[r+3]);a=MX3(a,C1[r],C1[r+1]);b=MX3(b,C1[r+2],C1[r+3]);} \
      float rm=__builtin_fmaxf(a,b); { auto rr=__builtin_amdgcn_permlane32_swap(__float_as_uint(rm),__float_as_uint(rm),false,false); rm=__builtin_fmaxf(__uint_as_float(rr[0]),__uint_as_float(rr[1])); } \
      resc=false; \
      if(__builtin_expect(__any(rm>(float)THRL),0)){ const float dl=__builtin_fmaxf(rm,0.f); mhat+=dl; \
        _Pragma("unroll") for(int r=0;r<16;++r){C0[r]-=dl;C1[r]-=dl;} \
        const float f=__builtin_amdgcn_exp2f(-dl); l_reg*=f; if(hi==0)wsf[r32]=f; resc=true; } } \
    SBAR(); \
    GAPB1(o[0]=__builtin_amdgcn_mfma_f32_32x32x16_bf16(PAF(0),VFR(0),o[0],0,0,0), C0,0,  VRDX(4,4096)); \
    GAPB1(o[0]=__builtin_amdgcn_mfma_f32_32x32x16_bf16(PAF(1),VFR(1),o[0],0,0,0), C0,4,  VRDX(5,4096)); \
    GAPB1(o[0]=__builtin_amdgcn_mfma_f32_32x32x16_bf16(PAF(2),VFR(2),o[0],0,0,0), C0,8,  VRDX(6,4096)); \
    GAPB1(o[0]=__builtin_amdgcn_mfma_f32_32x32x16_bf16(PAF(3),VFR(3),o[0],0,0,0), C0,12, VRDX(7,4096)); \
    GAPB1(o[1]=__builtin_amdgcn_mfma_f32_32x32x16_bf16(PAF(0),VFR(4),o[1],0,0,0), C1,0,  VRDX(0,8192)); \
    GAPB1(o[1]=__builtin_amdgcn_mfma_f32_32x32x16_bf16(PAF(1),VFR(5),o[1],0,0,0), C1,4,  VRDX(1,8192)); \
    GAPB1(o[1]=__builtin_amdgcn_mfma_f32_32x32x16_bf16(PAF(2),VFR(6),o[1],0,0,0), C1,8,  VRDX(2,8192)); \
    GAPB1(o[1]=__builtin_amdgcn_mfma_f32_32x32x16_bf16(PAF(3),VFR(7),o[1],0,0,0), C1,12, VRDX(3,8192)); \
    GAPB2(o[2]=__builtin_amdgcn_mfma_f32_32x32x16_bf16(PAF(0),VFR(0),o[2],0,0,0), GL,P0,0, VRDX(4,12288)); \
    GAPB2(o[2]=__builtin_amdgcn_mfma_f32_32x32x16_bf16(PAF(1),VFR(1),o[2],0,0,0), GL,P0,1, VRDX(5,12288)); \
    GAPB2(o[2]=__builtin_amdgcn_mfma_f32_32x32x16_bf16(PAF(2),VFR(2),o[2],0,0,0), GL,P0,2, VRDX(6,12288)); \
    GAPB2(o[2]=__builtin_amdgcn_mfma_f32_32x32x16_bf16(PAF(3),VFR(3),o[2],0,0,0), GL,P0,3, VRDX(7,12288)); \
    KRD(GL,0); GAPB2(o[3]=__builtin_amdgcn_mfma_f32_32x32x16_bf16(PAF(0),VFR(4),o[3],0,0,0), GL,P1,0, (void)0); \
    KRD(GL,1); GAPB2(o[3]=__builtin_amdgcn_mfma_f32_32x32x16_bf16(PAF(1),VFR(5),o[3],0,0,0), GL,P1,1, (void)0); \
    KRD(GL,2); GAPB2(o[3]=__builtin_amdgcn_mfma_f32_32x32x16_bf16(PAF(2),VFR(6),o[3],0,0,0), GL,P1,2, (void)0); \
    KRD(GL,3); GAPB2(o[3]=__builtin_amdgcn_mfma_f32_32x32x16_bf16(PAF(3),VFR(7),o[3],0,0,0), GL,P1,3, (void)0); \
    }while(0)
  int t=1;
  #undef CMASK
  #define CMASK(P0,P1,t) do{}while(0)
  for(;t+5<NT;t+=2){
    STEP(pB0,pB1,pA0,pA1,t,true,true,true);     WAIT_BAR(3); RESC(); ROT();
    STEP(pA0,pA1,pB0,pB1,t+1,true,true,true);   WAIT_BAR(3); RESC(); ROT();
  }
  #undef CMASK
  #define CMASK(P0,P1,t) do{int jb_=(t)-(NT-4); if(jb_>=0)cmask(P0,P1,jb_,qrel,hi);}while(0)
  #define ENDW(tt) do{ if((tt)+3<NT){WAIT_BAR(3);} else if((tt)+2<NT){WAIT_BAR(2);} else {WAIT_BAR(0);} }while(0)
  for(;t+1<NT;t+=2){
    STEP(pB0,pB1,pA0,pA1,t,(t+3<NT),(t+1<NT),(t+1<NT));       ENDW(t);   RESC(); ROT();
    STEP(pA0,pA1,pB0,pB1,t+1,(t+4<NT),(t+2<NT),(t+2<NT));     ENDW(t+1); RESC(); ROT();
  }
  STEP(pB0,pB1,pA0,pA1,NT-1,false,false,false); RESC();
  { float sacc=pB0[0]+pB0[1]; _Pragma("unroll") for(int r=2;r<16;++r)sacc+=pB0[r]; _Pragma("unroll") for(int r=0;r<16;++r)sacc+=pB1[r]; l_reg+=sacc;
    pw0=(u32x4){PKW(pB0,0),PKW(pB0,2),PKW(pB0,4),PKW(pB0,6)};pw1=(u32x4){PKW(pB0,8),PKW(pB0,10),PKW(pB0,12),PKW(pB0,14)};pw2=(u32x4){PKW(pB1,0),PKW(pB1,2),PKW(pB1,4),PKW(pB1,6)};pw3=(u32x4){PKW(pB1,8),PKW(pB1,10),PKW(pB1,12),PKW(pB1,14)};
    SBAR(); pv4(o,vb0+2*sl_cur,PAF(0),PAF(1),PAF(2),PAF(3)); }
  #undef PKW
  #undef PAF
  #undef VFR
  #undef PIN
  #undef MX3
  #undef GAPA
  #undef GAPB1
  #undef GAPB2
  #undef EX
  #undef VRDX
  #undef QLD
  #undef KRD
  #undef STEP
  #undef ENDW
  {auto rr=__builtin_amdgcn_permlane32_swap(__float_as_uint(l_reg),__float_as_uint(l_reg),false,false);l_reg=__uint_as_float(rr[0])+__uint_as_float(rr[1]);}
  if(hi==0)wsf[32+r32]=l_reg;asm volatile("s_waitcnt lgkmcnt(0)":::"memory");
  float rli[16];
  #pragma unroll
  for(int r=0;r<16;++r)rli[r]=__builtin_amdgcn_rcpf(wsf[32+crow(r,hi)]);
  bf16*Ow=Ou+(long)(wid*QBLK)*OPI;
  asm volatile("s_waitcnt lgkmcnt(0)\n\ts_barrier":::"memory");
  { bf16*stg=(bf16*)(shm)+wid*4096;
    #pragma unroll
    for(int r=0;r<16;++r){const int orow=crow(r,hi);
      #pragma unroll
      for(int d0=0;d0<4;++d0)stg[orow*128+d0*32+r32]=(bf16)(cvtpk_s(o[d0][r]*rli[r],0.f)&0xffffu);}
    asm volatile("s_waitcnt lgkmcnt(0)":::"memory");
    if constexpr(!FUSE){
    #pragma unroll
    for(int i=0;i<8;++i){const int row=i*4+(lane>>4),ch=lane&15; const u32x4 v=*(const u32x4*)(stg+row*128+ch*8); ATTN_STORE16(Ow+(long)row*OPI+ch*8,v);}
    } else {
    const int ch=lane&15; const bf16*O0w=O0+(long)(wid*QBLK)*O0PI;
    const f32x4 g0=*(const f32x4*)(sg+ch*8),g1=*(const f32x4*)(sg+ch*8+4);
    u32x4 a0[8];
    #pragma unroll
    for(int i=0;i<8;++i){const int row=i*4+(lane>>4); a0[i]=*(const u32x4*)(O0w+(long)row*O0PI+ch*8);}
    #pragma unroll
    for(int i=0;i<8;++i){const int row=i*4+(lane>>4); const u32x4 v=*(const u32x4*)(stg+row*128+ch*8); float y[8],ss=0.f;
      #pragma unroll
      for(int j=0;j<4;++j){ y[2*j]=__uint_as_float(a0[i][j]<<16)-lam*__uint_as_float(v[j]<<16); y[2*j+1]=__uint_as_float(a0[i][j]&0xffff0000u)-lam*__uint_as_float(v[j]&0xffff0000u); ss+=y[2*j]*y[2*j]+y[2*j+1]*y[2*j+1]; }
      ss+=__shfl_xor(ss,1);ss+=__shfl_xor(ss,2);ss+=__shfl_xor(ss,4);ss+=__shfl_xor(ss,8);
      const float r=0.8f/sqrtf(ss*(1.f/128.f)+1e-6f);
      u32x4 w; w.x=cvtpk_s(y[0]*r*g0[0],y[1]*r*g0[1]); w.y=cvtpk_s(y[2]*r*g0[2],y[3]*r*g0[3]); w.z=cvtpk_s(y[4]*r*g1[0],y[5]*r*g1[1]); w.w=cvtpk_s(y[6]*r*g1[2],y[7]*r*g1[3]);
      ATTN_STORE16(Ow+(long)row*OPI+ch*8,w);}
    } }
  asm volatile("s_waitcnt lgkmcnt(0)\n\ts_barrier":::"memory");
  #undef DMA_K
  #undef DMA_V
  #undef CMASK
  #undef START
  #undef RESC
  #undef ROT
  #undef MKC
}
#undef SBAR
#undef WAIT_BAR
}

__device__ __forceinline__ void phase2(Frame& F, const Params& P, int item_lo, int item_hi) {
    unsigned char* ws = F.ws;
    const int wid = F.wave;
#define P2_BASES() unsigned char* ws_ = ws; asm volatile("" : "+s"(ws_)); float* out_ = P.out; asm volatile("" : "+s"(out_)); \
    bf16* QB = (bf16*)(ws_ + WS_QBUF); const bf16* KVB = (const bf16*)(ws_ + WS_KVBUF); bf16* DO = (bf16*)out_; (void)QB; (void)KVB; (void)DO
    constexpr int N_DIFF = 1024, N_FOXP = 1024, N_MEM = 1024, N_ITEMS = N_DIFF + N_FOXP + N_MEM;
    float lam;
    { const int lane = lane_id(); const float* lp = P.in[7]; const float a = wave_sum(lp[lane] * lp[64 + lane]), b = wave_sum(lp[128 + lane] * lp[192 + lane]);
      lam = __uint_as_float(__builtin_amdgcn_readfirstlane(__float_as_uint(__expf(a) - __expf(b) + 0.2f))); }
    for (int i = 0;; ++i) {
        const int L4 = (item_lo >> 1) + i * F.G + F.vcu; if (L4 >= (item_hi >> 1) || L4 >= 512) break;
        {
            P2_BASES();
            const int u = L4 >> 3, pr = L4 & 7, b = u >> 2, h = u & 3;
            const long row0 = (long)b * SEQ;
            for (int which = 0; which < 2; ++which) {
                const int qb = which == 0 ? 15 - pr : pr; const long q0 = qb * 256;
                ta::attn_unit128<8, QP, KVP, 2048, false, 2048>(qb, QB + (row0 + q0) * QP + (h * 2 + 0) * 64, KVB + row0 * KVP + (h * 2 + 0) * 64, KVB + row0 * KVP + 512 + h * 128,
                                                    DO + (row0 + q0) * 2048 + h * 128, (char*)F.lds, wid, nullptr, nullptr, 0.f);
                ta::attn_unit128<8, QP, KVP, 512, true, 2048>(qb, QB + (row0 + q0) * QP + (h * 2 + 1) * 64, KVB + row0 * KVP + (h * 2 + 1) * 64, KVB + row0 * KVP + 512 + h * 128,
                                                    (bf16*)(ws_ + WS_YA) + (size_t)(row0 + q0) * 512 + h * 128, (char*)F.lds, wid, DO + (row0 + q0) * 2048 + h * 128, P.in[8], lam);
            }
        }
    }
    for (int i = 0;; ++i) {
        const int L = (item_lo > N_DIFF ? item_lo : N_DIFF) + i * F.G + F.vcu; if (L >= item_hi || L >= N_DIFF + N_FOXP) break;
        {
            P2_BASES();
            const int tid = wid * 64 + lane_id();
            const int pu = L - N_DIFF, bh = pu >> 3, pr = pu & 7, b = bh >> 3, h = bh & 7;
            const long row0 = (long)b * SEQ;
            const int qbmax = 15 - pr;
            {
                const float* CUM = (const float*)(ws_ + WS_CUM) + (size_t)(b * 8 + h) * SEQ; const float* CHTOT = (const float*)(ws_ + WS_CHTOT);
                LAS float* pfx = (LAS float*)(F.lds + ta::LDS_PFX); LAS float* keyarr = (LAS float*)(F.lds + ta::LDS_CK);
                if (tid < 16) { float a = 0.f; for (int c = 0; c < tid; ++c) a += CHTOT[(b * 16 + c) * 8 + h]; pfx[tid] = a; }
                __syncthreads();
                for (int k = tid; k < 256 * (qbmax + 1); k += 512) { const float v = -(CUM[k] + pfx[k >> 8]) * LOG2E;
                    const unsigned hb = cvt_pk_bf16(v, 0.f) & 0xffffu; const float lo = v - __uint_as_float(hb << 16);
                    ((LAS unsigned*)keyarr)[k] = hb | (cvt_pk_bf16(lo, 0.f) << 16); }
                __syncthreads();
            }
            for (int which = 0; which < 2; ++which) {
                const int qb = which == 0 ? qbmax : pr; const long q0 = qb * 256;
                ta::attn_unit<32, QP, KVP, 1024, true, true>(qb, QB + (row0 + q0) * QP + 512 + h * 64, KVB + row0 * KVP + 1024 + h * 64, KVB + row0 * KVP + 1536 + h * 64,
                                                     (bf16*)(ws_ + WS_Y8 + (size_t)(row0 + q0) * 1024 + h * 64), (char*)F.lds, wid);
            }
        }
    }
    for (int i = 0;; ++i) {
        const int L = (item_lo > N_DIFF + N_FOXP ? item_lo : N_DIFF + N_FOXP) + i * F.G + F.vcu; if (L >= item_hi) break;
        {
            P2_BASES();
            const int lane = lane_id(), tid = wid * 64 + lane, r32 = lane & 31, hi = lane >> 5;
            const int mu0 = L - N_DIFF - N_FOXP; const int mu = (F.G == 256) ? ((mu0 & 255) * 4 + (mu0 >> 8)) : mu0;
            const int b = mu >> 6, h = (mu >> 4) & 3, qb = mu & 15;
            const long row0 = (long)b * SEQ, q0 = qb * 256;
            const bf16* MKV = (const bf16*)(ws_ + WS_MEMKV) + (long)b * MEML * DM;
            const float* gq = P.in[14]; const float* gk = P.in[15];
            LAS float* gqk = (LAS float*)(F.lds + sa::R_GQK);
            if (i == 0 || F.G != 256) {
                __syncthreads();
                LAS float* keyarr = (LAS float*)(F.lds + sa::R_KEY);
                const int key = tid >> 1, half = tid & 1; const bf16* kr = MKV + (long)key * DM + h * 128 + half * 64; float ss = 0.f;
#pragma unroll
                for (int c = 0; c < 8; ++c) { const bf16x8 v = *(const bf16x8*)(kr + c * 8);
#pragma unroll
                    for (int j = 0; j < 8; ++j) { const float f = bf2f((unsigned short)v[j]); ss += f * f; } }
                ss += __shfl_xor(ss, 1);
                if (half == 0) keyarr[key] = 1.0f / sqrtf(ss * (1.f / 128.f) + EPS);
                if (tid < 128) gqk[tid] = gq[tid] * gk[tid] * (0.08838834764831845f * LOG2E);
                __syncthreads();
                sa::fill_kv_res(MKV + h * 128, MKV + 512 + h * 128, DM, F.lds, wid, keyarr);
                __syncthreads();
            }
            const bf16* Q = QB + (row0 + q0 + wid * 32 + r32) * QP + 1024 + h * 128 + hi * 8;
            bf16x8 qr[8]; float qf[8][8]; float ss = 0.f;
#pragma unroll
            for (int d0 = 0; d0 < 8; ++d0) { const bf16x8 v = *(const bf16x8*)(Q + d0 * 16);
#pragma unroll
                for (int j = 0; j < 8; ++j) { qf[d0][j] = bf2f((unsigned short)v[j]); ss += qf[d0][j] * qf[d0][j]; } }
            ss += __shfl_xor(ss, 32);
            const float rq = 1.0f / sqrtf(ss * (1.f / 128.f) + EPS);
#pragma unroll
            for (int d0 = 0; d0 < 8; ++d0) { const int ch = d0 * 16 + hi * 8; u32x4 w;
                const f32x4 ga = *(const LAS f32x4*)(gqk + ch), gb = *(const LAS f32x4*)(gqk + ch + 4);
                w[0] = cvt_pk_bf16(qf[d0][0] * rq * ga[0], qf[d0][1] * rq * ga[1]); w[1] = cvt_pk_bf16(qf[d0][2] * rq * ga[2], qf[d0][3] * rq * ga[3]);
                w[2] = cvt_pk_bf16(qf[d0][4] * rq * gb[0], qf[d0][5] * rq * gb[1]); w[3] = cvt_pk_bf16(qf[d0][6] * rq * gb[2], qf[d0][7] * rq * gb[3]);
                qr[d0] = __builtin_bit_cast(bf16x8, w); }
            sa::unit_res(qr, ws_ + WS_Y8 + (size_t)(row0 + q0) * 1024 + 512 + h * 128, 1024, F.lds, wid);
        }
    }
}

struct Sched3a { long a0; int pm;
    __device__ bool next(int j, pg8::Unit& u) const { if (j >= 12) return false; const int pn = j / 3, i = j % 3;
        u.aoff = a0 + (i == 0 ? (long)(WS_YA - WS_Y8) : (long)(i - 1) * 512); u.boff = (i == 0 ? 0 : (long)MiB + (long)(i - 1) * (1024 * 1024)) + (long)pn * 256 * 1024;
        u.gofs = i == 0 ? 0 : 1; u.pm = pm; u.pn = pn; u.sub = i; return true; } };
struct Sched3b { long a0; int pm;
    __device__ bool next(int j, pg8::Unit& u) const { if (j >= 4) return false; u.aoff = a0; u.boff = (long)j * 256 * 2048; u.gofs = 0; u.pm = pm; u.pn = j; u.sub = 0; return true; } };

struct EpiMerge {
    static constexpr bool PERM = true;
    const unsigned char* GT; bf16* MG;
    __device__ __forceinline__ bool operator()(f32x4 (&acc)[2][2][4][2], const pg8::Unit& u, int wr, int wc, int fr_in, int fq_in) const {
        int fr = fr_in, fq = fq_in; asm volatile("" : "+v"(fr), "+v"(fq));
        const int row0 = u.pm * 256 + wr * 64 + fr, i = u.sub;
        const unsigned char* ta_ = GT + (size_t)(u.pm * 12 + i * 4 + u.pn) * 65536 + (size_t)((wr * 4 + wc) * 64 + fq * 16 + fr) * 16;
        if (i < 2) {
            const float sc = i == 0 ? 128.f : 1.f;
#pragma unroll
            for (int ai = 0; ai < 2; ++ai) {
                u32x4 ga[4], gb[4];
#pragma unroll
                for (int m = 0; m < 4; ++m) { ga[m] = *(const u32x4*)(ta_ + (ai * 4 + m) * 8192); gb[m] = *(const u32x4*)(ta_ + 4 * 65536 + (ai * 4 + m) * 8192); }
#pragma unroll
                for (int m = 0; m < 4; ++m)
#pragma unroll
                    for (int bj = 0; bj < 2; ++bj)
#pragma unroll
                        for (int n = 0; n < 2; ++n) { const unsigned a = ga[m][bj * 2 + n], b = gb[m][bj * 2 + n];
#pragma unroll
                            for (int j = 0; j < 4; ++j) acc[ai][bj][m][n][j] *= (float)((a >> (8 * j)) & 255u) * sc * __builtin_amdgcn_rcpf((float)((b >> (8 * j)) & 255u)); }
            }
            return true;
        }
        const int col = u.pn * 256 + g64_col(wc, 0, fq);
        u32x4 ga[8];
#pragma unroll
        for (int jj = 0; jj < 8; ++jj) ga[jj] = *(const u32x4*)(ta_ + jj * 8192);
#pragma unroll
        for (int ai = 0; ai < 2; ++ai)
#pragma unroll
            for (int m = 0; m < 4; ++m) { const int row = row0 + ai * 128 + m * 16; const int jj = ai * 4 + m;
#pragma unroll
                for (int bj = 0; bj < 2; ++bj) { f32x4 v0 = acc[ai][bj][m][0], v1 = acc[ai][bj][m][1]; const unsigned a0 = ga[jj][bj * 2], a1 = ga[jj][bj * 2 + 1];
#pragma unroll
                    for (int j = 0; j < 4; ++j) { v0[j] *= (float)((a0 >> (8 * j)) & 255u) * (1.f / (255.f * 128.f)); v1[j] *= (float)((a1 >> (8 * j)) & 255u) * (1.f / (255.f * 128.f)); }
                    u32x4 w; w.x = cvt_pk_bf16(v0[0], v0[1]); w.y = cvt_pk_bf16(v0[2], v0[3]); w.z = cvt_pk_bf16(v1[0], v1[1]); w.w = cvt_pk_bf16(v1[2], v1[3]);
                    *(u32x4*)(MG + (size_t)row * DM + col + 32 * bj) = w; } }
        return false;
    }
};

struct EpiOut {
    static constexpr bool PERM = true;
    const float* X; float* rowss; bf16* X1B; const float* g2; unsigned char* H2U8;
    __device__ __forceinline__ bool operator()(f32x4 (&acc)[2][2][4][2], const pg8::Unit& u, int wr, int wc, int fr, int fq) const {
        const int col0 = u.pn * 256 + wc * 32 + 8 * fq;
        f32x4 gv[2][2];
#pragma unroll
        for (int bj = 0; bj < 2; ++bj)
#pragma unroll
            for (int n = 0; n < 2; ++n) gv[bj][n] = *(const f32x4*)(g2 + col0 + bj * 128 + n * 4);
#pragma unroll
        for (int am = 0; am < 2; ++am) { const int ai = am, m0 = 0;
            f32x4 xr[4][2][2];
#pragma unroll
            for (int m = m0; m < m0 + 4; ++m) { const size_t off = (size_t)(u.pm * 256 + ai * 128 + wr * 64 + m * 16 + fr) * DM + col0;
#pragma unroll
                for (int bj = 0; bj < 2; ++bj)
#pragma unroll
                    for (int n = 0; n < 2; ++n) xr[m][bj][n] = *(const f32x4*)(X + off + bj * 128 + n * 4); }
#pragma unroll
            for (int m = m0; m < m0 + 4; ++m) { const int rl = ai * 128 + wr * 64 + m * 16 + fr; const size_t off = (size_t)(u.pm * 256 + rl) * DM + col0; float ss = 0.f;
#pragma unroll
                for (int bj = 0; bj < 2; ++bj) { u32x4 w; u32x2 w8;
#pragma unroll
                    for (int n = 0; n < 2; ++n) { const f32x4 o = xr[m][bj][n] + acc[ai][bj][m][n];
                        ss += (o[0] * o[0] + o[1] * o[1]) + (o[2] * o[2] + o[3] * o[3]);
                        w[2 * n] = cvt_pk_bf16(o[0], o[1]); w[2 * n + 1] = cvt_pk_bf16(o[2], o[3]);
                        const f32x4 hv = o * gv[bj][n]; w8[n] = cvt4_fp8(hv[0], hv[1], hv[2], hv[3]); }
                    *(u32x4*)(X1B + off + bj * 128) = w; *(u32x2*)(H2U8 + off + bj * 128) = w8; }
                ss += __shfl_xor(ss, 16); ss += __shfl_xor(ss, 32);
                if (fq == 0) rowss[(size_t)(u.pm * 256 + rl) * 16 + u.pn * 4 + wc] = ss; }
            asm volatile("" ::: "memory");
        }
        return false;
    }
};

__device__ __forceinline__ void phase3(Frame& F, const Params& P) {
    unsigned char* ws = F.ws;
    bf16* QB = (bf16*)(ws + WS_QBUF);
    bf16* H2 = (bf16*)(ws + WS_KVBUF); bf16* MG = (bf16*)(ws + WS_KVBUF + 128 * MiB);
#ifndef NO3A
    if (!(P.dummy & 4)) for (int pm = blockIdx.x; pm < T / 256; pm += F.G) {
        {
            pg8::Gemm g{(const char*)(ws + WS_Y8), (const char*)(ws + WS_WO), 1024, 1024, 512 / 128, nullptr};
            Sched3a S{(long)pm * 256 * 1024, pm}; EpiMerge E{(const unsigned char*)(ws + WS_GATES), MG};
            pg8::gemm_phase<EpiMerge, Sched3a, true, false, true, true>(F.lds, g, S, E, F.wave);
        }
    }
#endif
#ifndef NO3B
    if (!(P.dummy & 8)) for (int pm = blockIdx.x; pm < T / 256; pm += F.G) {
        {
            pg8::Gemm g{(const char*)MG, (const char*)(ws + WS_WOUT), DM * 2, DM * 2, DM / 64, nullptr};
            Sched3b S{(long)pm * 256 * DM * 2, pm}; EpiOut E{P.in[0], (float*)(ws + WS_ROPE), H2, P.in[20], ws + WS_H2U8};
            pg8::gemm_phase<EpiOut, Sched3b, true, false>(F.lds, g, S, E, F.wave);
        }
    }
#endif
#ifndef NO3C
    if (!(P.dummy & 16)) for (int pm = blockIdx.x; pm < T / 256; pm += F.G) {
        {
            const int lane = lane_id(), wid = F.wave, tid = wid * 64 + lane, r32 = lane & 31, hi = lane >> 5;
            const float* rowss = (const float*)(ws + WS_ROPE);
            LAS float* LG = (LAS float*)F.lds;
            LAS int* cnt = (LAS int*)(F.lds + X_TAB);
            LAS float* rs = (LAS float*)(F.lds + 40960) + wid * 32;
            LAS unsigned char* at = F.lds + 45056 + wid * 4608;
            if (tid < 64) cnt[tid] = 0;
            const size_t prow0 = (size_t)pm * 256 + wid * 32;
            if (lane < 32) { const f32x4* rp = (const f32x4*)(rowss + (prow0 + lane) * 16); const f32x4 a = rp[0], b = rp[1], c = rp[2], d = rp[3];
                const float ss = ((a[0] + a[1]) + (a[2] + a[3])) + ((b[0] + b[1]) + (b[2] + b[3])) + ((c[0] + c[1]) + (c[2] + c[3])) + ((d[0] + d[1]) + (d[2] + d[3]));
                rs[lane] = 1.0f / sqrtf(ss * (1.f / DM) + EPS); }
            LDS_WAIT();
            if (lane < 32) ((float*)(ws + WS_RSTD))[prow0 + lane] = rs[lane];
            const int lr8 = lane >> 3, c8 = lane & 7;
            const bf16* hp = H2 + (prow0 + lr8) * DM + 8 * c8;
            const bf16* WR = (const bf16*)(ws + WS_WR) + (size_t)r32 * DM + hi * 8;
            f32x16 a0 = f32x16{}, a1 = f32x16{};
            u32x4 xv[4], xn[4];
#pragma unroll
            for (int i = 0; i < 4; ++i) xv[i] = *(const u32x4*)(hp + (size_t)(8 * i) * DM);
            for (int c = 0; c < 16; ++c) {
                if (c + 1 < 16) {
#pragma unroll
                    for (int i = 0; i < 4; ++i) xn[i] = *(const u32x4*)(hp + (size_t)(8 * i) * DM + (c + 1) * 64);
                }
#pragma unroll
                for (int i = 0; i < 4; ++i) *(LAS u32x4*)(at + (8 * i + lr8) * 144 + c8 * 16) = xv[i];
                LDS_WAIT();
#pragma unroll
                for (int kk = 0; kk < 4; ++kk) {
                    const bf16x8 af = *(const LAS bf16x8*)(at + r32 * 144 + kk * 32 + hi * 16);
                    const bf16x8 b0 = *(const bf16x8*)(WR + c * 64 + kk * 16), b1 = *(const bf16x8*)(WR + (size_t)32 * DM + c * 64 + kk * 16);
                    a0 = __builtin_amdgcn_mfma_f32_32x32x16_bf16(af, b0, a0, 0, 0, 0);
                    a1 = __builtin_amdgcn_mfma_f32_32x32x16_bf16(af, b1, a1, 0, 0, 0);
                }
#pragma unroll
                for (int i = 0; i < 4; ++i) xv[i] = xn[i];
            }
#pragma unroll
            for (int r = 0; r < 16; ++r) { const float sc = rs[sa::crow(r, hi)]; a0[r] *= sc; a1[r] *= sc; }
            __syncthreads();
#pragma unroll
            for (int r = 0; r < 16; ++r) { const int lr = wid * 32 + sa::crow(r, hi); LG[lr * 37 + r32] = a0[r]; if (r32 < 4) LG[lr * 37 + 32 + r32] = a1[r]; }
            __syncthreads();
            if (tid < 256) {
                const float* brg = P.in[22]; const float* bre = P.in[24];
                const LAS float* lg = LG + tid * 37;
                float gl[4]; int gi = 0;
#pragma unroll
                for (int j = 0; j < 4; ++j) gl[j] = lg[j] + brg[j];
#pragma unroll
                for (int j = 1; j < 4; ++j) if (gl[j] > gl[gi]) gi = j;
                float den = 0.f;
#pragma unroll
                for (int j = 0; j < 4; ++j) den += __expf(gl[j] - gl[gi]);
                const float gate = 1.0f / den;
                float el[8];
#pragma unroll
                for (int j = 0; j < 8; ++j) el[j] = lg[4 + 8 * gi + j] + bre[8 * gi + j];
                int i0 = 0;
#pragma unroll
                for (int j = 1; j < 8; ++j) if (el[j] > el[i0]) i0 = j;
                int i1 = i0 == 0 ? 1 : 0;
#pragma unroll
                for (int j = 0; j < 8; ++j) if (j != i0 && el[j] > el[i1]) i1 = j;
                const float w0 = 1.0f / (1.0f + __expf(el[i1] - el[i0])), w1 = 1.0f - w0;
                const int e0 = gi * 8 + i0, e1 = gi * 8 + i1;
                const int r0 = atomicAdd((int*)&cnt[e0], 1), r1 = atomicAdd((int*)&cnt[32 + e1], 1);
                int* RT = (int*)(ws + WS_ROUTE) + ((size_t)pm * 256 + tid) * 8;
                RT[0] = e0; RT[1] = e1; RT[2] = __float_as_int(gate * w0); RT[3] = __float_as_int(gate * w1); RT[4] = r0; RT[5] = r1;
            }
            __syncthreads();
            if (tid < 64) ((int*)(ws + WS_BLKCNT))[pm * 64 + tid] = cnt[tid];
            __syncthreads();
        }
#endif
    }
}

__device__ __forceinline__ void build_bins(Frame& F, int pm_for_prefix) {
    unsigned char* ws = F.ws; const int tid = F.wave * 64 + lane_id();
    LAS int* tab = (LAS int*)(F.lds + X_TAB);
    const int* BC = (const int*)(ws + WS_BLKCNT);
    if (tid < 64) { int tot = 0, pre = 0; for (int p = 0; p < T / 256; ++p) { const int c = BC[p * 64 + tid]; if (p < pm_for_prefix) pre += c; tot += c; } tab[tid] = tot; tab[128 + tid] = pre; }
    __syncthreads();
    if (tid == 0) { int tl = 0; for (int b = 0; b < 64; ++b) { tab[64 + b] = tl * 256; tab[192 + b] = tl; tl += (tab[b] + 255) >> 8; } tab[192 + 64] = tl; }
    __syncthreads();
}

__device__ __forceinline__ void phase4(Frame& F, const Params& P) {
    unsigned char* ws = F.ws; const int tid = F.wave * 64 + lane_id();
    LAS int* tab = (LAS int*)(F.lds + X_TAB);
    int* TOK = (int*)(ws + WS_TOK); float* WL = (float*)(ws + WS_WL);
    for (int pm = blockIdx.x; pm < T / 256; pm += F.G) {
        build_bins(F, pm);
        if (tid < 256) {
            const int tok = pm * 256 + tid; const int* RT = (const int*)(ws + WS_ROUTE) + (size_t)tok * 8;
            const int e0 = RT[0], e1 = RT[1];
            const int d0 = tab[64 + e0] + tab[128 + e0] + RT[4], d1 = tab[64 + 32 + e1] + tab[128 + 32 + e1] + RT[5];
            TOK[d0] = tok; WL[d0] = __int_as_float(RT[2]); TOK[d1] = tok; WL[d1] = __int_as_float(RT[3]);
        }
        __syncthreads();
    }
}

struct SchedMoe { const LAS int* rec; int n; long astep, bstep_e, bstep_pn; bool gather;
    __device__ bool next(int j, pg8::Unit& u) const { if (j >= n) return false; const int rt = __builtin_amdgcn_readfirstlane(rec[4 * j]), pn = __builtin_amdgcn_readfirstlane(rec[4 * j + 1]), bin = __builtin_amdgcn_readfirstlane(rec[4 * j + 2]);
        u.aoff = gather ? 0 : (long)rt * astep; u.boff = (long)(bin & 31) * bstep_e + (long)pn * bstep_pn; u.gofs = j * 256; u.pm = rt; u.pn = pn; u.sub = j; return true; } };

struct EpiUp {
    static constexpr bool PERM = true;
    bf16* ACT; const float* RSTD; const LAS int* gl;
    __device__ __forceinline__ bool operator()(f32x4 (&acc)[2][2][4][2], const pg8::Unit& u, int wr, int wc, int fr, int fq) const {
        const int row0 = u.pm * 256 + wr * 64 + fr;
        float rr[2][4];
#pragma unroll
        for (int ai = 0; ai < 2; ++ai)
#pragma unroll
            for (int m = 0; m < 4; ++m) rr[ai][m] = RSTD[gl[u.gofs + ai * 128 + wr * 64 + m * 16 + fr]] * (1.f / 32.f);
#pragma unroll
        for (int ai = 0; ai < 2; ++ai)
#pragma unroll
            for (int m = 0; m < 4; ++m) { float v[8]; const float r = rr[ai][m];
#pragma unroll
                for (int n = 0; n < 2; ++n)
#pragma unroll
                    for (int j = 0; j < 4; ++j) { const float a = acc[ai][0][m][n][j] * r, b = acc[ai][1][m][n][j] * r; v[4 * n + j] = a * __builtin_amdgcn_rcpf(1.f + __expf(-a)) * b; }
                u32x2 w; w.x = cvt4_fp8(v[0] * 8.f, v[1] * 8.f, v[2] * 8.f, v[3] * 8.f); w.y = cvt4_fp8(v[4] * 8.f, v[5] * 8.f, v[6] * 8.f, v[7] * 8.f);
                *(u32x2*)((unsigned char*)ACT + (size_t)(row0 + ai * 128 + m * 16) * EFF + u.pn * 128 + wc * 32 + fq * 8) = w; }
        return false;
    }
};

struct EpiDown0 {
    static constexpr bool PERM = true;
    bf16* Y0_; const int* TOK_; const float* WL_; const LAS int* rec;
    __device__ __forceinline__ bool operator()(f32x4 (&acc)[2][2][4][2], const pg8::Unit& u, int wr, int wc, int fr, int fq) const {
        bf16* Y0 = Y0_; const int* TOK = TOK_; const float* WL = WL_; asm volatile("" : "+s"(Y0), "+s"(TOK), "+s"(WL));
        const int nvalid = rec[4 * u.sub + 3]; const int col0 = u.pn * 256 + wc * 32 + 8 * fq;
        int tok[2][4]; float w[2][4];
#pragma unroll
        for (int ai = 0; ai < 2; ++ai)
#pragma unroll
            for (int m = 0; m < 4; ++m) { const int rl = ai * 128 + wr * 64 + m * 16 + fr; const bool ok = rl < nvalid;
                tok[ai][m] = ok ? TOK[u.pm * 256 + rl] : -1; w[ai][m] = ok ? WL[u.pm * 256 + rl] * (1.f / 128.f) : 0.f; }
#pragma unroll
        for (int ai = 0; ai < 2; ++ai)
#pragma unroll
            for (int m = 0; m < 4; ++m) { if (tok[ai][m] >= 0) { bf16* op = Y0 + (size_t)tok[ai][m] * DM + col0; const float ww = w[ai][m];
#pragma unroll
                for (int bj = 0; bj < 2; ++bj) { const f32x4 v0 = acc[ai][bj][m][0] * ww, v1 = acc[ai][bj][m][1] * ww;
                    u32x4 o; o.x = cvt_pk_bf16(v0[0], v0[1]); o.y = cvt_pk_bf16(v0[2], v0[3]); o.z = cvt_pk_bf16(v1[0], v1[1]); o.w = cvt_pk_bf16(v1[2], v1[3]);
                    *(u32x4*)(op + bj * 128) = o; } } }
        return false;
    }
};
struct EpiDown1 {
    static constexpr bool PERM = true;
    float* O_; const bf16* Y0_; const bf16* X1_; const int* TOK_; const float* WL_; const LAS int* rec;
    __device__ __forceinline__ bool operator()(f32x4 (&acc)[2][2][4][2], const pg8::Unit& u, int wr, int wc, int fr, int fq) const {
        float* O = O_; const bf16* Y0 = Y0_; const bf16* X1 = X1_; const int* TOK = TOK_; const float* WL = WL_; asm volatile("" : "+s"(O), "+s"(Y0), "+s"(X1), "+s"(TOK), "+s"(WL));
        const int nvalid = rec[4 * u.sub + 3]; const int col0 = u.pn * 256 + wc * 32 + 8 * fq;
#pragma unroll
        for (int am = 0; am < 2; ++am) { const int ai = am;
            int tok[4]; float w[4]; u32x4 xr[4][2]; u32x4 yr[4][2];
#pragma unroll
            for (int m = 0; m < 4; ++m) { const int rl = ai * 128 + wr * 64 + m * 16 + fr; const bool ok = rl < nvalid;
                tok[m] = ok ? TOK[u.pm * 256 + rl] : -1; w[m] = ok ? WL[u.pm * 256 + rl] * (1.f / 128.f) : 0.f; }
#pragma unroll
            for (int m = 0; m < 4; ++m) { const size_t ro = (size_t)(tok[m] < 0 ? 0 : tok[m]) * DM + col0;
#pragma unroll
                for (int bj = 0; bj < 2; ++bj) { yr[m][bj] = *(const u32x4*)(Y0 + ro + bj * 128); xr[m][bj] = *(const u32x4*)(X1 + ro + bj * 128); } }
#pragma unroll
            for (int m = 0; m < 4; ++m) { if (tok[m] >= 0) { float* op = O + (size_t)tok[m] * DM + col0;
#pragma unroll
                for (int bj = 0; bj < 2; ++bj)
#pragma unroll
                    for (int n = 0; n < 2; ++n) { const unsigned ya = yr[m][bj][2 * n], yb = yr[m][bj][2 * n + 1], xa = xr[m][bj][2 * n], xb = xr[m][bj][2 * n + 1];
                        const f32x4 yv = {__uint_as_float(ya << 16), __uint_as_float(ya & 0xffff0000u), __uint_as_float(yb << 16), __uint_as_float(yb & 0xffff0000u)};
                        const f32x4 xv = {__uint_as_float(xa << 16), __uint_as_float(xa & 0xffff0000u), __uint_as_float(xb << 16), __uint_as_float(xb & 0xffff0000u)};
                        *(f32x4*)(op + bj * 128 + n * 4) = xv + yv + acc[ai][bj][m][n] * w[m]; } } }
            asm volatile("" ::: "memory");
        }
        return false;
    }
};

__device__ __forceinline__ void phase_moe(Frame& F, const Params& P, int mode, int sub = 0) {
    unsigned char* ws = F.ws;
#if MK_N_LAUNCHES == 1
    if ((int)blockIdx.x >= T / 256) build_bins(F, 0);
#else
    build_bins(F, 0);
#endif
    LAS int* tab = (LAS int*)(F.lds + X_TAB); LAS int* rec = tab + 512; LAS int* gl = (LAS int*)(F.lds + X_ROWSS);
    const int b_lo = mode == 0 ? 32 * sub : (mode == 2 ? 32 : 0), b_hi = b_lo + 32;
    const int t_lo = __builtin_amdgcn_readfirstlane(tab[192 + b_lo]), t_hi = __builtin_amdgcn_readfirstlane(tab[192 + b_hi]), nunits = (t_hi - t_lo) * 4;
    const int u0 = __builtin_amdgcn_readfirstlane(tab[192 + 32]) * 4, u1 = __builtin_amdgcn_readfirstlane(tab[192 + 64]) * 4 - u0;
    const int rot = (mode == 0 ? (sub ? u0 : 0) : (mode == 1 ? u0 + u1 : 2 * u0 + u1)) % F.G;
    const int vc = (F.vcu + F.G - rot) % F.G;
    const int* TOK = (const int*)(ws + WS_TOK);
    for (int base = 0;; base += 16) {
        const int Lb = base * F.G + vc; if (Lb >= nunits) break;
        __syncthreads();
        const int tid = F.wave * 64 + lane_id();
        if (tid < 16) { const int L = (base + tid) * F.G + vc;
            if (L < nunits) { const int rt = t_lo + (L >> 2), pn = L & 3; int bin = b_lo; while (tab[192 + bin + 1] <= rt) ++bin;
                int nv = tab[bin] - (rt - tab[192 + bin]) * 256; nv = nv > 256 ? 256 : nv;
                rec[4 * tid] = rt; rec[4 * tid + 1] = pn; rec[4 * tid + 2] = bin; rec[4 * tid + 3] = nv; }
            else rec[4 * tid] = -1; }
        __syncthreads();
        int n = 0;
        _Pragma("nounroll") while (n < 16 && __builtin_amdgcn_readfirstlane(rec[4 * n]) >= 0) ++n;
        if (mode == 0) {
            for (int e = tid; e < n * 256; e += 512) { const int j = e >> 8, r = e & 255; gl[e] = r < rec[4 * j + 3] ? TOK[rec[4 * j] * 256 + r] : 0; }
            __syncthreads();
            pg8::Gemm g{(const char*)(ws + WS_H2U8), (const char*)(ws + WS_WUP), DM, DM, DM / 128, gl};
            SchedMoe S{rec, n, 0, 1024L * 1024, 256L * 1024, true}; EpiUp E{(bf16*)(ws + WS_GATES), (const float*)(ws + WS_RSTD), gl};
            pg8::gemm_phase<EpiUp, SchedMoe, true, true, true>(F.lds, g, S, E, F.wave);
        } else {
            pg8::Gemm g{(const char*)(ws + WS_GATES), (const char*)(ws + WS_WDN), EFF, EFF, EFF / 128, gl};
            SchedMoe S{rec, n, 256L * EFF, 1024L * 512, 256L * 512, false};
            bf16* Y0 = (bf16*)(ws + WS_KVBUF + 128 * MiB);
            if (mode == 1) { EpiDown0 E{Y0, TOK, (const float*)(ws + WS_WL), rec}; pg8::gemm_phase<EpiDown0, SchedMoe, true, false, true>(F.lds, g, S, E, F.wave); }
            else { EpiDown1 E{P.out, Y0, (const bf16*)(ws + WS_KVBUF), TOK, (const float*)(ws + WS_WL), rec}; pg8::gemm_phase<EpiDown1, SchedMoe, true, false, true>(F.lds, g, S, E, F.wave); }
        }
    }
}

__global__ void __launch_bounds__(512, 2) fwd_kernel(Params P) {
    extern __shared__ __attribute__((aligned(16))) unsigned char lds_raw[];
    Frame F;
    F.lds = (LAS unsigned char*)lds_raw;
    F.wave = __builtin_amdgcn_readfirstlane((int)threadIdx.x >> 6);
    F.G = gridDim.x; { const int bx = blockIdx.x; F.vcu = (F.G % 8 == 0) ? (bx % 8) * (F.G / 8) + bx / 8 : bx; }
    F.ws = P.ws;
    const int lo = P.ph_lo, hi = P.ph_hi;
#if MK_N_LAUNCHES == 1
    volatile LAS unsigned* bst = (volatile LAS unsigned*)(F.lds + X_BARST);
    { const int t_ = F.wave * 64 + lane_id(); if (t_ < 2) bst[t_] = 0u; }
    __syncthreads();
    XcdBarrier bar = xcd_barrier_post((unsigned*)(P.ws + WS_CTL) + CW_BAR, bst, F.wave == 0 && lane_id() == 0);
#endif
#ifndef PH_MASK
#define PH_MASK 0xff
#endif
#define IN(k) (((PH_MASK >> (k)) & 1) && lo <= (k) && (k) < hi)
#if MK_N_LAUNCHES == 1
#define SEAM(k) do { if (IN(k) && IN((k) + 1)) { xcd_barrier(bar, F.wave == 0 && lane_id() == 0); } } while (0)
#else
#define SEAM(k) do { } while (0)
#endif
    if (IN(0)) phase0(F, P);
    SEAM(0);
    if (IN(1)) phase1(F, P);
    SEAM(1);
    if (IN(2)) phase2(F, P, P.item_lo, P.item_hi);
    SEAM(2);
    if (IN(3)) phase3(F, P);
    SEAM(3);
    if (IN(4)) phase4(F, P);
    SEAM(4);
    if (IN(5)) { phase_moe(F, P, 0, 0); flag_signal((unsigned*)(P.ws + WS_CTL) + CW_BAR, XB_FLAG_A, F.wave == 0 && lane_id() == 0); phase_moe(F, P, 0, 1); }
    if (IN(6)) { flag_wait((unsigned*)(P.ws + WS_CTL) + CW_BAR, XB_FLAG_A, F.wave == 0 && lane_id() == 0); phase_moe(F, P, 1); }
    SEAM(6);
    if (IN(7)) phase_moe(F, P, 2);
#undef IN
#undef SEAM
}

extern "C" void kernel_launch(void* const* d_in, const int* in_sizes, int n_in, void* d_out, int out_size, void* d_ws, size_t ws_size, hipStream_t stream) {
    static int grid = 0;
    if (grid == 0) {
        if (n_in != 27 || out_size != T * DM || ws_size < WS_END) { fprintf(stderr, "kernel_launch: unexpected shapes (n_in %d out %d ws %zu)\n", n_in, out_size, ws_size); grid = -1; return; }
        int dev = 0, cus = 0, per_cu = 0;
        hipGetDevice(&dev); hipDeviceGetAttribute(&cus, hipDeviceAttributeMultiprocessorCount, dev);
        hipFuncSetAttribute((const void*)fwd_kernel, hipFuncAttributeMaxDynamicSharedMemorySize, LDS_BYTES);
        hipOccupancyMaxActiveBlocksPerMultiprocessor(&per_cu, (const void*)fwd_kernel, 512, LDS_BYTES);
        if (per_cu < 1) { fprintf(stderr, "kernel_launch: occupancy query says %d blocks per CU\n", per_cu); per_cu = 1; }
        grid = cus * 1;
        (void)hipGetLastError();
    }
    if (grid < 0) return;
    Params p{};
    for (int i = 0; i < 27; ++i) p.in[i] = (const float*)d_in[i];
    p.out = (float*)d_out; p.ws = (unsigned char*)d_ws; p.item_lo = 0; p.item_hi = 3072;
#if MK_N_LAUNCHES == 1
    p.ph_lo = 0; p.ph_hi = 8;
    (void)hipMemsetAsync((char*)d_ws + WS_CTL, 0, CTL_ZERO_BYTES, stream);
    void* args[] = {&p};
    hipError_t e = hipLaunchCooperativeKernel((const void*)fwd_kernel, dim3(grid), dim3(512), args, LDS_BYTES, stream);
    if (e != hipSuccess) fprintf(stderr, "cooperative launch failed: %s (grid %d)\n", hipGetErrorString(e), grid);
#else
#ifndef PHASE_LIST
#define PHASE_LIST {0, 1, 2, 3, 4, 5, 6, 7}
#endif
    const int plist[] = PHASE_LIST;
    for (int ph : plist) { p.item_lo = 0; p.item_hi = 3072; p.dummy = 0; int k = ph;
        if (ph == 100) { k = 2; p.item_hi = 1024; } else if (ph == 200) { k = 2; p.item_lo = 1024; p.item_hi = 2048; p.dummy = 1; } else if (ph == 201) { k = 2; p.item_lo = 2048; p.dummy = 1; }
        else if (ph == 150) { k = 1; p.dummy = 1; }
        else if (ph >= 300 && ph < 400) { k = 3; p.dummy = 1 | (ph - 300); }
        else if (ph >= 400) { k = ph / 100; p.dummy = 1; }
        p.ph_lo = k; p.ph_hi = k + 1; hipLaunchKernelGGL(fwd_kernel, dim3(grid), dim3(512), LDS_BYTES, stream, p); }
#endif
}
```

```cpp
#include <hip/hip_runtime.h>
#include <type_traits>
#include <hip/hip_cooperative_groups.h>
#include <cstdio>
#include <cstdint>
namespace cg = cooperative_groups;

#ifndef MK_N_LAUNCHES
#define MK_N_LAUNCHES 1
#endif

#define LAS __attribute__((address_space(3)))
typedef unsigned short bf16;
typedef short bf16x8 __attribute__((ext_vector_type(8)));
typedef short s16x4 __attribute__((ext_vector_type(4)));
typedef float f32x4 __attribute__((ext_vector_type(4)));
typedef float f32x16 __attribute__((ext_vector_type(16)));
typedef unsigned u32x4 __attribute__((ext_vector_type(4)));
typedef unsigned u32x2 __attribute__((ext_vector_type(2)));

constexpr int DM = 1024, NB = 16, SEQ = 4096, T = NB * SEQ, MEML = 256;
constexpr int NEXP = 32, EFF = 512;
constexpr float EPS = 1e-6f;
constexpr float LOG2E = 1.4426950408889634f;
constexpr int IN_COLS = 6664;
constexpr int N1 = 1536;
constexpr int QP = 1536, KVP = 2048, GP = 3072;
constexpr int MAXROWS = 2 * T + 64 * 256;

constexpr size_t MiB = 1u << 20;
constexpr size_t WS_CTL = 0;
constexpr size_t WS_WIN = 1 * MiB;
constexpr size_t WS_W8 = 8 * MiB;
constexpr size_t WS_WQK8 = 12 * MiB;
constexpr size_t WS_WMKV = 14 * MiB;
constexpr size_t WS_WO = 16 * MiB;
constexpr size_t WS_WOUT = 19 * MiB;
constexpr size_t WS_WR = 21 * MiB;
constexpr size_t WS_ROPE = 22 * MiB;
constexpr size_t WS_CUM = 26 * MiB;
constexpr size_t WS_CHTOT = 28 * MiB;
constexpr size_t WS_BLKCNT = 28 * MiB + 65536;
constexpr size_t WS_RSTD = 28 * MiB + 262144;
constexpr size_t WS_RINVA = 28 * MiB + 524288;
constexpr size_t WS_XFLAG = 28 * MiB + 786432;
constexpr size_t WS_ROUTE = 29 * MiB;
constexpr size_t WS_TOK = 31 * MiB;
constexpr size_t WS_WL = 32 * MiB;
constexpr size_t WS_MEMN = 33 * MiB;
constexpr size_t WS_MEMKV = 41 * MiB;
constexpr size_t WS_WUP = 49 * MiB;
constexpr size_t WS_WDN = 113 * MiB;
constexpr size_t WS_QBUF = 145 * MiB;
constexpr size_t WS_KVBUF = 337 * MiB;
constexpr size_t WS_GATES = 593 * MiB;
constexpr size_t WS_H2U8 = WS_GATES + 192 * MiB;
constexpr size_t WS_Y8 = WS_H2U8 + 64 * MiB;
constexpr size_t WS_YA = WS_Y8 + 64 * MiB;
constexpr size_t WS_END = 977 * MiB;

constexpr int RING_BYTES = 131072;
constexpr int XOFF = RING_BYTES;
constexpr int X_ROWSS = XOFF;
constexpr int X_TAB = XOFF + 16384;
constexpr int X_BARST = X_TAB + 4096;
constexpr int LDS_BYTES = XOFF + 24576;
constexpr int CW_BAR = 4096;
constexpr size_t CTL_ZERO_BYTES = 65536;

struct Params {
    const float* in[27];
    float* out;
    unsigned char* ws;
    int ph_lo, ph_hi, item_lo, item_hi, dummy, pad_;
};

__device__ __forceinline__ unsigned cvt_pk_bf16(float lo, float hi) { unsigned r; asm volatile("v_cvt_pk_bf16_f32 %0, %1, %2" : "=v"(r) : "v"(lo), "v"(hi)); return r; }
__device__ __forceinline__ float bf2f(unsigned short h) { return __uint_as_float((unsigned)h << 16); }
__device__ __forceinline__ float wave_sum(float v) {
#pragma unroll
    for (int o = 1; o < 16; o <<= 1) v += __shfl_xor(v, o);
    { const auto rr = __builtin_amdgcn_permlane16_swap(__float_as_uint(v), __float_as_uint(v), false, false); v = __uint_as_float(rr[0]) + __uint_as_float(rr[1]); }
    { const auto rr = __builtin_amdgcn_permlane32_swap(__float_as_uint(v), __float_as_uint(v), false, false); v = __uint_as_float(rr[0]) + __uint_as_float(rr[1]); }
    return v;
}
__device__ __forceinline__ int lane_id() { int l; asm volatile("v_mbcnt_lo_u32_b32 %0, -1, 0\n\tv_mbcnt_hi_u32_b32 %0, -1, %0" : "=v"(l)); return l; }
__device__ __forceinline__ unsigned cvt4_fp8(float a, float b, float c, float d) { int p = __builtin_amdgcn_cvt_pk_fp8_f32(a, b, 0, false); p = __builtin_amdgcn_cvt_pk_fp8_f32(c, d, p, true); return (unsigned)p; }
#define LDS_WAIT() asm volatile("s_waitcnt lgkmcnt(0)" ::: "memory")
#define VM_WAIT() asm volatile("s_waitcnt vmcnt(0)" ::: "memory")


#define RLX_AGENT __ATOMIC_RELAXED, __HIP_MEMORY_SCOPE_AGENT
#define XB_TMO      128
#define XB_XCNT(j)  (256  + 64 * (j))
#define XB_XSUB(j)  (1280 + 64 * (j))
#define XB_XGEN(j)  (2304 + 64 * (j))
#define XB_TOP      3328
#define XB_TOPGEN   3392
#define XCD_BAR_WORDS 3456
#define XB_SPIN_CAP (1u << 20)
__device__ __forceinline__ unsigned xb_ld(unsigned* p)              { return __hip_atomic_load(p, __ATOMIC_RELAXED, __HIP_MEMORY_SCOPE_AGENT); }
__device__ __forceinline__ unsigned xb_add(unsigned* p, unsigned v) { return __hip_atomic_fetch_add(p, v, __ATOMIC_RELAXED, __HIP_MEMORY_SCOPE_AGENT); }
__device__ __forceinline__ unsigned xb_xcc_id() { return (unsigned)__builtin_amdgcn_s_getreg((3 << 11) | 20) & 0xFu; }
#define XB_SPIN(cond, bar) do { unsigned _sp = 0; while (cond) { __builtin_amdgcn_s_sleep(1); \
    if ((++_sp & 255u) == 0u) { if (xb_ld(&(bar)[XB_TMO])) break; if (_sp > XB_SPIN_CAP) { atomicAdd(&(bar)[XB_TMO], 1u); break; } } } } while (0)
struct XcdBarrier { unsigned* bar; unsigned x; volatile LAS unsigned* st; };
__device__ __forceinline__ XcdBarrier xcd_barrier_post(unsigned* bar, volatile LAS unsigned* st, bool t0) {
    XcdBarrier b; b.bar = bar; b.x = xb_xcc_id(); b.st = st;
    if (t0) (void)xb_add(&bar[XB_XCNT(b.x)], 1u);
    return b;
}
__device__ __forceinline__ void xcd_barrier_complete(unsigned* bar, unsigned x, unsigned& nloc, unsigned& nx) {
    const unsigned G = gridDim.x * gridDim.y * gridDim.z;
    unsigned sum, cnt, mine, sp = 0u;
    for (;;) {
        sum = 0u; cnt = 0u; mine = 0u;
#pragma unroll
        for (unsigned j = 0; j < 16; ++j) { const unsigned c = xb_ld(&bar[XB_XCNT(j)]); sum += c; cnt += (c > 0u) ? 1u : 0u; mine = (j == x) ? c : mine; }
        if (sum == G) break;
        __builtin_amdgcn_s_sleep(1);
        if ((++sp & 255u) == 0u) { if (xb_ld(&bar[XB_TMO])) break; if (sp > XB_SPIN_CAP) { atomicAdd(&bar[XB_TMO], 1u); break; } }
    }
    nloc = mine > 0u ? mine : 1u; nx = cnt > 0u ? cnt : 1u;
}
__device__ __forceinline__ void xcd_barrier(const XcdBarrier& b, bool t0) {
    asm volatile("s_waitcnt vmcnt(0)" ::: "memory");
    __syncthreads();
    if (t0) {
        unsigned* bar = b.bar;
        __builtin_amdgcn_s_waitcnt(0);
        unsigned nloc = b.st[0], nx = b.st[1];
        if (nloc == 0u) { xcd_barrier_complete(bar, b.x, nloc, nx); b.st[0] = nloc; b.st[1] = nx; }
        const unsigned old = xb_add(&bar[XB_XSUB(b.x)], 1u);
        const unsigned gen = old / nloc;
        if (old + 1u == (gen + 1u) * nloc) {
            __builtin_amdgcn_fence(__ATOMIC_RELEASE, "agent");
            asm volatile("s_waitcnt vmcnt(0)" ::: "memory");
            const unsigned og = xb_add(&bar[XB_TOP], 1u);
            const unsigned tg = og / nx;
            if (og + 1u == (tg + 1u) * nx) xb_add(&bar[XB_TOPGEN], 1u);
            else XB_SPIN(xb_ld(&bar[XB_TOPGEN]) == tg, bar);
            __builtin_amdgcn_fence(__ATOMIC_ACQUIRE, "agent");
            xb_add(&bar[XB_XGEN(b.x)], 1u);
            asm volatile("s_waitcnt vmcnt(0)" ::: "memory");
        } else {
            XB_SPIN(xb_ld(&bar[XB_XGEN(b.x)]) == gen, bar);
            __builtin_amdgcn_fence(__ATOMIC_ACQUIRE, "agent");
            asm volatile("s_waitcnt vmcnt(0)" ::: "memory");
        }
    }
    __syncthreads();
}
#define XB_FLAG_A (XCD_BAR_WORDS + 64)
__device__ __forceinline__ void flag_signal(unsigned* bar, int word, bool t0) {
    asm volatile("s_waitcnt vmcnt(0)" ::: "memory");
    __syncthreads();
    if (t0) { __builtin_amdgcn_fence(__ATOMIC_RELEASE, "agent"); asm volatile("s_waitcnt vmcnt(0)" ::: "memory"); (void)xb_add(&bar[word], 1u); }
}
__device__ __forceinline__ void flag_wait(unsigned* bar, int word, bool t0) {
    if (t0) { const unsigned G = gridDim.x; XB_SPIN(xb_ld(&bar[word]) < G, bar); __builtin_amdgcn_fence(__ATOMIC_ACQUIRE, "agent"); asm volatile("s_waitcnt vmcnt(0)" ::: "memory"); }
    __syncthreads();
}

namespace pg8 {
typedef int v4i_t __attribute__((ext_vector_type(4)));
typedef int v8i_t __attribute__((ext_vector_type(8)));
constexpr int BM = 256, BK = 64, HALF = 128, HTB = HALF * BK * 2, STAGE_BYTES = 8 * HTB;
__host__ __device__ __forceinline__ int lds_byte(int r, int c) { const int st = (r >> 4) * 2 + (c >> 5), rr = r & 15, cc = c & 31, ob = rr * 64 + cc * 2; return st * 1024 + (ob ^ (((ob >> 9) & 1) << 5)); }
__host__ __device__ __forceinline__ void stage_rc(int b, int& R, int& C) { const int st = b / 1024, sb = b % 1024, swz = sb ^ (((sb >> 9) & 1) << 5); R = (st >> 1) * 16 + swz / 64; C = (st & 1) * 32 + (swz % 64) / 2; }
__device__ __forceinline__ const char* uni_ptr64(const char* p) { const unsigned long u = (unsigned long)p;
    const unsigned lo = __builtin_amdgcn_readfirstlane((unsigned)u), hi = __builtin_amdgcn_readfirstlane((unsigned)(u >> 32)); return (const char*)(((unsigned long)hi << 32) | lo); }
__device__ __forceinline__ void glds16_s(const char* sbase, unsigned voff, unsigned lds_dst) { unsigned keep;
    asm volatile("s_mov_b32 %0, m0\n\ts_mov_b32 m0, %3\n\ts_nop 0\n\tglobal_load_lds_dwordx4 %1, %2\n\ts_mov_b32 m0, %0" : "=&s"(keep) : "v"(voff), "s"(sbase), "s"(lds_dst) : "memory"); }
__host__ __device__ __forceinline__ int perm32(int rho) { const int n = rho >> 4, i = rho & 15; return 8 * (i >> 2) + 4 * n + (i & 3); }

struct Unit { long aoff, boff; int gofs; int pm, pn, sub; };
struct Gemm { const char* A; const char* Bt; int lda, ldb, nt; const LAS int* gl; };

template <class Epi, class Sched, bool ALIGN_EPI, bool GATHER, bool FP8 = false, bool MIXED = false>
__device__ __forceinline__ void gemm_phase(LAS unsigned char* lds, const Gemm g, const Sched& S, Epi& E, int wid) {
    const int lane = lane_id(), tid = wid * 64 + lane, wr = wid >> 2, wc = wid & 3, fr = lane & 15, fq = lane >> 4;
    const int nt = g.nt;
    int Rr[2], Cb[2]; unsigned voffB[2], voffA[2][2];
#pragma unroll
    for (int i = 0; i < 2; ++i) { int R, C; stage_rc(tid * 16 + i * 8192, R, C); const int Rb = Epi::PERM ? ((R & ~31) + perm32(R & 31)) : R;
        Rr[i] = R; Cb[i] = C * 2; voffB[i] = (unsigned)(Rb * g.ldb + C * 2); }
    const size_t kstep = (size_t)(BK * 2);
    const size_t hstepB = (size_t)HALF * g.ldb;
    const unsigned ldsw = (unsigned)wid * 1024u;
    const unsigned lds_u = (unsigned)(unsigned long)(LAS unsigned char*)lds;

#define PG8_SETA(u) do { _Pragma("unroll") for (int _h = 0; _h < 2; ++_h) _Pragma("unroll") for (int _i = 0; _i < 2; ++_i) { const int _row = _h * HALF + Rr[_i]; \
        const int _src = GATHER ? g.gl[(u).gofs + _row] : _row; voffA[_h][_i] = (unsigned)_src * (unsigned)g.lda + (unsigned)Cb[_i]; } } while (0)
#define PG8_SA(b, h) (((b) * 2 + (h)) * HTB)
#define PG8_SB(b, h) ((4 + (b) * 2 + (h)) * HTB)
#define PG8_STAGE_A(bufoff, gbase, h) do { _Pragma("unroll") for (int _i = 0; _i < 2; ++_i) \
        glds16_s((const char*)(gbase), voffA[h][_i], lds_u + (unsigned)(bufoff) + ldsw + _i * 8192u); } while (0)
#define PG8_STAGE_B(bufoff, gbase) do { _Pragma("unroll") for (int _i = 0; _i < 2; ++_i) \
        glds16_s((const char*)(gbase), voffB[_i], lds_u + (unsigned)(bufoff) + ldsw + _i * 8192u); } while (0)
#define PG8_LDA(dst, b, h) do { if constexpr (FP8) { _Pragma("unroll") for (int m = 0; m < 4; ++m) { const LAS unsigned char* p_ = lds + PG8_SA(b, h) + aoff + m * 2048; \
            dst##8[m] = __builtin_shufflevector(*(const LAS v4i_t*)p_, *(const LAS v4i_t*)(p_ + 1024), 0, 1, 2, 3, 4, 5, 6, 7); } } \
        else { _Pragma("unroll") for (int m = 0; m < 4; ++m) _Pragma("unroll") for (int k = 0; k < 2; ++k) dst[m][k] = *(const LAS bf16x8*)(lds + PG8_SA(b, h) + aoff + m * 2048 + k * 1024); } } while (0)
#define PG8_LDB(dst, b, h) do { if constexpr (FP8) { _Pragma("unroll") for (int n = 0; n < 2; ++n) { const LAS unsigned char* p_ = lds + PG8_SB(b, h) + boff + n * 2048; \
            dst##8[n] = __builtin_shufflevector(*(const LAS v4i_t*)p_, *(const LAS v4i_t*)(p_ + 1024), 0, 1, 2, 3, 4, 5, 6, 7); } } \
        else { _Pragma("unroll") for (int n = 0; n < 2; ++n) _Pragma("unroll") for (int k = 0; k < 2; ++k) dst[n][k] = *(const LAS bf16x8*)(lds + PG8_SB(b, h) + boff + n * 2048 + k * 1024); } } while (0)
#define PG8_MMA(ai, bj, At, Bt) do { __builtin_amdgcn_s_setprio(1); if constexpr (F8U) { _Pragma("unroll") for (int m = 0; m < 4; ++m) _Pragma("unroll") for (int n = 0; n < 2; ++n) \
        acc[ai][bj][m][n] = __builtin_amdgcn_mfma_scale_f32_16x16x128_f8f6f4(Bt##8[n], At##8[m], acc[ai][bj][m][n], 0, 0, 0, 0, 0, 0); } \
        else if constexpr (FP8) { _Pragma("unroll") for (int m = 0; m < 4; ++m) _Pragma("unroll") for (int n = 0; n < 2; ++n) {   \
        acc[ai][bj][m][n] = __builtin_amdgcn_mfma_f32_16x16x32_bf16(__builtin_bit_cast(bf16x8, __builtin_shufflevector(Bt##8[n], Bt##8[n], 0, 1, 2, 3)), __builtin_bit_cast(bf16x8, __builtin_shufflevector(At##8[m], At##8[m], 0, 1, 2, 3)), acc[ai][bj][m][n], 0, 0, 0); \
        acc[ai][bj][m][n] = __builtin_amdgcn_mfma_f32_16x16x32_bf16(__builtin_bit_cast(bf16x8, __builtin_shufflevector(Bt##8[n], Bt##8[n], 4, 5, 6, 7)), __builtin_bit_cast(bf16x8, __builtin_shufflevector(At##8[m], At##8[m], 4, 5, 6, 7)), acc[ai][bj][m][n], 0, 0, 0); } } \
        else { _Pragma("unroll") for (int m = 0; m < 4; ++m) _Pragma("unroll") for (int n = 0; n < 2; ++n) _Pragma("unroll") for (int k = 0; k < 2; ++k) \
        acc[ai][bj][m][n] = __builtin_amdgcn_mfma_f32_16x16x32_bf16(Bt[n][k], At[m][k], acc[ai][bj][m][n], 0, 0, 0); } __builtin_amdgcn_s_setprio(0); } while (0)
#define PG8_WR_NOW() ({ int w_ = wid; asm volatile("" : "+s"(w_)); w_ >> 2; })
#define PG8_WAIT_V(n) asm volatile("s_waitcnt vmcnt(" #n ")" ::: "memory")
#define PG8_WAIT_L(n) asm volatile("s_waitcnt lgkmcnt(" #n ")" ::: "memory")
#define PG8_BAR __builtin_amdgcn_s_barrier()
#define PG8_SCHED __builtin_amdgcn_sched_barrier(0)
#define PG8_KLOOP(F8U_, NTU_) do { constexpr bool F8U = (F8U_); const int nt_u = (NTU_); \
_Pragma("nounroll") for (int t = 0; t < nt_u; t += 2) { \
            const bool last = (t == nt_u - 2); \
            const char* a1 = cA + (size_t)(t + 1) * kstep; \
            const char* a2 = last ? nA : cA + (size_t)(t + 2) * kstep; const char* b2 = last ? nB : cB + (size_t)(t + 2) * kstep; \
            const char* a3 = a2 + kstep; const char* b3 = b2 + kstep; \
            PG8_LDB(B0, 0, 0); PG8_LDB(B1, 0, 1); PG8_SCHED; PG8_LDA(At, 0, 0); PG8_STAGE_A(PG8_SA(1, 1), a1, 1); \
            if (GATHER) { if (last && has_next) PG8_SETA(nxt); } \
            PG8_WAIT_V(8); PG8_WAIT_L(0); PG8_BAR; PG8_MMA(0, 0, At, B0); PG8_MMA(0, 1, At, B1); PG8_BAR; PG8_SCHED; \
            PG8_LDA(At, 0, 1); PG8_STAGE_B(PG8_SB(0, 0), b2); PG8_STAGE_B(PG8_SB(0, 1), b2 + hstepB); PG8_STAGE_A(PG8_SA(0, 0), a2, 0); \
            PG8_WAIT_V(8); PG8_WAIT_L(0); PG8_BAR; PG8_MMA(1, 0, At, B0); PG8_MMA(1, 1, At, B1); PG8_BAR; PG8_SCHED; \
            PG8_LDB(B0, 1, 0); PG8_LDB(B1, 1, 1); PG8_SCHED; PG8_LDA(At, 1, 0); PG8_STAGE_A(PG8_SA(0, 1), a2, 1); \
            PG8_WAIT_V(8); PG8_WAIT_L(0); PG8_BAR; PG8_MMA(0, 0, At, B0); PG8_MMA(0, 1, At, B1); PG8_BAR; PG8_SCHED; \
            PG8_LDA(At, 1, 1); PG8_STAGE_B(PG8_SB(1, 0), b3); PG8_STAGE_B(PG8_SB(1, 1), b3 + hstepB); PG8_STAGE_A(PG8_SA(1, 0), a3, 0); \
            PG8_WAIT_V(8); PG8_WAIT_L(0); PG8_BAR; PG8_MMA(1, 0, At, B0); PG8_MMA(1, 1, At, B1); PG8_BAR; PG8_SCHED; \
        } } while (0)
    Unit cur, nxt; int ui = 0;
    if (!S.next(0, cur)) return;
    f32x4 acc[2][2][4][2];
    bf16x8 At[4][2], B0[2][2], B1[2][2];
    v8i_t At8[4], B08[2], B18[2];
    const char* cA = g.A + cur.aoff; const char* cB = g.Bt + cur.boff;
    PG8_SETA(cur);
    if (GATHER) PG8_WAIT_L(0);
    PG8_STAGE_B(PG8_SB(0, 0), cB); PG8_STAGE_B(PG8_SB(0, 1), cB + hstepB); PG8_STAGE_A(PG8_SA(0, 0), cA, 0); PG8_STAGE_A(PG8_SA(0, 1), cA, 1);
    if (PG8_WR_NOW() == 1) PG8_BAR;
    PG8_WAIT_V(2); PG8_BAR;
    PG8_STAGE_B(PG8_SB(1, 0), cB + kstep); PG8_STAGE_A(PG8_SA(1, 0), cA + kstep, 0); PG8_STAGE_B(PG8_SB(1, 1), cB + hstepB + kstep);
    PG8_WAIT_V(6); PG8_BAR;
#pragma unroll
    for (int a = 0; a < 2; ++a)
#pragma unroll
        for (int b = 0; b < 2; ++b)
#pragma unroll
            for (int m = 0; m < 4; ++m)
#pragma unroll
                for (int n = 0; n < 2; ++n) acc[a][b][m][n] = (f32x4){0.f, 0.f, 0.f, 0.f};
    const int aoff = lds_byte(wr * 64 + fr, fq * 8), boff = lds_byte(wc * 32 + fr, fq * 8);
#define PG8_UNIT(F8V_, NTV_) { \
        const bool has_next = S.next(ui + 1, nxt); \
        const char* nA = has_next ? g.A + nxt.aoff : cA; const char* nB = has_next ? g.Bt + nxt.boff : cB; \
        PG8_KLOOP(F8V_, NTV_); \
        if constexpr (ALIGN_EPI) { if (PG8_WR_NOW() == 0) PG8_BAR; } \
        const int le_ = lane_id(); \
        const bool keep = E(acc, cur, wr, wc, le_ & 15, le_ >> 4); \
        if (!has_next) break; \
        if (!keep) { \
            _Pragma("unroll") for (int a = 0; a < 2; ++a) _Pragma("unroll") for (int b = 0; b < 2; ++b) _Pragma("unroll") for (int m = 0; m < 4; ++m) _Pragma("unroll") for (int n = 0; n < 2; ++n) acc[a][b][m][n] = (f32x4){0.f, 0.f, 0.f, 0.f}; \
        } \
        cur = nxt; cA = nA; cB = nB; ++ui; \
        if constexpr (ALIGN_EPI) { if (PG8_WR_NOW() == 1) PG8_BAR; } }
    for (;;) {
        if constexpr (MIXED) { PG8_UNIT(false, 2 * nt) PG8_UNIT(true, nt) PG8_UNIT(true, nt) }
        else { PG8_UNIT(FP8, nt) }
    }
#undef PG8_UNIT
    PG8_WAIT_V(0);
    if constexpr (!ALIGN_EPI) { if (PG8_WR_NOW() == 0) PG8_BAR; }
    PG8_BAR;
#undef PG8_SETA
#undef PG8_SA
#undef PG8_SB
#undef PG8_STAGE_A
#undef PG8_STAGE_B
#undef PG8_LDA
#undef PG8_LDB
#undef PG8_MMA
#undef PG8_WAIT_V
#undef PG8_WR_NOW
#undef PG8_WAIT_L
#undef PG8_BAR
#undef PG8_SCHED
}
}

__device__ __forceinline__ int g64_col(int wc, int bj, int fq) { return 64 * wc + 32 * bj + 8 * fq; }
__host__ __device__ __forceinline__ int map_g64(int L) { const int l = L & 255; return (L & ~255) + 128 * ((l & 63) >> 5) + 32 * (l >> 6) + (l & 31); }
__host__ __device__ __forceinline__ int map_up(int n) { const int half = n >> 9, c = n & 511; return 256 * (c >> 7) + 128 * half + (c & 127); }

struct Frame {
    LAS unsigned char* lds;
    int wave, vcu, G;
    unsigned char* ws;
};

template <int MAP>
__device__ __forceinline__ int p0_rowmap(int Lbase, int n) {
    if (MAP == 0) return n;
    if (MAP == 2) return map_up(n);
    int L = Lbase + n;
    if (MAP == 3 && L >= 512) { const int a = L & 127; L = (L & ~127) + (a & 3) * 32 + (a >> 2); }
    return map_g64(L);
}
template <int MAP>
__device__ __forceinline__ void p0_transpose_item(const float* W, int ldw, int ncols, int K, bf16* WT, int Lbase, LAS float* scr, int item, int lane) {
    const int nblk = ncols / 32, kb = item / nblk, nb = item % nblk, k0 = 64 * kb, n0 = 32 * nb;
    const float* wp = W + (size_t)(k0 + (lane >> 5)) * ldw + n0 + (lane & 31);
#pragma unroll
    for (int hb = 0; hb < 2; ++hb) {
        float v[16];
#pragma unroll
        for (int i = 0; i < 16; ++i) v[i] = __builtin_nontemporal_load(wp + (size_t)(2 * (16 * hb + i)) * ldw);
        __builtin_amdgcn_sched_barrier(0);
#pragma unroll
        for (int i = 0; i < 16; ++i) scr[(2 * (16 * hb + i) + (lane >> 5)) * 33 + (lane & 31)] = v[i];
        __builtin_amdgcn_sched_barrier(0);
    }
    LDS_WAIT(); asm volatile("" ::: "memory");
    const int c = lane & 7;
#pragma unroll
    for (int j = 0; j < 4; ++j) { const int n = (lane >> 3) + 8 * j; const LAS float* s = scr + (8 * c) * 33 + n;
        u32x4 o; o.x = cvt_pk_bf16(s[0 * 33], s[1 * 33]); o.y = cvt_pk_bf16(s[2 * 33], s[3 * 33]); o.z = cvt_pk_bf16(s[4 * 33], s[5 * 33]); o.w = cvt_pk_bf16(s[6 * 33], s[7 * 33]);
        *(u32x4*)(WT + (size_t)p0_rowmap<MAP>(Lbase, n0 + n) * K + k0 + 8 * c) = o; }
    LDS_WAIT(); asm volatile("" ::: "memory");
}

template <int MAP>
__device__ __forceinline__ void p0_transpose_item8(const float* W, int ldw, int ncols, int K, unsigned char* WT8, int Lbase, float scale, LAS float* scr, int item, int lane) {
    const int nblk = ncols / 32, kb = item / nblk, nb = item % nblk, k0 = 64 * kb, n0 = 32 * nb;
    const float* wp = W + (size_t)(k0 + (lane >> 5)) * ldw + n0 + (lane & 31);
#pragma unroll
    for (int hb = 0; hb < 2; ++hb) {
        float v[16];
#pragma unroll
        for (int i = 0; i < 16; ++i) v[i] = __builtin_nontemporal_load(wp + (size_t)(2 * (16 * hb + i)) * ldw);
        __builtin_amdgcn_sched_barrier(0);
#pragma unroll
        for (int i = 0; i < 16; ++i) scr[(2 * (16 * hb + i) + (lane >> 5)) * 33 + (lane & 31)] = v[i] * scale;
        __builtin_amdgcn_sched_barrier(0);
    }
    LDS_WAIT(); asm volatile("" ::: "memory");
    const int c = lane & 3;
#pragma unroll
    for (int j = 0; j < 2; ++j) { const int n = (lane >> 2) + 16 * j; const LAS float* s = scr + (16 * c) * 33 + n;
        u32x4 o; o.x = cvt4_fp8(s[0 * 33], s[1 * 33], s[2 * 33], s[3 * 33]); o.y = cvt4_fp8(s[4 * 33], s[5 * 33], s[6 * 33], s[7 * 33]);
        o.z = cvt4_fp8(s[8 * 33], s[9 * 33], s[10 * 33], s[11 * 33]); o.w = cvt4_fp8(s[12 * 33], s[13 * 33], s[14 * 33], s[15 * 33]);
        *(u32x4*)(WT8 + (size_t)p0_rowmap<MAP>(Lbase, n0 + n) * K + k0 + 16 * c) = o; }
    LDS_WAIT(); asm volatile("" ::: "memory");
}

__device__ __forceinline__ void phase0(Frame& F, const Params& P) {
    const float* x = P.in[0]; const float* mem = P.in[1]; const int* pos = (const int*)P.in[2];
    const float* g_attn = P.in[3]; const float* w_in = P.in[4]; const float* fbias = P.in[11]; const float* g_mem = P.in[12];
    unsigned char* ws = F.ws;
    bf16* H = (bf16*)P.out;
    unsigned char* H8 = (unsigned char*)P.out + 128 * MiB;
    const int tid0 = F.wave * 64 + lane_id();
    const int lane = tid0 & 63, wave = F.wave;
    const int gw_ = F.vcu * 8 + wave, NGW = F.G * 8;
    {
        unsigned char* MEMN = ws + WS_MEMN;
        for (int m = gw_; m < NB * MEML; m += NGW) {
            const f32x4* xr = (const f32x4*)(mem + (size_t)m * DM) + lane; f32x4 v[4]; float ss = 0.f;
#pragma unroll
            for (int j = 0; j < 4; ++j) { v[j] = xr[64 * j]; ss += (v[j][0] * v[j][0] + v[j][1] * v[j][1]) + (v[j][2] * v[j][2] + v[j][3] * v[j][3]); }
            const float rstd = 1.0f / sqrtf(wave_sum(ss) * (1.f / DM) + EPS);
            unsigned* o4 = (unsigned*)(MEMN + (size_t)m * DM) + lane;
#pragma unroll
            for (int j = 0; j < 4; ++j) { const f32x4 hn = v[j] * rstd * *(const f32x4*)(g_mem + 256 * j + 4 * lane);
                o4[64 * j] = cvt4_fp8(hn[0], hn[1], hn[2], hn[3]); }
        }
    }
    if (blockIdx.x == 0 && wave == 0) {
        bool ok = true; for (int k = lane; k < DM; k += 64) ok = ok && (fabsf(g_attn[k]) >= 1e-3f);
        const int all_ok = __all(ok) ? 1 : 0; if (lane == 0) *(int*)(ws + WS_XFLAG) = all_ok;
    }
    {
        bf16* WR = (bf16*)(ws + WS_WR); const float* wrg = P.in[21]; const float* wre = P.in[23]; const float* gffn = P.in[20];
        const int gt = (blockIdx.x * 512 + tid0), NT_ = F.G * 512;
        for (int e = gt; e < 64 * 1024; e += NT_) { const int n = e >> 10, k = e & 1023;
            const float v = (n < 4 ? wrg[k * 4 + n] : (n < 36 ? wre[k * 32 + (n - 4)] : 0.f)) * gffn[k];
            WR[e] = (bf16)(cvt_pk_bf16(v, 0.f) & 0xffffu); }
    }
    {
        LAS float* scr = (LAS float*)(F.lds + 8192 + wave * 12288);
        constexpr int I_IN1 = 16 * 48, I_IN2 = 16 * 16, I_IN4 = 16 * 32, I_ING = 16 * 96, I_MKV = 16 * 32, I_WO = 8 * 32, I_WOUT = 16 * 32, I_UP = 16 * 32, I_DN = 8 * 32;
        constexpr int NITEMS = I_IN1 + I_IN4 + 2 * I_IN2 + I_ING + I_MKV + 3 * I_WO + I_WOUT + NEXP * I_UP + NEXP * I_DN;
        for (int it = gw_; it < NITEMS; it += NGW) {
            int r = it;
            if (r < I_IN1) { p0_transpose_item<1>(w_in, IN_COLS, 1536, DM, (bf16*)(ws + WS_WIN), 0, scr, r, lane); continue; } r -= I_IN1;
            if (r < I_IN4) { p0_transpose_item8<1>(w_in + 1536, IN_COLS, 1024, DM, ws + WS_WQK8, 0, 32.f, scr, r, lane); continue; } r -= I_IN4;
            if (r < I_IN2) { p0_transpose_item8<1>(w_in + 2560, IN_COLS, 512, DM, ws + WS_W8, 0, 32.f, scr, r, lane); continue; } r -= I_IN2;
            if (r < I_IN2) { p0_transpose_item8<1>(w_in + 3080, IN_COLS, 512, DM, ws + WS_W8, 512, 32.f, scr, r, lane); continue; } r -= I_IN2;
            if (r < I_ING) { p0_transpose_item8<1>(w_in + 3592, IN_COLS, 3072, DM, ws + WS_W8, 1024, 32.f, scr, r, lane); continue; } r -= I_ING;
            if (r < I_MKV) { p0_transpose_item8<3>(P.in[13], 1024, 1024, DM, ws + WS_WMKV, 0, 32.f, scr, r, lane); continue; } r -= I_MKV;
            if (r < I_WO) { p0_transpose_item<1>(P.in[16], 1024, 1024, 512, (bf16*)(ws + WS_WO), 0, scr, r, lane); continue; } r -= I_WO;
            if (r < 2 * I_WO) { const int w = r / I_WO; p0_transpose_item8<1>(P.in[17 + w], 1024, 1024, 1024, ws + WS_WO + MiB + (size_t)w * 1024 * 1024, 0, 16.f, scr, r % I_WO, lane); continue; } r -= 2 * I_WO;
            if (r < I_WOUT) { p0_transpose_item<0>(P.in[19], 1024, 1024, DM, (bf16*)(ws + WS_WOUT), 0, scr, r, lane); continue; } r -= I_WOUT;
            if (r < NEXP * I_UP) { const int e = r / I_UP; p0_transpose_item8<2>(P.in[25] + (size_t)e * 1024 * 1024, 1024, 1024, DM, ws + WS_WUP + (size_t)e * 1024 * 1024, 0, 32.f, scr, r % I_UP, lane); continue; } r -= NEXP * I_UP;
            { const int e = r / I_DN; p0_transpose_item8<0>(P.in[26] + (size_t)e * 512 * 1024, 1024, 1024, 512, ws + WS_WDN + (size_t)e * 1024 * 512, 0, 16.f, scr, r % I_DN, lane); }
        }
    }
    __syncthreads();
    {
        float gw[4][4][8];
#pragma unroll
        for (int j = 0; j < 4; ++j)
#pragma unroll
            for (int e = 0; e < 4; ++e) { const int k = 256 * j + 4 * lane + e; const float gk = g_attn[k];
                const f32x4 w0 = *(const f32x4*)(w_in + (size_t)k * IN_COLS + 3072), w1 = *(const f32x4*)(w_in + (size_t)k * IN_COLS + 3076);
                gw[j][e][0] = gk * w0[0]; gw[j][e][1] = gk * w0[1]; gw[j][e][2] = gk * w0[2]; gw[j][e][3] = gk * w0[3];
                gw[j][e][4] = gk * w1[0]; gw[j][e][5] = gk * w1[1]; gw[j][e][6] = gk * w1[2]; gw[j][e][7] = gk * w1[3]; }
        f32x4 gv[4];
#pragma unroll
        for (int j = 0; j < 4; ++j) gv[j] = *(const f32x4*)(g_attn + 256 * j + 4 * lane);
        const float fb = fbias[lane & 7];
        LAS float* lf = (LAS float*)(F.lds);
        float* CUM = (float*)(ws + WS_CUM); float* CHTOT = (float*)(ws + WS_CHTOT);
        for (int ch = blockIdx.x; ch < T / 256; ch += F.G) {
            f32x4 vn[4];
            { const f32x4* xr0 = (const f32x4*)(x + (size_t)(ch * 256 + wave * 32) * DM) + lane;
#pragma unroll
              for (int j = 0; j < 4; ++j) vn[j] = __builtin_nontemporal_load(xr0 + 64 * j); }
            for (int rr = 0; rr < 32; ++rr) {
                const int row = ch * 256 + wave * 32 + rr;
                f32x4 v[4]; float ss = 0.f;
#pragma unroll
                for (int j = 0; j < 4; ++j) v[j] = vn[j];
                if (rr + 1 < 32) { const f32x4* xr1 = (const f32x4*)(x + (size_t)(row + 1) * DM) + lane;
#pragma unroll
                    for (int j = 0; j < 4; ++j) vn[j] = __builtin_nontemporal_load(xr1 + 64 * j); }
#pragma unroll
                for (int j = 0; j < 4; ++j) ss += (v[j][0] * v[j][0] + v[j][1] * v[j][1]) + (v[j][2] * v[j][2] + v[j][3] * v[j][3]);
                const float rms_ = sqrtf(wave_sum(ss) * (1.f / DM) + EPS); const float rstd = 1.0f / rms_;
                if (lane == 0) ((float*)(ws + WS_RINVA))[row] = rms_;
                float f[8];
#pragma unroll
                for (int h = 0; h < 8; ++h) f[h] = 0.f;
                unsigned long long* o8 = (unsigned long long*)(H + (size_t)row * DM) + lane;
#pragma unroll
                for (int j = 0; j < 4; ++j) {
#pragma unroll
                    for (int e = 0; e < 4; ++e) {
#pragma unroll
                        for (int h = 0; h < 8; ++h) f[h] += v[j][e] * gw[j][e][h]; }
                    const f32x4 hn = v[j] * rstd * gv[j];
                    o8[64 * j] = (unsigned long long)cvt_pk_bf16(hn[0], hn[1]) | ((unsigned long long)cvt_pk_bf16(hn[2], hn[3]) << 32);
                    ((unsigned*)(H8 + (size_t)row * DM))[64 * j + lane] = cvt4_fp8(hn[0], hn[1], hn[2], hn[3]);
                }
                float mine = 0.f;
#pragma unroll
                for (int h = 0; h < 8; ++h) { const float s = wave_sum(f[h]); if ((lane & 7) == h) mine = s; }
                if (lane < 8) { const float z = mine * rstd + fb; lf[(wave * 32 + rr) * 8 + lane] = -log1pf(__expf(-z)); }
            }
            __syncthreads();
            if (wave == 0) {
                const int seg = lane >> 3, h = lane & 7; float a = 0.f;
                for (int i = 0; i < 32; ++i) { a += lf[(seg * 32 + i) * 8 + h]; lf[(seg * 32 + i) * 8 + h] = a; }
                float incl = a, t;
                t = __shfl_up(incl, 8); if (seg >= 1) incl += t;
                t = __shfl_up(incl, 16); if (seg >= 2) incl += t;
                t = __shfl_up(incl, 32); if (seg >= 4) incl += t;
                const float excl = incl - a;
                const int b = ch >> 4, s0 = (ch & 15) * 256;
                float* dst = CUM + ((size_t)(b * 8 + h) * SEQ + s0 + seg * 32);
                for (int i = 0; i < 32; ++i) dst[i] = lf[(seg * 32 + i) * 8 + h] + excl;
                if (seg == 7) CHTOT[ch * 8 + h] = incl;
            }
            __syncthreads();
        }
    }
}

struct GridOrder {
    int nM, nN, nwg, G, c; long astep, bstep;
    __device__ void init(int nM_, int nN_, int G_, int c_, long astep_, long bstep_) { nM = nM_; nN = nN_; nwg = nM * nN; G = G_; c = c_; astep = astep_; bstep = bstep_; }
    __device__ bool next(int i, pg8::Unit& u) const {
        const long L = (long)i * G + c; if (L >= nwg) return false;
        int wgid = (int)L; { const int q = nwg / 8, r = nwg % 8, xcd = wgid % 8, off = wgid / 8; wgid = (xcd < r ? xcd * (q + 1) : r * (q + 1) + (xcd - r) * q) + off; }
        const int nig = 8 * nN, gid = wgid / nig, fm = gid * 8, gsz = (nM - fm) < 8 ? (nM - fm) : 8;
        u.pm = fm + ((wgid % nig) % gsz); u.pn = (wgid % nig) / gsz; u.aoff = (long)u.pm * astep; u.boff = (long)u.pn * bstep; u.gofs = 0; u.sub = 0; return true;
    }
};

template <int F8P>
struct EpiProjT {
    static constexpr bool PERM = true;
    bf16* QB; bf16* KVB; bf16* GT; const float* rope; const float* g_dq; const float* g_dk; const float* g_fq; const float* g_fk; int fp8part_unused; const int* pos; unsigned char* Y8;
    __device__ __forceinline__ bool operator()(f32x4 (&acc)[2][2][4][2], const pg8::Unit& u, int wr, int wc, int fr_in, int fq_in) const {
        int fr = fr_in, fq = fq_in; asm volatile("" : "+v"(fr), "+v"(fq));
        const int pn = F8P ? u.pn + 10 : u.pn;
        int kind; const float* gptr = g_dq; bf16* base; int pitch, colt; float qs = 1.f; float ps = 1.f;
        if constexpr (F8P == 0) {
            if (pn < 2)       { kind = 0; gptr = g_dq; base = QB;  pitch = QP;  colt = pn * 256;               qs = 0.125f * LOG2E; }
            else if (pn < 4)  { kind = 0; gptr = g_dk; base = KVB; pitch = KVP; colt = (pn - 2) * 256; }
            else              { kind = 2;         base = KVB; pitch = KVP; colt = 512 + (pn - 4) * 256; }
        } else {
            if (pn < 12)      { kind = 2;         base = KVB; pitch = KVP; colt = 1536 + (pn - 10) * 256; ps = 1.f / 32.f; }
            else if (pn < 14) { kind = 4;         base = QB;  pitch = QP;  colt = 512 + (pn - 12) * 256; }
            else              { kind = 3;         base = GT;  pitch = GP;  colt = (pn - 14) * 256; }
        }
        const int row0 = u.pm * 256 + wr * 64 + fr;
        f32x4 gn[2][2];
        if (F8P == 0 && kind < 2) {
#pragma unroll
            for (int bj = 0; bj < 2; ++bj)
#pragma unroll
                for (int n = 0; n < 2; ++n) gn[bj][n] = *(const f32x4*)(gptr + 32 * bj + 8 * fq + 4 * n);
        }
        float pp[2][4];
        if (F8P == 0 && kind == 0) {
#pragma unroll
            for (int ai = 0; ai < 2; ++ai)
#pragma unroll
                for (int m = 0; m < 4; ++m) pp[ai][m] = (float)pos[row0 + ai * 128 + m * 16];
        }
#pragma unroll
        for (int am = 0; am < 4; ++am) { const int ai = am >> 1, m0 = (am & 1) * 2;
            f32x4 rc[4][2], rsn[4][2];
            if (F8P == 0 && kind == 0) {
                constexpr float IR[8] = {0.15915494309189535f, 0.03086376340470123f, 0.005985185712713705f, 0.001160663641240061f, 0.00022507907903927653f, 4.364795279280289e-05f, 8.464330808241401e-06f, 1.6414262627950345e-06f};
#pragma unroll
                for (int m = m0; m < m0 + 2; ++m)
#pragma unroll
                    for (int n = 0; n < 2; ++n)
#pragma unroll
                        for (int j = 0; j < 4; ++j) { const float rf = __builtin_amdgcn_fractf(pp[ai][m] * IR[4 * n + j]); rc[m][n][j] = __builtin_amdgcn_cosf(rf); rsn[m][n][j] = __builtin_amdgcn_sinf(rf); }
            }
#pragma unroll
            for (int m = m0; m < m0 + 2; ++m) {
                const int row = row0 + ai * 128 + m * 16;
                f32x4 v[2][2];
#pragma unroll
                for (int bj = 0; bj < 2; ++bj)
#pragma unroll
                    for (int n = 0; n < 2; ++n) v[bj][n] = acc[ai][bj][m][n];
                if (F8P == 0 && kind < 2) {
                    float ss = 0.f;
#pragma unroll
                    for (int bj = 0; bj < 2; ++bj)
#pragma unroll
                        for (int n = 0; n < 2; ++n) ss += (v[bj][n][0] * v[bj][n][0] + v[bj][n][1] * v[bj][n][1]) + (v[bj][n][2] * v[bj][n][2] + v[bj][n][3] * v[bj][n][3]);
                    ss += __shfl_xor(ss, 16); ss += __shfl_xor(ss, 32);
                    const float r = qs / sqrtf(ss * (1.f / 64.f) + EPS);
#pragma unroll
                    for (int bj = 0; bj < 2; ++bj)
#pragma unroll
                        for (int n = 0; n < 2; ++n) v[bj][n] = v[bj][n] * gn[bj][n] * r;
                    if (kind == 0) {
#pragma unroll
                        for (int n = 0; n < 2; ++n) {
                            const f32x4 c = rc[m][n], s = rsn[m][n];
                            f32x4 o;
#pragma unroll
                            for (int j = 0; j < 4; ++j) { const float mine = v[0][n][j], oth = __shfl_xor(mine, 16);
                                o[j] = fq == 0 ? mine * c[j] - oth * s[j] : (fq == 1 ? mine * c[j] + oth * s[j] : mine); }
                            v[0][n] = o;
                        }
                    }
                } else if (F8P == 1 && kind == 3) {
                    const int t16 = ((wr * 4 + wc) * 64 + lane_id()) * 16;
                    u32x4 w;
#pragma unroll
                    for (int bj = 0; bj < 2; ++bj)
#pragma unroll
                        for (int n = 0; n < 2; ++n) { unsigned pk = 0;
#pragma unroll
                            for (int j = 0; j < 4; ++j) { const float sg = __builtin_amdgcn_rcpf(1.f + __expf(v[bj][n][j] * (-1.f / 32.f))); unsigned q = (unsigned)(sg * 255.f + 0.5f); q = q < 1u ? 1u : q; pk |= q << (8 * j); }
                            w[bj * 2 + n] = pk; }
                    *(u32x4*)((unsigned char*)GT + ((size_t)(u.pm * 12 + (pn - 14)) * 8 + (ai * 4 + m)) * 8192 + (unsigned)t16) = w;
                    continue;
                }
                if (F8P == 1 && kind == 4) {
                    unsigned char* rp8 = Y8 + (size_t)row * 1024 + colt + g64_col(wc, 0, fq);
#pragma unroll
                    for (int bj = 0; bj < 2; ++bj) { u32x2 w8; w8.x = cvt4_fp8(v[bj][0][0] * 0.5f, v[bj][0][1] * 0.5f, v[bj][0][2] * 0.5f, v[bj][0][3] * 0.5f); w8.y = cvt4_fp8(v[bj][1][0] * 0.5f, v[bj][1][1] * 0.5f, v[bj][1][2] * 0.5f, v[bj][1][3] * 0.5f);
                        *(u32x2*)(rp8 + 32 * bj) = w8; }
                    continue;
                }
                if (kind == 2) {
#pragma unroll
                    for (int bj = 0; bj < 2; ++bj)
#pragma unroll
                        for (int n = 0; n < 2; ++n) v[bj][n] = v[bj][n] * ps; }
                bf16* rp = base + (size_t)row * pitch + colt + g64_col(wc, 0, fq);
#pragma unroll
                for (int bj = 0; bj < 2; ++bj) { u32x4 w; w.x = cvt_pk_bf16(v[bj][0][0], v[bj][0][1]); w.y = cvt_pk_bf16(v[bj][0][2], v[bj][0][3]); w.z = cvt_pk_bf16(v[bj][1][0], v[bj][1][1]); w.w = cvt_pk_bf16(v[bj][1][2], v[bj][1][3]);
                    *(u32x4*)(rp + 32 * bj) = w; }
            }
        }
        return false;
    }
};

struct EpiNorm {
    static constexpr bool PERM = true;
    bf16* QB; bf16* KVB; const float* g_fq; const float* g_fk;
    __device__ __forceinline__ bool operator()(f32x4 (&acc)[2][2][4][2], const pg8::Unit& u, int wr, int wc, int fr_in, int fq_in) const {
        int fr = fr_in, fq = fq_in; asm volatile("" : "+v"(fr), "+v"(fq));
        const bool isq = u.pn < 2;
        bf16* base = isq ? QB : KVB; const int pitch = isq ? QP : KVP; const int colt = isq ? 512 + u.pn * 256 : 1024 + (u.pn - 2) * 256;
        const float qs = isq ? 0.125f * LOG2E : 1.f; const float* gptr = isq ? g_fq : g_fk;
        const int row0 = u.pm * 256 + wr * 64 + fr;
        f32x4 gg[2][2];
#pragma unroll
        for (int bj = 0; bj < 2; ++bj) { gg[bj][0] = *(const f32x4*)(gptr + 32 * bj + 8 * fq); gg[bj][1] = *(const f32x4*)(gptr + 32 * bj + 8 * fq + 4); }
#pragma unroll
        for (int ai = 0; ai < 2; ++ai)
#pragma unroll
            for (int m = 0; m < 4; ++m) {
                const int row = row0 + ai * 128 + m * 16; float ss = 0.f;
#pragma unroll
                for (int bj = 0; bj < 2; ++bj)
#pragma unroll
                    for (int n = 0; n < 2; ++n) { const f32x4 v = acc[ai][bj][m][n]; ss += (v[0] * v[0] + v[1] * v[1]) + (v[2] * v[2] + v[3] * v[3]); }
                ss += __shfl_xor(ss, 16); ss += __shfl_xor(ss, 32);
                const float r = qs / sqrtf(ss * (1.f / 64.f) + EPS * 1024.f);
                bf16* rp = base + (size_t)row * pitch + colt + g64_col(wc, 0, fq);
#pragma unroll
                for (int bj = 0; bj < 2; ++bj) { const f32x4 g0 = gg[bj][0], g1 = gg[bj][1];
                    const f32x4 v0 = acc[ai][bj][m][0] * g0 * r, v1 = acc[ai][bj][m][1] * g1 * r;
                    u32x4 w; w.x = cvt_pk_bf16(v0[0], v0[1]); w.y = cvt_pk_bf16(v0[2], v0[3]); w.z = cvt_pk_bf16(v1[0], v1[1]); w.w = cvt_pk_bf16(v1[2], v1[3]);
                    *(u32x4*)(rp + 32 * bj) = w; }
            }
        return false;
    }
};

struct EpiGates {
    static constexpr bool PERM = true;
    unsigned char* GT;
    __device__ __forceinline__ bool operator()(f32x4 (&acc)[2][2][4][2], const pg8::Unit& u, int wr, int wc, int fr, int fq) const {
        const int t16 = ((wr * 4 + wc) * 64 + lane_id()) * 16;
#pragma unroll
        for (int ai = 0; ai < 2; ++ai)
#pragma unroll
            for (int m = 0; m < 4; ++m) { u32x4 w;
#pragma unroll
                for (int bj = 0; bj < 2; ++bj)
#pragma unroll
                    for (int n = 0; n < 2; ++n) { unsigned pk = 0;
#pragma unroll
                        for (int j = 0; j < 4; ++j) { const float sg = __builtin_amdgcn_rcpf(1.f + __expf(acc[ai][bj][m][n][j] * (-1.f / 32.f))); unsigned q = (unsigned)(sg * 255.f + 0.5f); q = q < 1u ? 1u : q; pk |= q << (8 * j); }
                        w[bj * 2 + n] = pk; }
                *(u32x4*)(GT + ((size_t)(u.pm * 12 + u.pn) * 8 + (ai * 4 + m)) * 8192 + (unsigned)t16) = w; }
        return false;
    }
};

struct EpiPlain {
    static constexpr bool PERM = true;
    bf16* O; int pitch; float sc;
    __device__ __forceinline__ bool operator()(f32x4 (&acc)[2][2][4][2], const pg8::Unit& u, int wr, int wc, int fr, int fq) const {
        const int row0 = u.pm * 256 + wr * 64 + fr;
#pragma unroll
        for (int ai = 0; ai < 2; ++ai)
#pragma unroll
            for (int m = 0; m < 4; ++m) { bf16* rp = O + (size_t)(row0 + ai * 128 + m * 16) * pitch + u.pn * 256 + g64_col(wc, 0, fq);
#pragma unroll
                for (int bj = 0; bj < 2; ++bj) { const f32x4 v0 = acc[ai][bj][m][0] * sc, v1 = acc[ai][bj][m][1] * sc; u32x4 w; w.x = cvt_pk_bf16(v0[0], v0[1]); w.y = cvt_pk_bf16(v0[2], v0[3]); w.z = cvt_pk_bf16(v1[0], v1[1]); w.w = cvt_pk_bf16(v1[2], v1[3]);
                    *(u32x4*)(rp + 32 * bj) = w; } }
        return false;
    }
};

struct EpiPlain8 {
    static constexpr bool PERM = true;
    bf16* O; int pitch;
    __device__ __forceinline__ bool operator()(f32x4 (&acc)[2][2][4][2], const pg8::Unit& u, int wr, int wc, int fr, int fq) const {
        const int row0 = u.pm * 256 + wr * 64 + fr;
#pragma unroll
        for (int ai = 0; ai < 2; ++ai)
#pragma unroll
            for (int m = 0; m < 4; ++m) { bf16* rp = O + (size_t)(row0 + ai * 128 + m * 16) * pitch + (u.pn & 7) * 256 + g64_col(wc, 0, fq);
#pragma unroll
                for (int bj = 0; bj < 2; ++bj) { const f32x4 v0 = acc[ai][bj][m][0], v1 = acc[ai][bj][m][1]; u32x4 w; w.x = cvt_pk_bf16(v0[0], v0[1]); w.y = cvt_pk_bf16(v0[2], v0[3]); w.z = cvt_pk_bf16(v1[0], v1[1]); w.w = cvt_pk_bf16(v1[2], v1[3]);
                    *(u32x4*)(rp + 32 * bj) = w; } }
        return false;
    }
};
__device__ __forceinline__ void phase1(Frame& F, const Params& P) {
    unsigned char* ws = F.ws;
    {
        pg8::Gemm g{(const char*)P.out, (const char*)(ws + WS_WIN), DM * 2, DM * 2, DM / 64, nullptr};
        GridOrder S; S.init(T / 256, N1 / 256, F.G, (int)blockIdx.x, 256L * DM * 2, 256L * DM * 2);
#ifdef EXP_P1PLAIN
#ifdef EXP_P1SAME
        if (P.dummy) { EpiPlain8 E{(bf16*)(ws + WS_KVBUF), 2048}; S.astep = 0; S.bstep = 0; pg8::gemm_phase<EpiPlain8, GridOrder, true, false>(F.lds, g, S, E, F.wave); return; }
#endif
        if (P.dummy) { EpiPlain8 E{(bf16*)(ws + WS_KVBUF), 2048}; pg8::gemm_phase<EpiPlain8, GridOrder, true, false>(F.lds, g, S, E, F.wave); return; }
#endif
        EpiProjT<0> E{(bf16*)(ws + WS_QBUF), (bf16*)(ws + WS_KVBUF), (bf16*)(ws + WS_GATES), (const float*)(ws + WS_ROPE), P.in[5], P.in[6], P.in[9], P.in[10], 0, (const int*)P.in[2], ws + WS_Y8};
        pg8::gemm_phase<EpiProjT<0>, GridOrder, true, false>(F.lds, g, S, E, F.wave);
    }
    {
        pg8::Gemm g{(const char*)P.out + 128 * MiB, (const char*)(ws + WS_WQK8), DM, DM, DM / 128, nullptr};
        GridOrder S; S.init(T / 256, 4, F.G, (int)blockIdx.x, 256L * DM, 256L * DM);
        EpiNorm E{(bf16*)(ws + WS_QBUF), (bf16*)(ws + WS_KVBUF), P.in[9], P.in[10]};
        pg8::gemm_phase<EpiNorm, GridOrder, true, false, true>(F.lds, g, S, E, F.wave);
    }
    {
        pg8::Gemm g{(const char*)P.out + 128 * MiB, (const char*)(ws + WS_W8), DM, DM, DM / 128, nullptr};
        GridOrder S; S.init(T / 256, 16, F.G, (int)blockIdx.x, 256L * DM, 256L * DM);
        EpiProjT<1> E{(bf16*)(ws + WS_QBUF), (bf16*)(ws + WS_KVBUF), (bf16*)(ws + WS_GATES), (const float*)(ws + WS_ROPE), P.in[5], P.in[6], P.in[9], P.in[10], 1, (const int*)P.in[2], ws + WS_Y8};
        pg8::gemm_phase<EpiProjT<1>, GridOrder, true, false, true>(F.lds, g, S, E, F.wave);
    }
    {
        pg8::Gemm g{(const char*)(ws + WS_MEMN), (const char*)(ws + WS_WMKV), DM, DM, DM / 128, nullptr};
        GridOrder S; S.init(NB * MEML / 256, 4, F.G, (int)blockIdx.x, 256L * DM, 256L * DM);
        EpiPlain E{(bf16*)(ws + WS_MEMKV), DM, 1.f / 32.f};
        pg8::gemm_phase<EpiPlain, GridOrder, true, false, true>(F.lds, g, S, E, F.wave);
    }
}

__device__ __forceinline__ void ta_zero16(f32x16& x) {
#pragma unroll
    for (int r = 0; r < 16; ++r) { float z; asm volatile("v_mov_b32 %0, 0" : "=v"(z)); x[r] = z; }
}
namespace sa {
__device__ __forceinline__ int crow(int r, int hi) { return (r & 3) + 8 * (r >> 2) + 4 * hi; }
constexpr int L_K = 0, L_V = 32768, L_KEY = 65536, L_WSF = 81920, L_PFX = 81920 + 2048;
typedef short v4i16_t __attribute__((ext_vector_type(4)));
__device__ __forceinline__ s16x4 vtr(const LAS unsigned char* p) { return __builtin_bit_cast(s16x4, __builtin_amdgcn_ds_read_tr16_b64_v4i16((LAS v4i16_t*)p)); }

template <int DQK, int DV, int KEYMODE>
__device__ __forceinline__ void unit(const bf16x8* qr, const bf16* Kg, long kpitch, const bf16* Vg, long vpitch, bf16* Og, long opitch,
                                     int NT, int band0, LAS unsigned char* lds, int wid) {
    const int lane = lane_id(), tid = wid * 64 + lane;
    constexpr int NKL = DQK / 64, NVL = DV / 64, KSLOT = 64 * DQK * 2, VSLOT = 64 * DV * 2, ND = DV / 32, NKS = DQK / 16;
    const int r32 = lane & 31, hi = lane >> 5;
    LAS float* wsf = (LAS float*)(lds + L_WSF) + wid * 64;
    const LAS float* keyarr = (const LAS float*)(lds + L_KEY);
    u32x4 kreg[NKL], vreg[NVL];
    const bf16* ksrc = Kg + (long)lane * kpitch + wid * 8;
    const bf16* vsrc = Vg + (long)(16 * (wid & 3) + (lane >> 2)) * vpitch + (wid >> 2) * 32 + (lane & 3) * 8;
#define SA_LOAD(t) do { _Pragma("unroll") for (int c = 0; c < NKL; ++c) kreg[c] = *(const u32x4*)(ksrc + (long)(t) * 64 * kpitch + c * 64); \
                        _Pragma("unroll") for (int c = 0; c < NVL; ++c) vreg[c] = *(const u32x4*)(vsrc + (long)(t) * 64 * vpitch + c * 64); } while (0)
#define SA_WRITE(s) do { _Pragma("unroll") for (int c = 0; c < NKL; ++c) *(LAS u32x4*)(lds + L_K + (s) * KSLOT + (wid + 8 * c) * 1024 + lane * 16) = kreg[c]; \
                         _Pragma("unroll") for (int c = 0; c < NVL; ++c) *(LAS u32x4*)(lds + L_V + (s) * VSLOT + ((wid >> 2) + 2 * c) * 4096 + (wid & 3) * 1024 + lane * 16) = vreg[c]; } while (0)
    float m_run = -INFINITY, l_run = 0.f;
    f32x16 o[ND];
#pragma unroll
    for (int d = 0; d < ND; ++d) o[d] = f32x16{};
    const int vb0 = ((lane >> 4) & 1) * 32 + (lane & 3) * 8 + (4 * hi + ((lane & 15) >> 2)) * 64;
    SA_LOAD(0); SA_WRITE(0);
    __syncthreads();
    for (int t = 0; t < NT; ++t) {
        const int s = t & 1;
        if (t + 1 < NT) SA_LOAD(t + 1);
        const int jb = t - band0;
        const bool active = (jb < 0) || (64 * jb <= 32 * wid + 31);
        if (active) {
            const LAS unsigned char* kb = lds + L_K + s * KSLOT + hi * 1024 + r32 * 16;
            f32x16 p0 = f32x16{}, p1 = f32x16{};
#pragma unroll
            for (int d0 = 0; d0 < NKS; ++d0) {
                const bf16x8 b0 = *(const LAS bf16x8*)(kb + d0 * 2048), b1 = *(const LAS bf16x8*)(kb + d0 * 2048 + 512);
                p0 = __builtin_amdgcn_mfma_f32_32x32x16_bf16(b0, qr[d0], p0, 0, 0, 0);
                p1 = __builtin_amdgcn_mfma_f32_32x32x16_bf16(b1, qr[d0], p1, 0, 0, 0);
            }
            if (KEYMODE != 0) {
#pragma unroll
                for (int r = 0; r < 16; ++r) { const float k0 = keyarr[64 * t + crow(r, hi)], k1 = keyarr[64 * t + 32 + crow(r, hi)];
                    if (KEYMODE == 1) { p0[r] -= k0; p1[r] -= k1; } else { p0[r] *= k0; p1[r] *= k1; } }
            }
            if (jb >= 0) {
                const int qrel = 32 * wid + r32, kb0 = 64 * jb + 4 * hi;
#pragma unroll
                for (int r = 0; r < 16; ++r) { const int kv = kb0 + (r & 3) + 8 * (r >> 2); if (kv > qrel) p0[r] = -INFINITY; if (kv + 32 > qrel) p1[r] = -INFINITY; }
            }
            float rm = fmaxf(p0[0], p1[0]);
#pragma unroll
            for (int r = 1; r < 16; ++r) rm = fmaxf(rm, fmaxf(p0[r], p1[r]));
            rm = fmaxf(rm, __shfl_xor(rm, 32));
            const float m_new = fmaxf(m_run, rm);
            const float alpha = __builtin_amdgcn_exp2f(m_run - m_new);
            m_run = m_new;
            float rs = 0.f;
#pragma unroll
            for (int r = 0; r < 16; ++r) { p0[r] = __builtin_amdgcn_exp2f(p0[r] - m_new); p1[r] = __builtin_amdgcn_exp2f(p1[r] - m_new); rs += p0[r] + p1[r]; }
            l_run = l_run * alpha + rs;
            if (__any(alpha != 1.f)) {
                if (hi == 0) wsf[r32] = alpha;
                LDS_WAIT();
#pragma unroll
                for (int r = 0; r < 16; ++r) { const float a = wsf[crow(r, hi)];
#pragma unroll
                    for (int d = 0; d < ND; ++d) o[d][r] *= a; }
            }
            u32x4 pw[4];
#pragma unroll
            for (int e = 0; e < 4; ++e) { pw[0][e] = cvt_pk_bf16(p0[2 * e], p0[2 * e + 1]); pw[1][e] = cvt_pk_bf16(p0[8 + 2 * e], p0[9 + 2 * e]);
                                          pw[2][e] = cvt_pk_bf16(p1[2 * e], p1[2 * e + 1]); pw[3][e] = cvt_pk_bf16(p1[8 + 2 * e], p1[9 + 2 * e]); }
            const LAS unsigned char* vb = lds + L_V + s * VSLOT + vb0;
#pragma unroll
            for (int d = 0; d < ND; ++d)
#pragma unroll
                for (int ks = 0; ks < 4; ++ks) {
                    const s16x4 lo = vtr(vb + d * 4096 + ks * 1024), hh = vtr(vb + d * 4096 + ks * 1024 + 512);
                    const bf16x8 vf = (bf16x8){lo[0], lo[1], lo[2], lo[3], hh[0], hh[1], hh[2], hh[3]};
                    o[d] = __builtin_amdgcn_mfma_f32_32x32x16_bf16(__builtin_bit_cast(bf16x8, pw[ks]), vf, o[d], 0, 0, 0);
                }
        }
        if (t + 1 < NT) SA_WRITE(s ^ 1);
        __syncthreads();
    }
    l_run += __shfl_xor(l_run, 32);
    if (hi == 0) wsf[32 + r32] = l_run;
    LDS_WAIT();
    LAS unsigned short* stg = (LAS unsigned short*)(lds + wid * (32 * DV * 2));
#pragma unroll
    for (int r = 0; r < 16; ++r) { const float rl = 1.0f / wsf[32 + crow(r, hi)]; const int orow = crow(r, hi);
#pragma unroll
        for (int d = 0; d < ND; ++d) stg[orow * DV + d * 32 + r32] = (unsigned short)(cvt_pk_bf16(o[d][r] * rl, 0.f) & 0xffffu); }
    LDS_WAIT();
    constexpr int CH = DV / 8;
#pragma unroll
    for (int i = 0; i < 32 * CH / 64; ++i) { const int piece = i * 64 + lane, row = piece / CH, ch = piece % CH;
        const u32x4 v = *(const LAS u32x4*)(stg + row * DV + ch * 8);
        *(u32x4*)(Og + (long)(wid * 32 + row) * opitch + ch * 8) = v; }
    __syncthreads();
#undef SA_LOAD
#undef SA_WRITE
}
constexpr int R_KEY = XOFF, R_WSF = XOFF + 1024, R_GQK = XOFF + 3072;
__device__ __forceinline__ void fill_kv_res(const bf16* Kg, const bf16* Vg, long pitch, LAS unsigned char* lds, int wid, const LAS float* keyarr) {
    const int lane = lane_id();
    const bf16* ksrc = Kg + (long)lane * pitch + wid * 8;
    const bf16* vsrc = Vg + (long)(16 * (wid & 3) + (lane >> 2)) * pitch + (wid >> 2) * 32 + (lane & 3) * 8;
    u32x4 kr[4][2], vr[4][2];
#pragma unroll
    for (int t = 0; t < 4; ++t)
#pragma unroll
        for (int c = 0; c < 2; ++c) { kr[t][c] = *(const u32x4*)(ksrc + (long)t * 64 * pitch + c * 64); vr[t][c] = *(const u32x4*)(vsrc + (long)t * 64 * pitch + c * 64); }
#pragma unroll
    for (int t = 0; t < 4; ++t) { const float sc = keyarr[t * 64 + lane];
#pragma unroll
        for (int c = 0; c < 2; ++c) { u32x4 k = kr[t][c];
#pragma unroll
            for (int e = 0; e < 4; ++e) k[e] = cvt_pk_bf16(__uint_as_float(k[e] << 16) * sc, __uint_as_float(k[e] & 0xffff0000u) * sc);
            *(LAS u32x4*)(lds + t * 16384 + (wid + 8 * c) * 1024 + lane * 16) = k;
            *(LAS u32x4*)(lds + 65536 + t * 16384 + ((wid >> 2) + 2 * c) * 4096 + (wid & 3) * 1024 + lane * 16) = vr[t][c]; } }
}
__device__ __forceinline__ void unit_res(const bf16x8* qr, unsigned char* Og, long opitch, LAS unsigned char* lds, int wid) {
    const int lane = lane_id(), r32 = lane & 31, hi = lane >> 5;
    LAS float* wsf = (LAS float*)(lds + R_WSF) + wid * 64;
    f32x16 p[4][2];
#pragma unroll
    for (int t = 0; t < 4; ++t) {
        const LAS unsigned char* kb = lds + t * 16384 + hi * 1024 + r32 * 16;
        ta_zero16(p[t][0]); ta_zero16(p[t][1]);
#pragma unroll
        for (int d0 = 0; d0 < 8; ++d0) {
            const bf16x8 b0 = *(const LAS bf16x8*)(kb + d0 * 2048), b1 = *(const LAS bf16x8*)(kb + d0 * 2048 + 512);
            p[t][0] = __builtin_amdgcn_mfma_f32_32x32x16_bf16(b0, qr[d0], p[t][0], 0, 0, 0);
            p[t][1] = __builtin_amdgcn_mfma_f32_32x32x16_bf16(b1, qr[d0], p[t][1], 0, 0, 0);
        }
    }
    float rm = fmaxf(p[0][0][0], p[0][1][0]);
#pragma unroll
    for (int t = 0; t < 4; ++t)
#pragma unroll
        for (int r = 0; r < 16; ++r) rm = fmaxf(rm, fmaxf(p[t][0][r], p[t][1][r]));
    rm = fmaxf(rm, __shfl_xor(rm, 32));
    float rs = 0.f;
    u32x4 pw[4][4];
#pragma unroll
    for (int t = 0; t < 4; ++t) {
#pragma unroll
        for (int r = 0; r < 16; ++r) { p[t][0][r] = __builtin_amdgcn_exp2f(p[t][0][r] - rm); p[t][1][r] = __builtin_amdgcn_exp2f(p[t][1][r] - rm); rs += p[t][0][r] + p[t][1][r]; }
#pragma unroll
        for (int e = 0; e < 4; ++e) { pw[t][0][e] = cvt_pk_bf16(p[t][0][2 * e], p[t][0][2 * e + 1]); pw[t][1][e] = cvt_pk_bf16(p[t][0][8 + 2 * e], p[t][0][9 + 2 * e]);
                                      pw[t][2][e] = cvt_pk_bf16(p[t][1][2 * e], p[t][1][2 * e + 1]); pw[t][3][e] = cvt_pk_bf16(p[t][1][8 + 2 * e], p[t][1][9 + 2 * e]); }
    }
    f32x16 o[4];
#pragma unroll
    for (int d = 0; d < 4; ++d) ta_zero16(o[d]);
    const int vb0 = ((lane >> 4) & 1) * 32 + (lane & 3) * 8 + (4 * hi + ((lane & 15) >> 2)) * 64;
#pragma unroll
    for (int t = 0; t < 4; ++t) {
        const LAS unsigned char* vb = lds + 65536 + t * 16384 + vb0;
#pragma unroll
        for (int d = 0; d < 4; ++d)
#pragma unroll
            for (int ks = 0; ks < 4; ++ks) {
                const s16x4 lo = vtr(vb + d * 4096 + ks * 1024), hh = vtr(vb + d * 4096 + ks * 1024 + 512);
                const bf16x8 vf = (bf16x8){lo[0], lo[1], lo[2], lo[3], hh[0], hh[1], hh[2], hh[3]};
                o[d] = __builtin_amdgcn_mfma_f32_32x32x16_bf16(__builtin_bit_cast(bf16x8, pw[t][ks]), vf, o[d], 0, 0, 0);
            }
    }
    rs += __shfl_xor(rs, 32);
    if (hi == 0) wsf[32 + r32] = rs;
    LDS_WAIT();
#pragma unroll
    for (int r = 0; r < 16; ++r) { const float rl = 8.0f / wsf[32 + crow(r, hi)];
        *(unsigned*)(Og + (long)(wid * 32 + crow(r, hi)) * opitch + 4 * r32) = cvt4_fp8(o[0][r] * rl, o[1][r] * rl, o[2][r] * rl, o[3][r] * rl); }
}
}

namespace ta {
constexpr int NW=8,QBLK=32,QB=QBLK*NW,KVBLK=64;
__device__ __forceinline__ void zero16(f32x16&x){
  #pragma unroll
  for(int r=0;r<16;++r){float z;asm volatile("v_mov_b32 %0, 0":"=v"(z));x[r]=z;}
}
__device__ __forceinline__ int crow(int r,int hi){return (r&3)+8*(r>>2)+4*hi;}
#define SBAR() __builtin_amdgcn_sched_barrier(0)
__device__ __forceinline__ void cmask(f32x16&p0,f32x16&p1,int jb,int qrel,int hi){
  const float NEG=-INFINITY; int kb=64*jb+4*hi;
  #pragma unroll
  for(int r=0;r<16;++r){int kv=kb+(r&3)+8*(r>>2); if(kv>qrel)p0[r]=NEG; if(kv+32>qrel)p1[r]=NEG;}
}

constexpr int NSLOT=3, SLOTB=8192;
constexpr int LDS_K=0, LDS_V=NSLOT*SLOTB, LDS_WS=2*NSLOT*SLOTB, LDS_OST=LDS_WS+NW*64*4, LDS_CK=LDS_OST+NW*4096, LDS_PFX=LDS_CK+16384, LDS_Q=LDS_PFX+64, LDS_BYTES=LDS_Q+NW*4096;
__device__ __forceinline__ void glds16(const void*gsrc,unsigned lds_dst){unsigned keep;
  asm volatile("s_mov_b32 %0, m0\n\ts_mov_b32 m0, %2\n\ts_nop 0\n\tglobal_load_lds_dwordx4 %1, off\n\ts_mov_b32 m0, %0":"=&s"(keep):"v"(gsrc),"s"(lds_dst):"memory");}
__device__ __forceinline__ float max3f(float a,float b,float c){float r;asm("v_max3_f32 %0, %1, %2, %3":"=v"(r):"v"(a),"v"(b),"v"(c));return r;}
__device__ __forceinline__ float max2f(float a,float b){float r;asm("v_max_f32_e32 %0, %1, %2":"=v"(r):"v"(a),"v"(b));return r;}
__device__ __forceinline__ float fadd_s(float a,float b){float r;asm("v_add_f32_e32 %0, %1, %2":"=v"(r):"v"(a),"v"(b));return r;}
__device__ __forceinline__ float fsub_s(float a,float b){float r;asm("v_sub_f32_e32 %0, %1, %2":"=v"(r):"v"(a),"v"(b));return r;}
typedef float f32x2_t __attribute__((ext_vector_type(2))); typedef __bf16 bf16x2_t __attribute__((ext_vector_type(2)));
__device__ __forceinline__ unsigned cvtpk_s(float lo,float hi){f32x2_t v={lo,hi};bf16x2_t b=__builtin_convertvector(v,bf16x2_t);return __builtin_bit_cast(unsigned,b);}
#define WAIT_BAR(N) asm volatile("s_waitcnt vmcnt(" #N ") lgkmcnt(0)\n\ts_barrier":::"memory")

__device__ __forceinline__ void qkt(f32x16&p0,f32x16&p1,const char*Kslot,const bf16x8*qr,const f32x16&c0,const f32x16&c1,int r32,int hi){
  const char*kb=Kslot+hi*1024+r32*16;
  #pragma unroll
  for(int d0=0;d0<4;++d0){
    const bf16x8 b0=*reinterpret_cast<const bf16x8*>(kb+d0*2048);
    const bf16x8 b1=*reinterpret_cast<const bf16x8*>(kb+d0*2048+512);
    if(d0==0){p0=__builtin_amdgcn_mfma_f32_32x32x16_bf16(b0,qr[0],c0,0,0,0);p1=__builtin_amdgcn_mfma_f32_32x32x16_bf16(b1,qr[0],c1,0,0,0);}
    else{p0=__builtin_amdgcn_mfma_f32_32x32x16_bf16(b0,qr[d0],p0,0,0,0);p1=__builtin_amdgcn_mfma_f32_32x32x16_bf16(b1,qr[d0],p1,0,0,0);}}
}
__device__ __forceinline__ void qkt0(f32x16&p0,f32x16&p1,const char*Kslot,const bf16x8*qr,int r32,int hi){
  const char*kb=Kslot+hi*1024+r32*16;
  #pragma unroll
  for(int d0=0;d0<4;++d0){
    const bf16x8 b0=*reinterpret_cast<const bf16x8*>(kb+d0*2048);
    const bf16x8 b1=*reinterpret_cast<const bf16x8*>(kb+d0*2048+512);
    if(d0==0){p0=__builtin_amdgcn_mfma_f32_32x32x16_bf16(b0,qr[0],(f32x16){0.f,0.f,0.f,0.f,0.f,0.f,0.f,0.f,0.f,0.f,0.f,0.f,0.f,0.f,0.f,0.f},0,0,0);p1=__builtin_amdgcn_mfma_f32_32x32x16_bf16(b1,qr[0],(f32x16){0.f,0.f,0.f,0.f,0.f,0.f,0.f,0.f,0.f,0.f,0.f,0.f,0.f,0.f,0.f,0.f},0,0,0);}
    else{p0=__builtin_amdgcn_mfma_f32_32x32x16_bf16(b0,qr[d0],p0,0,0,0);p1=__builtin_amdgcn_mfma_f32_32x32x16_bf16(b1,qr[d0],p1,0,0,0);}}
}
typedef __attribute__((address_space(3))) const char* lds_cptr;
typedef short v4i16_t __attribute__((ext_vector_type(4)));
__device__ __forceinline__ void kload8(bf16x8*kf,lds_cptr kp){
  kf[0]=*(const __attribute__((address_space(3))) bf16x8*)(kp);      kf[1]=*(const __attribute__((address_space(3))) bf16x8*)(kp+512);
  kf[2]=*(const __attribute__((address_space(3))) bf16x8*)(kp+2048); kf[3]=*(const __attribute__((address_space(3))) bf16x8*)(kp+2560);
  kf[4]=*(const __attribute__((address_space(3))) bf16x8*)(kp+4096); kf[5]=*(const __attribute__((address_space(3))) bf16x8*)(kp+4608);
  kf[6]=*(const __attribute__((address_space(3))) bf16x8*)(kp+6144); kf[7]=*(const __attribute__((address_space(3))) bf16x8*)(kp+6656);
}
__device__ __forceinline__ void kload2(bf16x8*kf,lds_cptr kp,int j){ kf[2*j]=*(const __attribute__((address_space(3))) bf16x8*)(kp+j*2048); kf[2*j+1]=*(const __attribute__((address_space(3))) bf16x8*)(kp+j*2048+512); }
__device__ __forceinline__ s16x4 vtr(lds_cptr p){ return __builtin_bit_cast(s16x4,__builtin_amdgcn_ds_read_tr16_b64_v4i16((__attribute__((address_space(3))) v4i16_t*)p)); }
__device__ __forceinline__ float rowmax(const f32x16&p0,const f32x16&p1){
  float a=max3f(p0[0],p0[1],p1[0]),b=max3f(p0[2],p0[3],p1[1]);a=max3f(a,p1[2],p1[3]);
  #pragma unroll
  for(int r=4;r<16;r+=4){a=max3f(a,p0[r],p0[r+1]);b=max3f(b,p0[r+2],p0[r+3]);a=max3f(a,p1[r],p1[r+1]);b=max3f(b,p1[r+2],p1[r+3]);}
  const float m=max2f(a,b);
  auto rr=__builtin_amdgcn_permlane32_swap(__float_as_uint(m),__float_as_uint(m),false,false);
  return max2f(__uint_as_float(rr[0]),__uint_as_float(rr[1]));
}
__device__ __forceinline__ void pv(f32x16*o,int vb,bf16x8 pa0,bf16x8 pa1,bf16x8 pa2,bf16x8 pa3){
  #pragma unroll
  for(int d0=0;d0<2;++d0){s16x4 lo[4],hi[4];
    #pragma unroll
    for(int ks=0;ks<4;++ks){
      asm volatile("ds_read_b64_tr_b16 %0,%1 offset:%c2":"=&v"(lo[ks]):"v"(vb),"i"(d0*4096+ks*1024):"memory");
      asm volatile("ds_read_b64_tr_b16 %0,%1 offset:%c2":"=&v"(hi[ks]):"v"(vb),"i"(d0*4096+ks*1024+512):"memory");}
    asm volatile("s_waitcnt lgkmcnt(0)":::"memory");SBAR();
    #define PK(k) (bf16x8){lo[k][0],lo[k][1],lo[k][2],lo[k][3],hi[k][0],hi[k][1],hi[k][2],hi[k][3]}
    o[d0]=__builtin_amdgcn_mfma_f32_32x32x16_bf16(pa0,PK(0),o[d0],0,0,0);
    o[d0]=__builtin_amdgcn_mfma_f32_32x32x16_bf16(pa1,PK(1),o[d0],0,0,0);
    o[d0]=__builtin_amdgcn_mfma_f32_32x32x16_bf16(pa2,PK(2),o[d0],0,0,0);
    o[d0]=__builtin_amdgcn_mfma_f32_32x32x16_bf16(pa3,PK(3),o[d0],0,0,0);
    #undef PK
  }
}

#ifndef ATTN_STORE16
#define ATTN_STORE16(p,v) (*(u32x4*)(p)=(v))
#endif
template<int THRL,int QPI,int KPI,int OPI,bool BIAS,bool OUT8=false> __device__ __forceinline__ void attn_unit(int qb,const bf16*Qu,const bf16*__restrict__ Kh,const bf16*__restrict__ Vh,bf16*Ou,char*shm,int wid_in){
  int wid=wid_in; asm volatile("":"+s"(wid));
  const int lane=lane_id(),r32=lane&31,hi=lane>>5;
  const int q0=qb*QB;
  const bf16*Qw=Qu+(long)(wid*QBLK)*QPI;
  const unsigned lds0=(unsigned)(uintptr_t)shm;
  float*wsf=(float*)(shm+LDS_WS)+wid*64;
  const bf16*ksrc=Kh+(long)lane*KPI+wid*8;
  const bf16*vsrc=Vh+(long)(16*(wid&3)+(lane>>2))*KPI+(wid>>2)*32+(lane&3)*8;
  const unsigned kdst=lds0+LDS_K+wid*1024, vdst=lds0+LDS_V+wid*1024;
  #define DMA_K(t,slot) glds16(ksrc+(long)(t)*KVBLK*KPI,(unsigned)__builtin_amdgcn_readfirstlane(kdst+(slot)))
  #define DMA_V(t,slot) glds16(vsrc+(long)(t)*KVBLK*KPI,(unsigned)__builtin_amdgcn_readfirstlane(vdst+(slot)))
  const int vb0=(int)(lds0+LDS_V)+((lane>>4)&1)*32+(lane&3)*8+(4*hi+((lane&15)>>2))*64;
  const char*Kbase=shm+LDS_K; bf16x8 kf[8];
  const lds_cptr shm3=(lds_cptr)shm; const lds_cptr kp0=shm3+LDS_K+hi*1024+r32*16; const lds_cptr vp0=shm3+LDS_V+((lane>>4)&1)*32+(lane&3)*8+(4*hi+((lane&15)>>2))*64;
  const int NT=(q0+QB)/KVBLK;
  DMA_K(0,0);DMA_V(0,0);DMA_K(1,SLOTB);
  bf16x8 qr[4];
  #pragma unroll
  for(int d0=0;d0<4;++d0)qr[d0]=*reinterpret_cast<const bf16x8*>(&Qw[(long)r32*QPI+d0*16+hi*8]);
  float mhat=0.f,l_reg=0.f;f32x16 o[2];zero16(o[0]);zero16(o[1]);f32x16 negm;zero16(negm);
  const __attribute__((address_space(3))) unsigned*ckp=(const __attribute__((address_space(3))) unsigned*)((__attribute__((address_space(3))) const char*)shm+LDS_CK)+r32;
  const unsigned q5w=hi?0u:0x3F803F80u; unsigned ka0=0u,ka1=0u;
  #define KALD(t) do{ if(BIAS){ const unsigned a_=ckp[(t)*64], b_=ckp[(t)*64+32]; ka0=hi?0u:a_; ka1=hi?0u:b_; } }while(0)
  #define KAF(x) __builtin_bit_cast(bf16x8,(u32x4){x,0u,0u,0u})
  const int qrel=wid*QBLK+r32;
  #define CMASK(P0,P1,t) do{int jb_=(t)-(NT-4); if(jb_>=0)cmask(P0,P1,jb_,qrel,hi);}while(0)
  bool resc=false;
  #define START(P0,P1) do{ const float rm=rowmax(P0,P1); resc=false; \
    { const float dl=rm; mhat=fadd_s(mhat,dl); \
      _Pragma("unroll") for(int r=0;r<16;++r){P0[r]=fsub_s(P0[r],dl);P1[r]=fsub_s(P1[r],dl);} \
      _Pragma("unroll") for(int r=0;r<16;++r)negm[r]=-mhat; asm volatile("":"+v"(negm)); } \
    _Pragma("unroll") for(int r=0;r<16;++r)P0[r]=__builtin_amdgcn_exp2f(P0[r]); }while(0)
  #define RESC() do{ if(resc){ asm volatile("s_waitcnt lgkmcnt(0)":::"memory"); \
      _Pragma("unroll") for(int d_=0;d_<2;++d_) _Pragma("unroll") for(int r=0;r<16;++r)o[d_][r]*=wsf[crow(r,hi)]; } }while(0)
  f32x16 pA0,pA1,pB0,pB1;
  int sl_prev=0,sl_cur=0,sl_next=SLOTB;
  #define ROT() do{sl_prev=sl_cur;sl_cur=sl_next;sl_next=(sl_next==(NSLOT-1)*SLOTB)?0:sl_next+SLOTB;}while(0)
  DMA_K(2,2*SLOTB);
  WAIT_BAR(3);
  KALD(0); qkt(pA0,pA1,Kbase,qr,negm,negm,r32,hi); if(BIAS){ pA0=__builtin_amdgcn_mfma_f32_32x32x16_bf16(KAF(ka0),KAF(q5w),pA0,0,0,0); pA1=__builtin_amdgcn_mfma_f32_32x32x16_bf16(KAF(ka1),KAF(q5w),pA1,0,0,0); }asm volatile("s_nop 15\n\ts_nop 7":"+v"(pA0),"+v"(pA1));CMASK(pA0,pA1,0);
  START(pA0,pA1);
  KALD(1);
  _Pragma("unroll") for(int r=0;r<16;++r)pA1[r]=__builtin_amdgcn_exp2f(pA1[r]);
  WAIT_BAR(0);
  DMA_K(3,0);DMA_V(1,SLOTB);
  ROT();
  kload8(kf,kp0+sl_cur);
  WAIT_BAR(2);
  s16x4 vlo[8],vhi[8]; u32x4 pw0,pw1,pw2,pw3;
  #define PKW(P,B) cvtpk_s(P[B],P[B+1])
  #define PAF(k) __builtin_bit_cast(bf16x8,pw##k)
  #define VFR(i) (bf16x8){vlo[i][0],vlo[i][1],vlo[i][2],vlo[i][3],vhi[i][0],vhi[i][1],vhi[i][2],vhi[i][3]}
  #define PIN(x) asm volatile("":"+v"(x))
  #define MX3(a,b,c) __builtin_fmaxf(__builtin_fmaxf((a),(b)),(c))
  #define GAPA(MF,A0,A1,A2,A3,W0,W1,PW) do{ MF; sacc+=A0; sacc+=A1; sacc+=A2; sacc+=A3; PIN(sacc); W0; W1; PIN(PW); SBAR(); }while(0)
  #define EX(v) __builtin_amdgcn_exp2f(v)
  #define GAPB(MF,X,B) do{ MF; X[B]=EX(X[B]); X[B+1]=EX(X[B+1]); X[B+2]=EX(X[B+2]); X[B+3]=EX(X[B+3]); PIN(X); SBAR(); }while(0)
  #define GAPBS(MF,X,B,DO_,Y,G) do{ MF; X[B]=EX(X[B]); X[B+1]=EX(X[B+1]); X[B+2]=EX(X[B+2]); X[B+3]=EX(X[B+3]); PIN(X); SBAR(); }while(0)
  #define VRD(i) do{ vlo[i]=vtr(vp_+(((i)>>2)*4096+((i)&3)*1024)); vhi[i]=vtr(vp_+(((i)>>2)*4096+((i)&3)*1024+512)); }while(0)
  #define KRD(G,j) do{ if(G){ kload2(kf,kp0+sl_next,j); SBAR(); } }while(0)
  #define STEP(C0,C1,P0,P1,t,GK,GV,GL) do{ SBAR(); \
    const lds_cptr vp_=vp0+sl_prev; \
    const bf16x8 qd0=qr[0], qd1=qr[1], qd2=qr[2], qd3=qr[3]; \
    VRD(0); SBAR(); float sacc=(P0[0]+P0[1]); \
    GAPA(C0=__builtin_amdgcn_mfma_f32_32x32x16_bf16(kf[0],qd0,negm,0,0,0), P0[2],P0[3],P0[4],P0[5],     pw0[0]=PKW(P0,0), pw0[1]=PKW(P0,2), pw0); \
    VRD(4); SBAR(); GAPA(C1=__builtin_amdgcn_mfma_f32_32x32x16_bf16(kf[1],qd0,negm,0,0,0), P0[6],P0[7],P0[8],P0[9],     pw0[2]=PKW(P0,4), pw0[3]=PKW(P0,6), pw0); \
    VRD(1); SBAR(); GAPA(C0=__builtin_amdgcn_mfma_f32_32x32x16_bf16(kf[2],qd1,C0,0,0,0),   P0[10],P0[11],P0[12],P0[13], pw1[0]=PKW(P0,8), pw1[1]=PKW(P0,10), pw1); \
    VRD(5); SBAR(); GAPA(C1=__builtin_amdgcn_mfma_f32_32x32x16_bf16(kf[3],qd1,C1,0,0,0),   P0[14],P0[15],P1[0],P1[1],   pw1[2]=PKW(P0,12),pw1[3]=PKW(P0,14), pw1); \
    VRD(2); SBAR(); GAPA(C0=__builtin_amdgcn_mfma_f32_32x32x16_bf16(kf[4],qd2,C0,0,0,0),   P1[2],P1[3],P1[4],P1[5],     pw2[0]=PKW(P1,0), pw2[1]=PKW(P1,2), pw2); \
    VRD(6); SBAR(); GAPA(C1=__builtin_amdgcn_mfma_f32_32x32x16_bf16(kf[5],qd2,C1,0,0,0),   P1[6],P1[7],P1[8],P1[9],     pw2[2]=PKW(P1,4), pw2[3]=PKW(P1,6), pw2); \
    VRD(3); SBAR(); GAPA(C0=__builtin_amdgcn_mfma_f32_32x32x16_bf16(kf[6],qd3,C0,0,0,0),   P1[10],P1[11],P1[12],P1[13], pw3[0]=PKW(P1,8), pw3[1]=PKW(P1,10), pw3); \
    VRD(7); SBAR(); GAPA(C1=__builtin_amdgcn_mfma_f32_32x32x16_bf16(kf[7],qd3,C1,0,0,0),   P1[14],P1[15],0.f,0.f,       pw3[2]=PKW(P1,12),pw3[3]=PKW(P1,14), pw3); \
    if(BIAS){ C0=__builtin_amdgcn_mfma_f32_32x32x16_bf16(KAF(ka0),KAF(q5w),C0,0,0,0); C1=__builtin_amdgcn_mfma_f32_32x32x16_bf16(KAF(ka1),KAF(q5w),C1,0,0,0); SBAR(); } \
    l_reg+=sacc; \
    if(GK){DMA_K((t)+3,sl_cur);} if(GV){DMA_V((t)+1,sl_next);} \
    CMASK(C0,C1,t); \
    { float a=MX3(C0[0],C0[1],C1[0]),b=MX3(C0[2],C0[3],C1[1]); a=MX3(a,C1[2],C1[3]); \
      _Pragma("unroll") for(int r=4;r<16;r+=4){a=MX3(a,C0[r],C0[r+1]);b=MX3(b,C0[r+2],C0[r+3]);a=MX3(a,C1[r],C1[r+1]);b=MX3(b,C1[r+2],C1[r+3]);} \
      float rm=__builtin_fmaxf(a,b); { auto rr=__builtin_amdgcn_permlane32_swap(__float_as_uint(rm),__float_as_uint(rm),false,false); rm=__builtin_fmaxf(__uint_as_float(rr[0]),__uint_as_float(rr[1])); } \
      resc=false; \
      if(__builtin_expect(__any(rm>(float)THRL),0)){ const float dl=__builtin_fmaxf(rm,0.f); mhat+=dl; \
        _Pragma("unroll") for(int r=0;r<16;++r){C0[r]-=dl;C1[r]-=dl;} \
        _Pragma("unroll") for(int r=0;r<16;++r)negm[r]=-mhat; asm volatile("":"+v"(negm)); \
        const float f=__builtin_amdgcn_exp2f(-dl); l_reg*=f; if(hi==0)wsf[r32]=f; resc=true; } } \
    SBAR(); \
    GAPBS(o[0]=__builtin_amdgcn_mfma_f32_32x32x16_bf16(PAF(0),VFR(0),o[0],0,0,0), C0,0, GL,P0,0); \
    GAPBS(o[1]=__builtin_amdgcn_mfma_f32_32x32x16_bf16(PAF(0),VFR(4),o[1],0,0,0), C0,4, GL,P0,1); \
    KRD(GL,0); GAPBS(o[0]=__builtin_amdgcn_mfma_f32_32x32x16_bf16(PAF(1),VFR(1),o[0],0,0,0), C0,8, GL,P0,2); \
    KRD(GL,1); GAPBS(o[1]=__builtin_amdgcn_mfma_f32_32x32x16_bf16(PAF(1),VFR(5),o[1],0,0,0), C0,12, GL,P0,3); \
    KRD(GL,2); GAPBS(o[0]=__builtin_amdgcn_mfma_f32_32x32x16_bf16(PAF(2),VFR(2),o[0],0,0,0), C1,0, GL,P1,0); \
    KRD(GL,3); if(GL){KALD((t)+1);} SBAR(); GAPBS(o[1]=__builtin_amdgcn_mfma_f32_32x32x16_bf16(PAF(2),VFR(6),o[1],0,0,0), C1,4, GL,P1,1); \
    GAPBS(o[0]=__builtin_amdgcn_mfma_f32_32x32x16_bf16(PAF(3),VFR(3),o[0],0,0,0), C1,8, GL,P1,2); \
    GAPBS(o[1]=__builtin_amdgcn_mfma_f32_32x32x16_bf16(PAF(3),VFR(7),o[1],0,0,0), C1,12, GL,P1,3); \
    }while(0)
  int t=1;
  #undef CMASK
  #define CMASK(P0,P1,t) do{}while(0)
  for(;t+5<NT;t+=2){
    STEP(pB0,pB1,pA0,pA1,t,true,true,true);     WAIT_BAR(2); RESC(); ROT();
    STEP(pA0,pA1,pB0,pB1,t+1,true,true,true);   WAIT_BAR(2); RESC(); ROT();
  }
  #undef CMASK
  #define CMASK(P0,P1,t) do{int jb_=(t)-(NT-4); if(jb_>=0)cmask(P0,P1,jb_,qrel,hi);}while(0)
  #define ENDW(tt) do{ if((tt)+3<NT){WAIT_BAR(2);} else if((tt)+2<NT){WAIT_BAR(1);} else {WAIT_BAR(0);} }while(0)
  for(;t+1<NT;t+=2){
    STEP(pB0,pB1,pA0,pA1,t,(t+3<NT),(t+1<NT),(t+1<NT));       ENDW(t);   RESC(); ROT();
    STEP(pA0,pA1,pB0,pB1,t+1,(t+4<NT),(t+2<NT),(t+2<NT));     ENDW(t+1); RESC(); ROT();
  }
  STEP(pB0,pB1,pA0,pA1,NT-1,false,false,false); RESC();
  { float sacc=pB0[0]+pB0[1]; _Pragma("unroll") for(int r=2;r<16;++r)sacc+=pB0[r]; _Pragma("unroll") for(int r=0;r<16;++r)sacc+=pB1[r]; l_reg+=sacc;
    pw0=(u32x4){PKW(pB0,0),PKW(pB0,2),PKW(pB0,4),PKW(pB0,6)};pw1=(u32x4){PKW(pB0,8),PKW(pB0,10),PKW(pB0,12),PKW(pB0,14)};pw2=(u32x4){PKW(pB1,0),PKW(pB1,2),PKW(pB1,4),PKW(pB1,6)};pw3=(u32x4){PKW(pB1,8),PKW(pB1,10),PKW(pB1,12),PKW(pB1,14)};
    SBAR(); pv(o,vb0+sl_cur,PAF(0),PAF(1),PAF(2),PAF(3)); }
  #undef PKW
  #undef PAF
  #undef VFR
  #undef PIN
  #undef MX3
  #undef GAPA
  #undef GAPB
  #undef GAPBS
  #undef EX
  #undef VRD
  #undef KRD
  #undef STEP
  #undef ENDW
  {auto rr=__builtin_amdgcn_permlane32_swap(__float_as_uint(l_reg),__float_as_uint(l_reg),false,false);l_reg=__uint_as_float(rr[0])+__uint_as_float(rr[1]);}
  if(hi==0)wsf[32+r32]=l_reg;asm volatile("s_waitcnt lgkmcnt(0)":::"memory");
  float rli[16];
  #pragma unroll
  for(int r=0;r<16;++r)rli[r]=__builtin_amdgcn_rcpf(wsf[32+crow(r,hi)]);
  bf16*Ow=OUT8?Ou:Ou+(long)(wid*QBLK)*OPI;
  { bf16*stg=(bf16*)(shm+LDS_OST)+wid*2048;
    #pragma unroll
    for(int r=0;r<16;++r){const int orow=crow(r,hi);
      #pragma unroll
      for(int d0=0;d0<2;++d0)stg[orow*64+d0*32+r32]=(bf16)(cvtpk_s(o[d0][r]*rli[r],0.f)&0xffffu);}
    asm volatile("s_waitcnt lgkmcnt(0)":::"memory");
    if constexpr(!OUT8){
    #pragma unroll
    for(int i=0;i<4;++i){const int row=i*8+(lane>>3),ch=lane&7; const u32x4 v=*(const u32x4*)(stg+row*64+ch*8); ATTN_STORE16(Ow+(long)row*OPI+ch*8,v);}
    } else {
    unsigned char*O8=(unsigned char*)Ou+(long)(wid*QBLK)*OPI;
    #pragma unroll
    for(int i=0;i<4;++i){const int row=i*8+(lane>>3),ch=lane&7; const u32x4 v=*(const u32x4*)(stg+row*64+ch*8); u32x2 w;
      w.x=cvt4_fp8(__uint_as_float(v[0]<<16)*8.f,__uint_as_float(v[0]&0xffff0000u)*8.f,__uint_as_float(v[1]<<16)*8.f,__uint_as_float(v[1]&0xffff0000u)*8.f);
      w.y=cvt4_fp8(__uint_as_float(v[2]<<16)*8.f,__uint_as_float(v[2]&0xffff0000u)*8.f,__uint_as_float(v[3]<<16)*8.f,__uint_as_float(v[3]&0xffff0000u)*8.f);
      *(u32x2*)(O8+(long)row*OPI+ch*8)=w;}
    } }
  asm volatile("s_waitcnt lgkmcnt(0)\n\ts_barrier":::"memory");
  #undef DMA_K
  #undef DMA_V
  #undef CMASK
  #undef START
  #undef RESC
  #undef ROT
  #undef KALD
  #undef KAF
}
constexpr int U8_VSLOT=16384, U8_LV=NSLOT*SLOTB, U8_WS=U8_LV+NSLOT*U8_VSLOT, U8_Q=U8_WS+NW*256, U8_BYTES=U8_Q+NW*4096;
__device__ __forceinline__ void pv4(f32x16*o,int vb,bf16x8 pa0,bf16x8 pa1,bf16x8 pa2,bf16x8 pa3){
  #pragma unroll
  for(int d0=0;d0<4;++d0){s16x4 lo[4],hi[4];
    #pragma unroll
    for(int ks=0;ks<4;++ks){
      asm volatile("ds_read_b64_tr_b16 %0,%1 offset:%c2":"=&v"(lo[ks]):"v"(vb),"i"(d0*4096+ks*1024):"memory");
      asm volatile("ds_read_b64_tr_b16 %0,%1 offset:%c2":"=&v"(hi[ks]):"v"(vb),"i"(d0*4096+ks*1024+512):"memory");}
    asm volatile("s_waitcnt lgkmcnt(0)":::"memory");SBAR();
    #define PK(k) (bf16x8){lo[k][0],lo[k][1],lo[k][2],lo[k][3],hi[k][0],hi[k][1],hi[k][2],hi[k][3]}
    o[d0]=__builtin_amdgcn_mfma_f32_32x32x16_bf16(pa0,PK(0),o[d0],0,0,0);
    o[d0]=__builtin_amdgcn_mfma_f32_32x32x16_bf16(pa1,PK(1),o[d0],0,0,0);
    o[d0]=__builtin_amdgcn_mfma_f32_32x32x16_bf16(pa2,PK(2),o[d0],0,0,0);
    o[d0]=__builtin_amdgcn_mfma_f32_32x32x16_bf16(pa3,PK(3),o[d0],0,0,0);
    #undef PK
  }
}
template<int THRL,int QPI,int KPI,int OPI,bool FUSE,int O0PI> __device__ __forceinline__ void attn_unit128(int qb,const bf16*Qu,const bf16*__restrict__ Kh,const bf16*__restrict__ Vh,bf16*Ou,char*shm,int wid_in,const bf16*O0,const float*sg,float lam){
  int wid=wid_in; asm volatile("":"+s"(wid));
  const int lane=lane_id(),r32=lane&31,hi=lane>>5;
  const int q0=qb*QB;
  const bf16*Qw=Qu+(long)(wid*QBLK)*QPI;
  const unsigned lds0=(unsigned)(uintptr_t)shm;
  float*wsf=(float*)(shm+U8_WS)+wid*64;
  const bf16*ksrc=Kh+(long)lane*KPI+wid*8;
  const bf16*vsrc=Vh+(long)(16*(wid&3)+(lane>>2))*KPI+(wid>>2)*32+(lane&3)*8;
  const unsigned kdst=lds0+LDS_K+wid*1024, vdst=lds0+U8_LV+wid*1024;
  #define DMA_K(t,slot) glds16(ksrc+(long)(t)*KVBLK*KPI,(unsigned)__builtin_amdgcn_readfirstlane(kdst+(slot)))
  #define DMA_V(t,slot) do{ glds16(vsrc+(long)(t)*KVBLK*KPI,(unsigned)__builtin_amdgcn_readfirstlane(vdst+2*(slot))); glds16(vsrc+(long)(t)*KVBLK*KPI+64,(unsigned)__builtin_amdgcn_readfirstlane(vdst+2*(slot)+8192)); }while(0)
  const int vb0=(int)(lds0+U8_LV)+((lane>>4)&1)*32+(lane&3)*8+(4*hi+((lane&15)>>2))*64;
  const char*Kbase=shm+LDS_K; bf16x8 kf[8];
  const lds_cptr shm3=(lds_cptr)shm; const lds_cptr kp0=shm3+LDS_K+hi*1024+r32*16; const lds_cptr vp0=shm3+U8_LV+((lane>>4)&1)*32+(lane&3)*8+(4*hi+((lane&15)>>2))*64;
  const int NT=(q0+QB)/KVBLK;
  DMA_K(0,0);DMA_V(0,0);DMA_K(1,SLOTB);
  bf16x8 qr[4];
  #pragma unroll
  for(int d0=0;d0<4;++d0)qr[d0]=*reinterpret_cast<const bf16x8*>(&Qw[(long)r32*QPI+d0*16+hi*8]);
  float mhat=0.f,l_reg=0.f;f32x16 o[4];zero16(o[0]);zero16(o[1]);zero16(o[2]);zero16(o[3]);
  const int qrel=wid*QBLK+r32;
  #define CMASK(P0,P1,t) do{int jb_=(t)-(NT-4); if(jb_>=0)cmask(P0,P1,jb_,qrel,hi);}while(0)
  bool resc=false;
  #define START(P0,P1) do{ const float rm=rowmax(P0,P1); resc=false; \
    { const float dl=rm; mhat=fadd_s(mhat,dl); \
      _Pragma("unroll") for(int r=0;r<16;++r){P0[r]=fsub_s(P0[r],dl);P1[r]=fsub_s(P1[r],dl);} } \
    _Pragma("unroll") for(int r=0;r<16;++r)P0[r]=__builtin_amdgcn_exp2f(P0[r]); }while(0)
  #define RESC() do{ if(resc){ asm volatile("s_waitcnt lgkmcnt(0)":::"memory"); \
      _Pragma("unroll") for(int r=0;r<16;++r){ const float f_=wsf[crow(r,hi)]; o[0][r]*=f_; o[1][r]*=f_; o[2][r]*=f_; o[3][r]*=f_; } } }while(0)
  f32x16 pA0,pA1,pB0,pB1;
  #define MKC(X,G) do{ const float nm_=-mhat; X[4*(G)]=nm_; X[4*(G)+1]=nm_; X[4*(G)+2]=nm_; X[4*(G)+3]=nm_; }while(0)
  int sl_prev=0,sl_cur=0,sl_next=SLOTB;
  #define ROT() do{sl_prev=sl_cur;sl_cur=sl_next;sl_next=(sl_next==(NSLOT-1)*SLOTB)?0:sl_next+SLOTB;}while(0)
  DMA_K(2,2*SLOTB);
  WAIT_BAR(4);
  qkt0(pA0,pA1,Kbase,qr,r32,hi);asm volatile("s_nop 15\n\ts_nop 7":"+v"(pA0),"+v"(pA1));CMASK(pA0,pA1,0);
  START(pA0,pA1);
  MKC(pB0,0);MKC(pB0,1);MKC(pB0,2);MKC(pB0,3);MKC(pB1,0);MKC(pB1,1);MKC(pB1,2);MKC(pB1,3);
  _Pragma("unroll") for(int r=0;r<16;++r)pA1[r]=__builtin_amdgcn_exp2f(pA1[r]);
  WAIT_BAR(0);
  DMA_K(3,0);DMA_V(1,SLOTB);
  ROT();
  kload8(kf,kp0+sl_cur);
  WAIT_BAR(3);
  s16x4 vlo[8],vhi[8]; u32x4 pw0,pw1,pw2,pw3;
  #define PKW(P,B) cvtpk_s(P[B],P[B+1])
  #define PAF(k) __builtin_bit_cast(bf16x8,pw##k)
  #define VFR(i) (bf16x8){vlo[i][0],vlo[i][1],vlo[i][2],vlo[i][3],vhi[i][0],vhi[i][1],vhi[i][2],vhi[i][3]}
  #define PIN(x) asm volatile("":"+v"(x))
  #define MX3(a,b,c) __builtin_fmaxf(__builtin_fmaxf((a),(b)),(c))
  #define GAPA(MF,A0,A1,A2,A3,W0,W1,PW) do{ MF; sacc+=A0; sacc+=A1; sacc+=A2; sacc+=A3; PIN(sacc); W0; W1; PIN(PW); SBAR(); }while(0)
  #define EX(v) __builtin_amdgcn_exp2f(v)
  #define GAPB1(MF,X,B,RD) do{ MF; X[B]=EX(X[B]); X[B+1]=EX(X[B+1]); X[B+2]=EX(X[B+2]); X[B+3]=EX(X[B+3]); PIN(X); SBAR(); RD; SBAR(); }while(0)
  #define GAPB2(MF,DO_,Y,G,RD) do{ MF; if(DO_){ MKC(Y,G); PIN(Y); } SBAR(); RD; SBAR(); }while(0)
  #define VRDX(i,off) do{ vlo[i]=vtr(vp_+((off)+((i)&3)*1024)); vhi[i]=vtr(vp_+((off)+((i)&3)*1024+512)); }while(0)
  #define KRD(G,j) do{ if(G){ kload2(kf,kp0+sl_next,j); SBAR(); } }while(0)
  #define QLD(j) (*(const __attribute__((address_space(3))) bf16x8*)(qp0+(j)*1024))
  #define STEP(C0,C1,P0,P1,t,GK,GV,GL) do{ SBAR(); \
    const lds_cptr vp_=vp0+2*sl_prev; \
    VRDX(0,0); SBAR(); float sacc=(P0[0]+P0[1]); \
    GAPA(C0=__builtin_amdgcn_mfma_f32_32x32x16_bf16(kf[0],qr[0],C0,0,0,0), P0[2],P0[3],P0[4],P0[5],     pw0[0]=PKW(P0,0), pw0[1]=PKW(P0,2), pw0); \
    GAPA(C1=__builtin_amdgcn_mfma_f32_32x32x16_bf16(kf[1],qr[0],C1,0,0,0), P0[6],P0[7],P0[8],P0[9],     pw0[2]=PKW(P0,4), pw0[3]=PKW(P0,6), pw0); \
    VRDX(1,0); SBAR(); GAPA(C0=__builtin_amdgcn_mfma_f32_32x32x16_bf16(kf[2],qr[1],C0,0,0,0),   P0[10],P0[11],P0[12],P0[13], pw1[0]=PKW(P0,8), pw1[1]=PKW(P0,10), pw1); \
    GAPA(C1=__builtin_amdgcn_mfma_f32_32x32x16_bf16(kf[3],qr[1],C1,0,0,0),   P0[14],P0[15],P1[0],P1[1],   pw1[2]=PKW(P0,12),pw1[3]=PKW(P0,14), pw1); \
    VRDX(2,0); SBAR(); GAPA(C0=__builtin_amdgcn_mfma_f32_32x32x16_bf16(kf[4],qr[2],C0,0,0,0),   P1[2],P1[3],P1[4],P1[5],     pw2[0]=PKW(P1,0), pw2[1]=PKW(P1,2), pw2); \
    GAPA(C1=__builtin_amdgcn_mfma_f32_32x32x16_bf16(kf[5],qr[2],C1,0,0,0),   P1[6],P1[7],P1[8],P1[9],     pw2[2]=PKW(P1,4), pw2[3]=PKW(P1,6), pw2); \
    VRDX(3,0); SBAR(); GAPA(C0=__builtin_amdgcn_mfma_f32_32x32x16_bf16(kf[6],qr[3],C0,0,0,0),   P1[10],P1[11],P1[12],P1[13], pw3[0]=PKW(P1,8), pw3[1]=PKW(P1,10), pw3); \
    GAPA(C1=__builtin_amdgcn_mfma_f32_32x32x16_bf16(kf[7],qr[3],C1,0,0,0),   P1[14],P1[15],0.f,0.f,       pw3[2]=PKW(P1,12),pw3[3]=PKW(P1,14), pw3); \
    l_reg+=sacc; \
    if(GK){DMA_K((t)+3,sl_cur);} if(GV){DMA_V((t)+1,sl_next);} \
    CMASK(C0,C1,t); \
    { float a=MX3(C0[0],C0[1],C1[0]),b=MX3(C0[2],C0[3],C1[1]); a=MX3(a,C1[2],C1[3]); \
      _Pragma("unroll") for(int r=4;r<16;r+=4){a=MX3(a,C0[r],C0[r+1]);b=MX3(b,C0[r+2],C0[r+3]);a=MX3(a,C1[r],C1[r+1]);b=MX3(b,C1[r+2],C1[r+3]);} \
      float rm=__builtin_fmaxf(a,b); { auto rr=__builtin_amdgcn_permlane32_swap(__float_as_uint(rm),__float_as_uint(rm),false,false); rm=__builtin_fmaxf(__uint_as_float(rr[0]),__uint_as_float(rr[1])); } \
      resc=false; \
      if(__builtin_expect(__any(rm>(float)THRL),0)){ const float dl=__builtin_fmaxf(rm,0.f); mhat+=dl; \
        _Pragma("unroll") for(int r=0;r<16;++r){C0[r]-=dl;C1[r]-=dl;} \
        const float f=__builtin_amdgcn_exp2f(-dl); l_reg*=f; if(hi==0)wsf[r32]=f; resc=true; } } \
    SBAR(); \
    GAPB1(o[0]=__builtin_amdgcn_mfma_f32_32x32x16_bf16(PAF(0),VFR(0),o[0],0,0,0), C0,0,  VRDX(4,4096)); \
    GAPB1(o[0]=__builtin_amdgcn_mfma_f32_32x32x16_bf16(PAF(1),VFR(1),o[0],0,0,0), C0,4,  VRDX(5,4096)); \
    GAPB1(o[0]=__builtin_amdgcn_mfma_f32_32x32x16_bf16(PAF(2),VFR(2),o[0],0,0,0), C0,8,  VRDX(6,4096)); \
    GAPB1(o[0]=__builtin_amdgcn_mfma_f32_32x32x16_bf16(PAF(3),VFR(3),o[0],0,0,0), C0,12, VRDX(7,4096)); \
    GAPB1(o[1]=__builtin_amdgcn_mfma_f32_32x32x16_bf16(PAF(0),VFR(4),o[1],0,0,0), C1,0,  VRDX(0,8192)); \
    GAPB1(o[1]=__builtin_amdgcn_mfma_f32_32x32x16_bf16(PAF(1),VFR(5),o[1],0,0,0), C1,4,  VRDX(1,8192)); \
    GAPB1(o[1]=__builtin_amdgcn_mfma_f32_32x32x16_bf16(PAF(2),VFR(6),o[1],0,0,0), C1,8,  VRDX(2,8192)); \
    GAPB1(o[1]=__builtin_amdgcn_mfma_f32_32x32x16_bf16(PAF(3),VFR(7),o[1],0,0,0), C1,12, VRDX(3,8192)); \
    GAPB2(o[2]=__builtin_amdgcn_mfma_f32_32x32x16_bf16(PAF(0),VFR(0),o[2],0,0,0), GL,P0,0, VRDX(4,12288)); \
    GAPB2(o[2]=__builtin_amdgcn_mfma_f32_32x32x16_bf16(PAF(1),VFR(1),o[2],0,0,0), GL,P0,1, VRDX(5,12288)); \
    GAPB2(o[2]=__builtin_amdgcn_mfma_f32_32x32x16_bf16(PAF(2),VFR(2),o[2],0,0,0), GL,P0,2, VRDX(6,12288)); \
    GAPB2(o[2]=__builtin_amdgcn_mfma_f32_32x32x16_bf16(PAF(3),VFR(3),o[2],0,0,0), GL,P0,3, VRDX(7,12288)); \
    KRD(GL,0); GAPB2(o[3]=__builtin_amdgcn_mfma_f32_32x32x16_bf16(PAF(0),VFR(4),o[3],0,0,0), GL,P1,0, (void)0); \
    KRD(GL,1); GAPB2(o[3]=__builtin_amdgcn_mfma_f32_32x32x16_bf16(PAF(1),VFR(5),o[3],0,0,0), GL,P1,1, (void)0); \
    KRD(GL,2); GAPB2(o[3]=__builtin_amdgcn_mfma_f32_32x32x16_bf16(PAF(2),VFR(6),o[3],0,0,0), GL,P1,2, (void)0); \
    KRD(GL,3); GAPB2(o[3]=__builtin_amdgcn_mfma_f32_32x32x16_bf16(PAF(3),VFR(7),o[3],0,0,0), GL,P1,3, (void)0); \
    }while(0)
  int t=1;
  #undef CMASK
  #define CMASK(P0,P1,t) do{}while(0)
  for(;t+5<NT;t+=2){
    STEP(pB0,pB1,pA0,pA1,t,true,true,true);     WAIT_BAR(3); RESC(); ROT();
    STEP(pA0,pA1,pB0,pB1,t+1,true,true,true);   WAIT_BAR(3); RESC(); ROT();
  }
  #undef CMASK
  #define CMASK(P0,P1,t) do{int jb_=(t)-(NT-4); if(jb_>=0)cmask(P0,P1,jb_,qrel,hi);}while(0)
  #define ENDW(tt) do{ if((tt)+3<NT){WAIT_BAR(3);} else if((tt)+2<NT){WAIT_BAR(2);} else {WAIT_BAR(0);} }while(0)
  for(;t+1<NT;t+=2){
    STEP(pB0,pB1,pA0,pA1,t,(t+3<NT),(t+1<NT),(t+1<NT));       ENDW(t);   RESC(); ROT();
    STEP(pA0,pA1,pB0,pB1,t+1,(t+4<NT),(t+2<NT),(t+2<NT));     ENDW(t+1); RESC(); ROT();
  }
  STEP(pB0,pB1,pA0,pA1,NT-1,false,false,false); RESC();
  { float sacc=pB0[0]+pB0[1]; _Pragma("unroll") for(int r=2;r<16;++r)sacc+=pB0[r]; _Pragma("unroll") for(int r=0;r<16;++r)sacc+=pB1[r]; l_reg+=sacc;
    pw0=(u32x4){PKW(pB0,0),PKW(pB0,2),PKW(pB0,4),PKW(pB0,6)};pw1=(u32x4){PKW(pB0,8),PKW(pB0,10),PKW(pB0,12),PKW(pB0,14)};pw2=(u32x4){PKW(pB1,0),PKW(pB1,2),PKW(pB1,4),PKW(pB1,6)};pw3=(u32x4){PKW(pB1,8),PKW(pB1,10),PKW(pB1,12),PKW(pB1,14)};
    SBAR(); pv4(o,vb0+2*sl_cur,PAF(0),PAF(1),PAF(2),PAF(3)); }
  #undef PKW
  #undef PAF
  #undef VFR
  #undef PIN
  #undef MX3
  #undef GAPA
  #undef GAPB1
  #undef GAPB2
  #undef EX
  #undef VRDX
  #undef QLD
  #undef KRD
  #undef STEP
  #undef ENDW
  {auto rr=__builtin_amdgcn_permlane32_swap(__float_as_uint(l_reg),__float_as_uint(l_reg),false,false);l_reg=__uint_as_float(rr[0])+__uint_as_float(rr[1]);}
  if(hi==0)wsf[32+r32]=l_reg;asm volatile("s_waitcnt lgkmcnt(0)":::"memory");
  float rli[16];
  #pragma unroll
  for(int r=0;r<16;++r)rli[r]=__builtin_amdgcn_rcpf(wsf[32+crow(r,hi)]);
  bf16*Ow=Ou+(long)(wid*QBLK)*OPI;
  asm volatile("s_waitcnt lgkmcnt(0)\n\ts_barrier":::"memory");
  { bf16*stg=(bf16*)(shm)+wid*4096;
    #pragma unroll
    for(int r=0;r<16;++r){const int orow=crow(r,hi);
      #pragma unroll
      for(int d0=0;d0<4;++d0)stg[orow*128+d0*32+r32]=(bf16)(cvtpk_s(o[d0][r]*rli[r],0.f)&0xffffu);}
    asm volatile("s_waitcnt lgkmcnt(0)":::"memory");
    if constexpr(!FUSE){
    #pragma unroll
    for(int i=0;i<8;++i){const int row=i*4+(lane>>4),ch=lane&15; const u32x4 v=*(const u32x4*)(stg+row*128+ch*8); ATTN_STORE16(Ow+(long)row*OPI+ch*8,v);}
    } else {
    const int ch=lane&15; const bf16*O0w=O0+(long)(wid*QBLK)*O0PI;
    const f32x4 g0=*(const f32x4*)(sg+ch*8),g1=*(const f32x4*)(sg+ch*8+4);
    u32x4 a0[8];
    #pragma unroll
    for(int i=0;i<8;++i){const int row=i*4+(lane>>4); a0[i]=*(const u32x4*)(O0w+(long)row*O0PI+ch*8);}
    #pragma unroll
    for(int i=0;i<8;++i){const int row=i*4+(lane>>4); const u32x4 v=*(const u32x4*)(stg+row*128+ch*8); float y[8],ss=0.f;
      #pragma unroll
      for(int j=0;j<4;++j){ y[2*j]=__uint_as_float(a0[i][j]<<16)-lam*__uint_as_float(v[j]<<16); y[2*j+1]=__uint_as_float(a0[i][j]&0xffff0000u)-lam*__uint_as_float(v[j]&0xffff0000u); ss+=y[2*j]*y[2*j]+y[2*j+1]*y[2*j+1]; }
      ss+=__shfl_xor(ss,1);ss+=__shfl_xor(ss,2);ss+=__shfl_xor(ss,4);ss+=__shfl_xor(ss,8);
      const float r=0.8f/sqrtf(ss*(1.f/128.f)+1e-6f);
      u32x4 w; w.x=cvtpk_s(y[0]*r*g0[0],y[1]*r*g0[1]); w.y=cvtpk_s(y[2]*r*g0[2],y[3]*r*g0[3]); w.z=cvtpk_s(y[4]*r*g1[0],y[5]*r*g1[1]); w.w=cvtpk_s(y[6]*r*g1[2],y[7]*r*g1[3]);
      ATTN_STORE16(Ow+(long)row*OPI+ch*8,w);}
    } }
  asm volatile("s_waitcnt lgkmcnt(0)\n\ts_barrier":::"memory");
  #undef DMA_K
  #undef DMA_V
  #undef CMASK
  #undef START
  #undef RESC
  #undef ROT
  #undef MKC
}
#undef SBAR
#undef WAIT_BAR
}

__device__ __forceinline__ void phase2(Frame& F, const Params& P, int item_lo, int item_hi) {
    unsigned char* ws = F.ws;
    const int wid = F.wave;
#define P2_BASES() unsigned char* ws_ = ws; asm volatile("" : "+s"(ws_)); float* out_ = P.out; asm volatile("" : "+s"(out_)); \
    bf16* QB = (bf16*)(ws_ + WS_QBUF); const bf16* KVB = (const bf16*)(ws_ + WS_KVBUF); bf16* DO = (bf16*)((char*)out_ + 192 * MiB); (void)QB; (void)KVB; (void)DO
    constexpr int N_DIFF = 1024, N_FOXP = 1024, N_MEM = 1024, N_ITEMS = N_DIFF + N_FOXP + N_MEM;
    float lam;
    { const int lane = lane_id(); const float* lp = P.in[7]; const float a = wave_sum(lp[lane] * lp[64 + lane]), b = wave_sum(lp[128 + lane] * lp[192 + lane]);
      lam = __uint_as_float(__builtin_amdgcn_readfirstlane(__float_as_uint(__expf(a) - __expf(b) + 0.2f))); }
    for (int i = 0;; ++i) {
        const int L4 = (item_lo >> 1) + i * F.G + F.vcu; if (L4 >= (item_hi >> 1) || L4 >= 512) break;
        {
            P2_BASES();
            const int u = L4 >> 3, pr = L4 & 7, b = u >> 2, h = u & 3;
            const long row0 = (long)b * SEQ;
            for (int which = 0; which < 2; ++which) {
                const int qb = which == 0 ? 15 - pr : pr; const long q0 = qb * 256;
                ta::attn_unit128<8, QP, KVP, 512, false, 512>(qb, QB + (row0 + q0) * QP + (h * 2 + 0) * 64, KVB + row0 * KVP + (h * 2 + 0) * 64, KVB + row0 * KVP + 512 + h * 128,
                                                    DO + (row0 + q0) * 512 + h * 128, (char*)F.lds, wid, nullptr, nullptr, 0.f);
                ta::attn_unit128<8, QP, KVP, 512, true, 512>(qb, QB + (row0 + q0) * QP + (h * 2 + 1) * 64, KVB + row0 * KVP + (h * 2 + 1) * 64, KVB + row0 * KVP + 512 + h * 128,
                                                    (bf16*)(ws_ + WS_YA) + (size_t)(row0 + q0) * 512 + h * 128, (char*)F.lds, wid, DO + (row0 + q0) * 512 + h * 128, P.in[8], lam);
            }
        }
    }
    for (int i = 0;; ++i) {
        const int L = (item_lo > N_DIFF ? item_lo : N_DIFF) + i * F.G + F.vcu; if (L >= item_hi || L >= N_DIFF + N_FOXP) break;
        {
            P2_BASES();
            const int tid = wid * 64 + lane_id();
            const int pu = L - N_DIFF, bh = pu >> 3, pr = pu & 7, b = bh >> 3, h = bh & 7;
            const long row0 = (long)b * SEQ;
            const int qbmax = 15 - pr;
            {
                const float* CUM = (const float*)(ws_ + WS_CUM) + (size_t)(b * 8 + h) * SEQ; const float* CHTOT = (const float*)(ws_ + WS_CHTOT);
                LAS float* pfx = (LAS float*)(F.lds + ta::LDS_PFX); LAS float* keyarr = (LAS float*)(F.lds + ta::LDS_CK);
                if (tid < 16) { float a = 0.f; for (int c = 0; c < tid; ++c) a += CHTOT[(b * 16 + c) * 8 + h]; pfx[tid] = a; }
                __syncthreads();
                for (int k = tid; k < 256 * (qbmax + 1); k += 512) { const float v = -(CUM[k] + pfx[k >> 8]) * LOG2E;
                    const unsigned hb = cvt_pk_bf16(v, 0.f) & 0xffffu; const float lo = v - __uint_as_float(hb << 16);
                    ((LAS unsigned*)keyarr)[k] = hb | (cvt_pk_bf16(lo, 0.f) << 16); }
                __syncthreads();
            }
            for (int which = 0; which < 2; ++which) {
                const int qb = which == 0 ? qbmax : pr; const long q0 = qb * 256;
                ta::attn_unit<32, QP, KVP, 1024, true, true>(qb, QB + (row0 + q0) * QP + 512 + h * 64, KVB + row0 * KVP + 1024 + h * 64, KVB + row0 * KVP + 1536 + h * 64,
                                                     (bf16*)(ws_ + WS_Y8 + (size_t)(row0 + q0) * 1024 + h * 64), (char*)F.lds, wid);
            }
        }
    }
    for (int i = 0;; ++i) {
        const int L = (item_lo > N_DIFF + N_FOXP ? item_lo : N_DIFF + N_FOXP) + i * F.G + F.vcu; if (L >= item_hi) break;
        {
            P2_BASES();
            const int lane = lane_id(), tid = wid * 64 + lane, r32 = lane & 31, hi = lane >> 5;
            const int mu0 = L - N_DIFF - N_FOXP; const int mu = (F.G == 256) ? ((mu0 & 255) * 4 + (mu0 >> 8)) : mu0;
            const int b = mu >> 6, h = (mu >> 4) & 3, qb = mu & 15;
            const long row0 = (long)b * SEQ, q0 = qb * 256;
            const bf16* MKV = (const bf16*)(ws_ + WS_MEMKV) + (long)b * MEML * DM;
            const float* gq = P.in[14]; const float* gk = P.in[15];
            LAS float* gqk = (LAS float*)(F.lds + sa::R_GQK);
            if (i == 0 || F.G != 256) {
                __syncthreads();
                LAS float* keyarr = (LAS float*)(F.lds + sa::R_KEY);
                const int key = tid >> 1, half = tid & 1; const bf16* kr = MKV + (long)key * DM + h * 128 + half * 64; float ss = 0.f;
#pragma unroll
                for (int c = 0; c < 8; ++c) { const bf16x8 v = *(const bf16x8*)(kr + c * 8);
#pragma unroll
                    for (int j = 0; j < 8; ++j) { const float f = bf2f((unsigned short)v[j]); ss += f * f; } }
                ss += __shfl_xor(ss, 1);
                if (half == 0) keyarr[key] = 1.0f / sqrtf(ss * (1.f / 128.f) + EPS);
                if (tid < 128) gqk[tid] = gq[tid] * gk[tid] * (0.08838834764831845f * LOG2E);
                __syncthreads();
                sa::fill_kv_res(MKV + h * 128, MKV + 512 + h * 128, DM, F.lds, wid, keyarr);
                __syncthreads();
            }
            const unsigned char* Q = ws_ + WS_Y8 + (size_t)(row0 + q0 + wid * 32 + r32) * 1024 + 512 + h * 128 + hi * 8;
            bf16x8 qr[8]; float qf[8][8]; float ss = 0.f;
#pragma unroll
            for (int d0 = 0; d0 < 8; ++d0) { const u32x2 v = *(const u32x2*)(Q + d0 * 16);
                const ta::f32x2_t a0 = __builtin_amdgcn_cvt_pk_f32_fp8((int)v.x, false), a1 = __builtin_amdgcn_cvt_pk_f32_fp8((int)v.x, true), a2 = __builtin_amdgcn_cvt_pk_f32_fp8((int)v.y, false), a3 = __builtin_amdgcn_cvt_pk_f32_fp8((int)v.y, true);
                qf[d0][0] = a0[0]; qf[d0][1] = a0[1]; qf[d0][2] = a1[0]; qf[d0][3] = a1[1]; qf[d0][4] = a2[0]; qf[d0][5] = a2[1]; qf[d0][6] = a3[0]; qf[d0][7] = a3[1];
#pragma unroll
                for (int j = 0; j < 8; ++j) ss += qf[d0][j] * qf[d0][j]; }
            ss += __shfl_xor(ss, 32);
            const float rq = 1.0f / sqrtf(ss * (1.f / 128.f) + EPS * 256.f);
#pragma unroll
            for (int d0 = 0; d0 < 8; ++d0) { const int ch = d0 * 16 + hi * 8; u32x4 w;
                const f32x4 ga = *(const LAS f32x4*)(gqk + ch), gb = *(const LAS f32x4*)(gqk + ch + 4);
                w[0] = cvt_pk_bf16(qf[d0][0] * rq * ga[0], qf[d0][1] * rq * ga[1]); w[1] = cvt_pk_bf16(qf[d0][2] * rq * ga[2], qf[d0][3] * rq * ga[3]);
                w[2] = cvt_pk_bf16(qf[d0][4] * rq * gb[0], qf[d0][5] * rq * gb[1]); w[3] = cvt_pk_bf16(qf[d0][6] * rq * gb[2], qf[d0][7] * rq * gb[3]);
                qr[d0] = __builtin_bit_cast(bf16x8, w); }
            sa::unit_res(qr, ws_ + WS_Y8 + (size_t)(row0 + q0) * 1024 + 512 + h * 128, 1024, F.lds, wid);
        }
    }
}

struct Sched3a { long a0; int pm;
    __device__ bool next(int j, pg8::Unit& u) const { if (j >= 12) return false; const int pn = j / 3, i = j % 3;
        u.aoff = a0 + (i == 0 ? (long)(WS_YA - WS_Y8) : (long)(i - 1) * 512); u.boff = (i == 0 ? 0 : (long)MiB + (long)(i - 1) * (1024 * 1024)) + (long)pn * 256 * 1024;
        u.gofs = i == 0 ? 0 : 1; u.pm = pm; u.pn = pn; u.sub = i; return true; } };
struct Sched3b { long a0; int pm;
    __device__ bool next(int j, pg8::Unit& u) const { if (j >= 4) return false; u.aoff = a0; u.boff = (long)j * 256 * 2048; u.gofs = 0; u.pm = pm; u.pn = j; u.sub = 0; return true; } };

struct EpiMerge {
    static constexpr bool PERM = true;
    const unsigned char* GT; bf16* MG;
    __device__ __forceinline__ bool operator()(f32x4 (&acc)[2][2][4][2], const pg8::Unit& u, int wr, int wc, int fr_in, int fq_in) const {
        int fr = fr_in, fq = fq_in; asm volatile("" : "+v"(fr), "+v"(fq));
        const int row0 = u.pm * 256 + wr * 64 + fr, i = u.sub;
        const unsigned char* ta_ = GT + (size_t)(u.pm * 12 + i * 4 + u.pn) * 65536 + (size_t)((wr * 4 + wc) * 64 + fq * 16 + fr) * 16;
        if (i < 2) {
            const float sc = i == 0 ? 128.f : 1.f;
#pragma unroll
            for (int ai = 0; ai < 2; ++ai) {
                u32x4 ga[4], gb[4];
#pragma unroll
                for (int m = 0; m < 4; ++m) { ga[m] = *(const u32x4*)(ta_ + (ai * 4 + m) * 8192); gb[m] = *(const u32x4*)(ta_ + 4 * 65536 + (ai * 4 + m) * 8192); }
#pragma unroll
                for (int m = 0; m < 4; ++m)
#pragma unroll
                    for (int bj = 0; bj < 2; ++bj)
#pragma unroll
                        for (int n = 0; n < 2; ++n) { const unsigned a = ga[m][bj * 2 + n], b = gb[m][bj * 2 + n];
#pragma unroll
                            for (int j = 0; j < 4; ++j) acc[ai][bj][m][n][j] *= (float)((a >> (8 * j)) & 255u) * sc * __builtin_amdgcn_rcpf((float)((b >> (8 * j)) & 255u)); }
            }
            return true;
        }
        const int col = u.pn * 256 + g64_col(wc, 0, fq);
        u32x4 ga[8];
#pragma unroll
        for (int jj = 0; jj < 8; ++jj) ga[jj] = *(const u32x4*)(ta_ + jj * 8192);
#pragma unroll
        for (int ai = 0; ai < 2; ++ai)
#pragma unroll
            for (int m = 0; m < 4; ++m) { const int row = row0 + ai * 128 + m * 16; const int jj = ai * 4 + m;
#pragma unroll
                for (int bj = 0; bj < 2; ++bj) { f32x4 v0 = acc[ai][bj][m][0], v1 = acc[ai][bj][m][1]; const unsigned a0 = ga[jj][bj * 2], a1 = ga[jj][bj * 2 + 1];
#pragma unroll
                    for (int j = 0; j < 4; ++j) { v0[j] *= (float)((a0 >> (8 * j)) & 255u) * (1.f / (255.f * 128.f)); v1[j] *= (float)((a1 >> (8 * j)) & 255u) * (1.f / (255.f * 128.f)); }
                    u32x4 w; w.x = cvt_pk_bf16(v0[0], v0[1]); w.y = cvt_pk_bf16(v0[2], v0[3]); w.z = cvt_pk_bf16(v1[0], v1[1]); w.w = cvt_pk_bf16(v1[2], v1[3]);
                    *(u32x4*)(MG + (size_t)row * DM + col + 32 * bj) = w; } }
        return false;
    }
};

struct EpiOut {
    static constexpr bool PERM = true;
    const float* X; bf16* X1B; const float* g2; unsigned char* H2U8; const bf16* H; const float* RINV; const float* gattn; int useH;
    __device__ __forceinline__ bool operator()(f32x4 (&acc)[2][2][4][2], const pg8::Unit& u, int wr, int wc, int fr, int fq) const {
        const int col0 = u.pn * 256 + wc * 32 + 8 * fq;
        f32x4 gv[2][2];
#pragma unroll
        for (int bj = 0; bj < 2; ++bj)
#pragma unroll
            for (int n = 0; n < 2; ++n) gv[bj][n] = *(const f32x4*)(g2 + col0 + bj * 128 + n * 4);
        if (useH) {
            f32x4 gi[2][2];
#pragma unroll
            for (int bj = 0; bj < 2; ++bj)
#pragma unroll
                for (int n = 0; n < 2; ++n) { const f32x4 g = *(const f32x4*)(gattn + col0 + bj * 128 + n * 4);
#pragma unroll
                    for (int j = 0; j < 4; ++j) gi[bj][n][j] = __builtin_amdgcn_rcpf(g[j]); }
#pragma unroll
            for (int ai = 0; ai < 2; ++ai) {
                u32x4 hr[4][2]; float ri[4];
#pragma unroll
                for (int m = 0; m < 4; ++m) { const unsigned row = (unsigned)(u.pm * 256 + ai * 128 + wr * 64 + m * 16 + fr); ri[m] = RINV[row];
#pragma unroll
                    for (int bj = 0; bj < 2; ++bj) hr[m][bj] = *(const u32x4*)((const char*)H + ((row * DM + col0 + bj * 128) * 2u)); }
#pragma unroll
                for (int m = 0; m < 4; ++m) { const int rl = ai * 128 + wr * 64 + m * 16 + fr; const unsigned off = (unsigned)(u.pm * 256 + rl) * DM + col0; const float r = ri[m];
#pragma unroll
                    for (int bj = 0; bj < 2; ++bj) { u32x4 w; u32x2 w8; const u32x4 hh = hr[m][bj];
#pragma unroll
                        for (int n = 0; n < 2; ++n) { const f32x4 xv = {__uint_as_float(hh[2 * n] << 16), __uint_as_float(hh[2 * n] & 0xffff0000u), __uint_as_float(hh[2 * n + 1] << 16), __uint_as_float(hh[2 * n + 1] & 0xffff0000u)};
                            const f32x4 o = xv * gi[bj][n] * r + acc[ai][bj][m][n];
                            w[2 * n] = cvt_pk_bf16(o[0], o[1]); w[2 * n + 1] = cvt_pk_bf16(o[2], o[3]);
                            const f32x4 hv = o * gv[bj][n]; w8[n] = cvt4_fp8(hv[0], hv[1], hv[2], hv[3]); }
                        *(u32x4*)((char*)X1B + (off + bj * 128) * 2u) = w; *(u32x2*)(H2U8 + (off + bj * 128)) = w8; }
                    }
                asm volatile("" ::: "memory");
            }
            return false;
        }
#pragma unroll
        for (int am = 0; am < 2; ++am) { const int ai = am, m0 = 0;
            f32x4 xr[4][2][2];
#pragma unroll
            for (int m = m0; m < m0 + 4; ++m) { const size_t off = (size_t)(u.pm * 256 + ai * 128 + wr * 64 + m * 16 + fr) * DM + col0;
#pragma unroll
                for (int bj = 0; bj < 2; ++bj)
#pragma unroll
                    for (int n = 0; n < 2; ++n) xr[m][bj][n] = *(const f32x4*)(X + off + bj * 128 + n * 4); }
#pragma unroll
            for (int m = m0; m < m0 + 4; ++m) { const int rl = ai * 128 + wr * 64 + m * 16 + fr; const size_t off = (size_t)(u.pm * 256 + rl) * DM + col0;
#pragma unroll
                for (int bj = 0; bj < 2; ++bj) { u32x4 w; u32x2 w8;
#pragma unroll
                    for (int n = 0; n < 2; ++n) { const f32x4 o = xr[m][bj][n] + acc[ai][bj][m][n];
                        w[2 * n] = cvt_pk_bf16(o[0], o[1]); w[2 * n + 1] = cvt_pk_bf16(o[2], o[3]);
                        const f32x4 hv = o * gv[bj][n]; w8[n] = cvt4_fp8(hv[0], hv[1], hv[2], hv[3]); }
                    *(u32x4*)(X1B + off + bj * 128) = w; *(u32x2*)(H2U8 + off + bj * 128) = w8; }
                }
            asm volatile("" ::: "memory");
        }
        return false;
    }
};

__device__ __forceinline__ void phase3(Frame& F, const Params& P) {
    unsigned char* ws = F.ws;
    bf16* QB = (bf16*)(ws + WS_QBUF);
    bf16* H2 = (bf16*)(ws + WS_KVBUF); bf16* MG = (bf16*)(ws + WS_KVBUF + 128 * MiB);
#ifndef NO3A
    if (!(P.dummy & 4)) for (int pm = blockIdx.x; pm < T / 256; pm += F.G) {
        {
            pg8::Gemm g{(const char*)(ws + WS_Y8), (const char*)(ws + WS_WO), 1024, 1024, 512 / 128, nullptr};
            Sched3a S{(long)pm * 256 * 1024, pm}; EpiMerge E{(const unsigned char*)(ws + WS_GATES), MG};
            pg8::gemm_phase<EpiMerge, Sched3a, true, false, true, true>(F.lds, g, S, E, F.wave);
        }
    }
#endif
#ifndef NO3B
    if (!(P.dummy & 8)) for (int pm = blockIdx.x; pm < T / 256; pm += F.G) {
        {
            pg8::Gemm g{(const char*)MG, (const char*)(ws + WS_WOUT), DM * 2, DM * 2, DM / 64, nullptr};
            Sched3b S{(long)pm * 256 * DM * 2, pm}; EpiOut E{P.in[0], H2, P.in[20], ws + WS_H2U8, (const bf16*)P.out, (const float*)(ws + WS_RINVA), P.in[3], __builtin_amdgcn_readfirstlane(*(const int*)(ws + WS_XFLAG))};
            pg8::gemm_phase<EpiOut, Sched3b, true, false>(F.lds, g, S, E, F.wave);
        }
    }
#endif
#ifndef NO3C
    if (!(P.dummy & 16)) for (int pm = blockIdx.x; pm < T / 256; pm += F.G) {
        {
            const int lane = lane_id(), wid = F.wave, tid = wid * 64 + lane, r32 = lane & 31, hi = lane >> 5;
            LAS float* LG = (LAS float*)F.lds;
            LAS int* cnt = (LAS int*)(F.lds + X_TAB);
            LAS float* rs = (LAS float*)(F.lds + 40960) + wid * 32;
            LAS unsigned char* at = F.lds + 45056 + wid * 4608;
            if (tid < 64) cnt[tid] = 0;
            const size_t prow0 = (size_t)pm * 256 + wid * 32;
            const int lr8 = lane >> 3, c8 = lane & 7;
            const bf16* hp = H2 + (prow0 + lr8) * DM + 8 * c8;
            const bf16* WR = (const bf16*)(ws + WS_WR) + (size_t)r32 * DM + hi * 8;
            f32x16 a0 = f32x16{}, a1 = f32x16{};
            u32x4 xv[4], xn[4]; float ssr[4] = {0.f, 0.f, 0.f, 0.f};
#pragma unroll
            for (int i = 0; i < 4; ++i) xv[i] = *(const u32x4*)(hp + (size_t)(8 * i) * DM);
            for (int c = 0; c < 16; ++c) {
                if (c + 1 < 16) {
#pragma unroll
                    for (int i = 0; i < 4; ++i) xn[i] = *(const u32x4*)(hp + (size_t)(8 * i) * DM + (c + 1) * 64);
                }
#pragma unroll
                for (int i = 0; i < 4; ++i) { *(LAS u32x4*)(at + (8 * i + lr8) * 144 + c8 * 16) = xv[i];
#pragma unroll
                    for (int e = 0; e < 4; ++e) { const float lo_ = __uint_as_float(xv[i][e] << 16), hi_ = __uint_as_float(xv[i][e] & 0xffff0000u); ssr[i] += lo_ * lo_ + hi_ * hi_; } }
                LDS_WAIT();
#pragma unroll
                for (int kk = 0; kk < 4; ++kk) {
                    const bf16x8 af = *(const LAS bf16x8*)(at + r32 * 144 + kk * 32 + hi * 16);
                    const bf16x8 b0 = *(const bf16x8*)(WR + c * 64 + kk * 16), b1 = *(const bf16x8*)(WR + (size_t)32 * DM + c * 64 + kk * 16);
                    a0 = __builtin_amdgcn_mfma_f32_32x32x16_bf16(af, b0, a0, 0, 0, 0);
                    a1 = __builtin_amdgcn_mfma_f32_32x32x16_bf16(af, b1, a1, 0, 0, 0);
                }
#pragma unroll
                for (int i = 0; i < 4; ++i) xv[i] = xn[i];
            }
#pragma unroll
            for (int i = 0; i < 4; ++i) { float t_ = ssr[i]; t_ += __shfl_xor(t_, 1); t_ += __shfl_xor(t_, 2); t_ += __shfl_xor(t_, 4);
                if (c8 == 0) rs[8 * i + lr8] = 1.0f / sqrtf(t_ * (1.f / DM) + EPS); }
            LDS_WAIT();
            if (lane < 32) ((float*)(ws + WS_RSTD))[prow0 + lane] = rs[lane];
#pragma unroll
            for (int r = 0; r < 16; ++r) { const float sc = rs[sa::crow(r, hi)]; a0[r] *= sc; a1[r] *= sc; }
            __syncthreads();
#pragma unroll
            for (int r = 0; r < 16; ++r) { const int lr = wid * 32 + sa::crow(r, hi); LG[lr * 37 + r32] = a0[r]; if (r32 < 4) LG[lr * 37 + 32 + r32] = a1[r]; }
            __syncthreads();
            if (tid < 256) {
                const float* brg = P.in[22]; const float* bre = P.in[24];
                const LAS float* lg = LG + tid * 37;
                float gl[4]; int gi = 0;
#pragma unroll
                for (int j = 0; j < 4; ++j) gl[j] = lg[j] + brg[j];
#pragma unroll
                for (int j = 1; j < 4; ++j) if (gl[j] > gl[gi]) gi = j;
                float den = 0.f;
#pragma unroll
                for (int j = 0; j < 4; ++j) den += __expf(gl[j] - gl[gi]);
                const float gate = 1.0f / den;
                float el[8];
#pragma unroll
                for (int j = 0; j < 8; ++j) el[j] = lg[4 + 8 * gi + j] + bre[8 * gi + j];
                int i0 = 0;
#pragma unroll
                for (int j = 1; j < 8; ++j) if (el[j] > el[i0]) i0 = j;
                int i1 = i0 == 0 ? 1 : 0;
#pragma unroll
                for (int j = 0; j < 8; ++j) if (j != i0 && el[j] > el[i1]) i1 = j;
                const float w0 = 1.0f / (1.0f + __expf(el[i1] - el[i0])), w1 = 1.0f - w0;
                const int e0 = gi * 8 + i0, e1 = gi * 8 + i1;
                const int r0 = atomicAdd((int*)&cnt[e0], 1), r1 = atomicAdd((int*)&cnt[32 + e1], 1);
                int* RT = (int*)(ws + WS_ROUTE) + ((size_t)pm * 256 + tid) * 8;
                RT[0] = e0; RT[1] = e1; RT[2] = __float_as_int(gate * w0); RT[3] = __float_as_int(gate * w1); RT[4] = r0; RT[5] = r1;
            }
            __syncthreads();
            if (tid < 64) ((int*)(ws + WS_BLKCNT))[pm * 64 + tid] = cnt[tid];
            __syncthreads();
        }
#endif
    }
}

__device__ __forceinline__ void build_bins(Frame& F, int pm_for_prefix) {
    unsigned char* ws = F.ws; const int tid = F.wave * 64 + lane_id();
    LAS int* tab = (LAS int*)(F.lds + X_TAB);
    const int* BC = (const int*)(ws + WS_BLKCNT);
    if (tid < 64) { int tot = 0, pre = 0; for (int p = 0; p < T / 256; ++p) { const int c = BC[p * 64 + tid]; if (p < pm_for_prefix) pre += c; tot += c; } tab[tid] = tot; tab[128 + tid] = pre; }
    __syncthreads();
    if (tid == 0) { int tl = 0; for (int b = 0; b < 64; ++b) { tab[64 + b] = tl * 256; tab[192 + b] = tl; tl += (tab[b] + 255) >> 8; } tab[192 + 64] = tl; }
    __syncthreads();
}

__device__ __forceinline__ void phase4(Frame& F, const Params& P) {
    unsigned char* ws = F.ws; const int tid = F.wave * 64 + lane_id();
    LAS int* tab = (LAS int*)(F.lds + X_TAB);
    int* TOK = (int*)(ws + WS_TOK); float* WL = (float*)(ws + WS_WL);
    for (int pm = blockIdx.x; pm < T / 256; pm += F.G) {
        build_bins(F, pm);
        if (tid < 256) {
            const int tok = pm * 256 + tid; const int* RT = (const int*)(ws + WS_ROUTE) + (size_t)tok * 8;
            const int e0 = RT[0], e1 = RT[1];
            const int d0 = tab[64 + e0] + tab[128 + e0] + RT[4], d1 = tab[64 + 32 + e1] + tab[128 + 32 + e1] + RT[5];
            TOK[d0] = tok; WL[d0] = __int_as_float(RT[2]); TOK[d1] = tok; WL[d1] = __int_as_float(RT[3]);
        }
        __syncthreads();
    }
}

struct SchedMoe { const LAS int* rec; int n; long astep, bstep_e, bstep_pn; bool gather;
    __device__ bool next(int j, pg8::Unit& u) const { if (j >= n) return false; const int rt = __builtin_amdgcn_readfirstlane(rec[4 * j]), pn = __builtin_amdgcn_readfirstlane(rec[4 * j + 1]), bin = __builtin_amdgcn_readfirstlane(rec[4 * j + 2]);
        u.aoff = gather ? 0 : (long)rt * astep; u.boff = (long)(bin & 31) * bstep_e + (long)pn * bstep_pn; u.gofs = j * 256; u.pm = rt; u.pn = pn; u.sub = j; return true; } };

struct EpiUp {
    static constexpr bool PERM = true;
    bf16* ACT; const float* RSTD; const LAS int* gl;
    __device__ __forceinline__ bool operator()(f32x4 (&acc)[2][2][4][2], const pg8::Unit& u, int wr, int wc, int fr, int fq) const {
        const int row0 = u.pm * 256 + wr * 64 + fr;
        float rr[2][4];
#pragma unroll
        for (int ai = 0; ai < 2; ++ai)
#pragma unroll
            for (int m = 0; m < 4; ++m) rr[ai][m] = RSTD[gl[u.gofs + ai * 128 + wr * 64 + m * 16 + fr]] * (1.f / 32.f);
#pragma unroll
        for (int ai = 0; ai < 2; ++ai)
#pragma unroll
            for (int m = 0; m < 4; ++m) { float v[8]; const float r = rr[ai][m];
#pragma unroll
                for (int n = 0; n < 2; ++n)
#pragma unroll
                    for (int j = 0; j < 4; ++j) { const float a = acc[ai][0][m][n][j] * r, b = acc[ai][1][m][n][j] * r; v[4 * n + j] = a * __builtin_amdgcn_rcpf(1.f + __expf(-a)) * b; }
                u32x2 w; w.x = cvt4_fp8(v[0] * 8.f, v[1] * 8.f, v[2] * 8.f, v[3] * 8.f); w.y = cvt4_fp8(v[4] * 8.f, v[5] * 8.f, v[6] * 8.f, v[7] * 8.f);
                *(u32x2*)((unsigned char*)ACT + (size_t)(row0 + ai * 128 + m * 16) * EFF + u.pn * 128 + wc * 32 + fq * 8) = w; }
        return false;
    }
};

struct EpiDown0 {
    static constexpr bool PERM = true;
    bf16* Y0_; const int* TOK_; const float* WL_; const LAS int* rec;
    __device__ __forceinline__ bool operator()(f32x4 (&acc)[2][2][4][2], const pg8::Unit& u, int wr, int wc, int fr, int fq) const {
        bf16* Y0 = Y0_; const int* TOK = TOK_; const float* WL = WL_; asm volatile("" : "+s"(Y0), "+s"(TOK), "+s"(WL));
        const int nvalid = rec[4 * u.sub + 3]; const int col0 = u.pn * 256 + wc * 32 + 8 * fq;
        int tok[2][4]; float w[2][4];
#pragma unroll
        for (int ai = 0; ai < 2; ++ai)
#pragma unroll
            for (int m = 0; m < 4; ++m) { const int rl = ai * 128 + wr * 64 + m * 16 + fr; const bool ok = rl < nvalid;
                tok[ai][m] = ok ? TOK[u.pm * 256 + rl] : -1; w[ai][m] = ok ? WL[u.pm * 256 + rl] * (1.f / 128.f) : 0.f; }
#pragma unroll
        for (int ai = 0; ai < 2; ++ai)
#pragma unroll
            for (int m = 0; m < 4; ++m) { if (tok[ai][m] >= 0) { unsigned char* op = (unsigned char*)Y0 + (size_t)tok[ai][m] * DM + col0; const float ww = w[ai][m] * 32.f;
#pragma unroll
                for (int bj = 0; bj < 2; ++bj) { const f32x4 v0 = acc[ai][bj][m][0] * ww, v1 = acc[ai][bj][m][1] * ww;
                    u32x2 o; o.x = cvt4_fp8(v0[0], v0[1], v0[2], v0[3]); o.y = cvt4_fp8(v1[0], v1[1], v1[2], v1[3]);
                    *(u32x2*)(op + bj * 128) = o; } } }
        return false;
    }
};
struct EpiDown1 {
    static constexpr bool PERM = true;
    float* O_; const bf16* Y0_; const bf16* X1_; const int* TOK_; const float* WL_; const LAS int* rec;
    __device__ __forceinline__ bool operator()(f32x4 (&acc)[2][2][4][2], const pg8::Unit& u, int wr, int wc, int fr, int fq) const {
        float* O = O_; const bf16* Y0 = Y0_; const bf16* X1 = X1_; const int* TOK = TOK_; const float* WL = WL_; asm volatile("" : "+s"(O), "+s"(Y0), "+s"(X1), "+s"(TOK), "+s"(WL));
        const int nvalid = rec[4 * u.sub + 3]; const int col0 = u.pn * 256 + wc * 32 + 8 * fq;
#pragma unroll
        for (int am = 0; am < 2; ++am) { const int ai = am;
            int tok[4]; float w[4]; u32x4 xr[4][2]; u32x2 yr[4][2];
#pragma unroll
            for (int m = 0; m < 4; ++m) { const int rl = ai * 128 + wr * 64 + m * 16 + fr; const bool ok = rl < nvalid;
                tok[m] = ok ? TOK[u.pm * 256 + rl] : -1; w[m] = ok ? WL[u.pm * 256 + rl] * (1.f / 128.f) : 0.f; }
#pragma unroll
            for (int m = 0; m < 4; ++m) { const size_t ro = (size_t)(tok[m] < 0 ? 0 : tok[m]) * DM + col0;
#pragma unroll
                for (int bj = 0; bj < 2; ++bj) { yr[m][bj] = *(const u32x2*)((const unsigned char*)Y0 + ro + bj * 128); xr[m][bj] = *(const u32x4*)(X1 + ro + bj * 128); } }
#pragma unroll
            for (int m = 0; m < 4; ++m) { if (tok[m] >= 0) { float* op = O + (size_t)tok[m] * DM + col0;
#pragma unroll
                for (int bj = 0; bj < 2; ++bj)
#pragma unroll
                    for (int n = 0; n < 2; ++n) { const unsigned y8 = yr[m][bj][n], xa = xr[m][bj][2 * n], xb = xr[m][bj][2 * n + 1];
                        const ta::f32x2_t y01 = __builtin_amdgcn_cvt_pk_f32_fp8((int)y8, false), y23 = __builtin_amdgcn_cvt_pk_f32_fp8((int)y8, true);
                        const f32x4 yv = {y01[0] * (1.f / 32.f), y01[1] * (1.f / 32.f), y23[0] * (1.f / 32.f), y23[1] * (1.f / 32.f)};
                        const f32x4 xv = {__uint_as_float(xa << 16), __uint_as_float(xa & 0xffff0000u), __uint_as_float(xb << 16), __uint_as_float(xb & 0xffff0000u)};
                        *(f32x4*)(op + bj * 128 + n * 4) = xv + yv + acc[ai][bj][m][n] * w[m]; } } }
            asm volatile("" ::: "memory");
        }
        return false;
    }
};

__device__ __forceinline__ void phase_moe(Frame& F, const Params& P, int mode, int sub = 0) {
    unsigned char* ws = F.ws;
#if MK_N_LAUNCHES == 1
    if ((int)blockIdx.x >= T / 256) build_bins(F, 0);
#else
    build_bins(F, 0);
#endif
    LAS int* tab = (LAS int*)(F.lds + X_TAB); LAS int* rec = tab + 512; LAS int* gl = (LAS int*)(F.lds + X_ROWSS);
    const int b_lo = mode == 0 ? 32 * sub : (mode == 2 ? 32 : 0), b_hi = b_lo + 32;
    const int t_lo = __builtin_amdgcn_readfirstlane(tab[192 + b_lo]), t_hi = __builtin_amdgcn_readfirstlane(tab[192 + b_hi]), nunits = (t_hi - t_lo) * 4;
    const int u0 = __builtin_amdgcn_readfirstlane(tab[192 + 32]) * 4, u1 = __builtin_amdgcn_readfirstlane(tab[192 + 64]) * 4 - u0;
    const int rot = (mode == 0 ? (sub ? u0 : 0) : (mode == 1 ? u0 + u1 : 2 * u0 + u1)) % F.G;
    const int vc = (F.vcu + F.G - rot) % F.G;
    const int* TOK = (const int*)(ws + WS_TOK);
    for (int base = 0;; base += 16) {
        const int Lb = base * F.G + vc; if (Lb >= nunits) break;
        __syncthreads();
        const int tid = F.wave * 64 + lane_id();
        if (tid < 16) { const int L = (base + tid) * F.G + vc;
            if (L < nunits) { const int rt = t_lo + (L >> 2), pn = L & 3; int bin = b_lo; while (tab[192 + bin + 1] <= rt) ++bin;
                int nv = tab[bin] - (rt - tab[192 + bin]) * 256; nv = nv > 256 ? 256 : nv;
                rec[4 * tid] = rt; rec[4 * tid + 1] = pn; rec[4 * tid + 2] = bin; rec[4 * tid + 3] = nv; }
            else rec[4 * tid] = -1; }
        __syncthreads();
        int n = 0;
        _Pragma("nounroll") while (n < 16 && __builtin_amdgcn_readfirstlane(rec[4 * n]) >= 0) ++n;
        if (mode == 0) {
            for (int e = tid; e < n * 256; e += 512) { const int j = e >> 8, r = e & 255; gl[e] = r < rec[4 * j + 3] ? TOK[rec[4 * j] * 256 + r] : 0; }
            __syncthreads();
            pg8::Gemm g{(const char*)(ws + WS_H2U8), (const char*)(ws + WS_WUP), DM, DM, DM / 128, gl};
            SchedMoe S{rec, n, 0, 1024L * 1024, 256L * 1024, true}; EpiUp E{(bf16*)(ws + WS_GATES), (const float*)(ws + WS_RSTD), gl};
            pg8::gemm_phase<EpiUp, SchedMoe, true, true, true>(F.lds, g, S, E, F.wave);
        } else {
            pg8::Gemm g{(const char*)(ws + WS_GATES), (const char*)(ws + WS_WDN), EFF, EFF, EFF / 128, gl};
            SchedMoe S{rec, n, 256L * EFF, 1024L * 512, 256L * 512, false};
            bf16* Y0 = (bf16*)(ws + WS_KVBUF + 128 * MiB);
            if (mode == 1) { EpiDown0 E{Y0, TOK, (const float*)(ws + WS_WL), rec}; pg8::gemm_phase<EpiDown0, SchedMoe, true, false, true>(F.lds, g, S, E, F.wave); }
            else { EpiDown1 E{P.out, Y0, (const bf16*)(ws + WS_KVBUF), TOK, (const float*)(ws + WS_WL), rec}; pg8::gemm_phase<EpiDown1, SchedMoe, true, false, true>(F.lds, g, S, E, F.wave); }
        }
    }
}

__global__ void __launch_bounds__(512, 2) fwd_kernel(Params P) {
    extern __shared__ __attribute__((aligned(16))) unsigned char lds_raw[];
    Frame F;
    F.lds = (LAS unsigned char*)lds_raw;
    F.wave = __builtin_amdgcn_readfirstlane((int)threadIdx.x >> 6);
    F.G = gridDim.x; { const int bx = blockIdx.x; F.vcu = (F.G % 8 == 0) ? (bx % 8) * (F.G / 8) + bx / 8 : bx; }
    F.ws = P.ws;
    const int lo = P.ph_lo, hi = P.ph_hi;
#if MK_N_LAUNCHES == 1
    volatile LAS unsigned* bst = (volatile LAS unsigned*)(F.lds + X_BARST);
    { const int t_ = F.wave * 64 + lane_id(); if (t_ < 2) bst[t_] = 0u; }
    __syncthreads();
    XcdBarrier bar = xcd_barrier_post((unsigned*)(P.ws + WS_CTL) + CW_BAR, bst, F.wave == 0 && lane_id() == 0);
#endif
#ifndef PH_MASK
#define PH_MASK 0xff
#endif
#define IN(k) (((PH_MASK >> (k)) & 1) && lo <= (k) && (k) < hi)
#if MK_N_LAUNCHES == 1
#define SEAM(k) do { if (IN(k) && IN((k) + 1)) { xcd_barrier(bar, F.wave == 0 && lane_id() == 0); } } while (0)
#else
#define SEAM(k) do { } while (0)
#endif
    if (IN(0)) phase0(F, P);
    SEAM(0);
    if (IN(1)) phase1(F, P);
    SEAM(1);
    if (IN(2)) phase2(F, P, P.item_lo, P.item_hi);
    SEAM(2);
    if (IN(3)) phase3(F, P);
    SEAM(3);
    if (IN(4)) phase4(F, P);
    SEAM(4);
    if (IN(5)) { phase_moe(F, P, 0, 0); flag_signal((unsigned*)(P.ws + WS_CTL) + CW_BAR, XB_FLAG_A, F.wave == 0 && lane_id() == 0); phase_moe(F, P, 0, 1); }
    if (IN(6)) { flag_wait((unsigned*)(P.ws + WS_CTL) + CW_BAR, XB_FLAG_A, F.wave == 0 && lane_id() == 0); phase_moe(F, P, 1); }
    SEAM(6);
    if (IN(7)) phase_moe(F, P, 2);
#undef IN
#undef SEAM
}

extern "C" void kernel_launch(void* const* d_in, const int* in_sizes, int n_in, void* d_out, int out_size, void* d_ws, size_t ws_size, hipStream_t stream) {
    static int grid = 0;
    if (grid == 0) {
        if (n_in != 27 || out_size != T * DM || ws_size < WS_END) { fprintf(stderr, "kernel_launch: unexpected shapes (n_in %d out %d ws %zu)\n", n_in, out_size, ws_size); grid = -1; return; }
        int dev = 0, cus = 0, per_cu = 0;
        hipGetDevice(&dev); hipDeviceGetAttribute(&cus, hipDeviceAttributeMultiprocessorCount, dev);
        hipFuncSetAttribute((const void*)fwd_kernel, hipFuncAttributeMaxDynamicSharedMemorySize, LDS_BYTES);
        hipOccupancyMaxActiveBlocksPerMultiprocessor(&per_cu, (const void*)fwd_kernel, 512, LDS_BYTES);
        if (per_cu < 1) { fprintf(stderr, "kernel_launch: occupancy query says %d blocks per CU\n", per_cu); per_cu = 1; }
        grid = cus * 1;
        (void)hipGetLastError();
    }
    if (grid < 0) return;
    Params p{};
    for (int i = 0; i < 27; ++i) p.in[i] = (const float*)d_in[i];
    p.out = (float*)d_out; p.ws = (unsigned char*)d_ws; p.item_lo = 0; p.item_hi = 3072;
#if MK_N_LAUNCHES == 1
    p.ph_lo = 0; p.ph_hi = 8;
    (void)hipMemsetAsync((char*)d_ws + WS_CTL, 0, CTL_ZERO_BYTES, stream);
    void* args[] = {&p};
    hipError_t e = hipLaunchCooperativeKernel((const void*)fwd_kernel, dim3(grid), dim3(512), args, LDS_BYTES, stream);
    if (e != hipSuccess) fprintf(stderr, "cooperative launch failed: %s (grid %d)\n", hipGetErrorString(e), grid);
#else
#ifndef PHASE_LIST
#define PHASE_LIST {0, 1, 2, 3, 4, 5, 6, 7}
#endif
    const int plist[] = PHASE_LIST;
    for (int ph : plist) { p.item_lo = 0; p.item_hi = 3072; p.dummy = 0; int k = ph;
        if (ph == 100) { k = 2; p.item_hi = 1024; } else if (ph == 200) { k = 2; p.item_lo = 1024; p.item_hi = 2048; p.dummy = 1; } else if (ph == 201) { k = 2; p.item_lo = 2048; p.dummy = 1; }
        else if (ph == 150) { k = 1; p.dummy = 1; }
        else if (ph >= 300 && ph < 400) { k = 3; p.dummy = 1 | (ph - 300); }
        else if (ph >= 400) { k = ph / 100; p.dummy = 1; }
        p.ph_lo = k; p.ph_hi = k + 1; hipLaunchKernelGGL(fwd_kernel, dim3(grid), dim3(512), LDS_BYTES, stream, p); }
#endif
}
```
